# Optimizing an MI355X kernel written in HIP

```python
import math
import jax, jax.numpy as jnp
from jax import lax
import numpy as np

D_MODEL = 1024
BATCH = 2
SEQ = 16384
DEPTH = 2
DEC_BATCH = 1
DEC_SEQ = 16384
PAST_LEN = 128

N_MEM = 256
ATT_HEADS = 8
ATT_KV_HEADS = 2
ATT_HEAD_DIM = 64
ATT_WIDTH = ATT_HEADS * ATT_HEAD_DIM
ATT_KV_WIDTH = ATT_KV_HEADS * ATT_HEAD_DIM
WINDOW = 128
BLOCK = 128
N_BUCKETS = 32
MAX_DISTANCE = 128
HYENA_WIDTH = 512
HYENA_ORDER = 2
SHORT_CONV = 3
FILTER_EMB = 33
FILTER_BANDS = (FILTER_EMB - 1) // 2
FILTER_HIDDEN = 64
FILTER_INNER = 2
FAST_DECAY_PCT = 0.3
SLOW_DECAY_PCT = 1.5
DECAY_TARGET = 1e-2
MEM_HEADS = 4
MEM_HEAD_DIM = 128
MEM_WIDTH = MEM_HEADS * MEM_HEAD_DIM
N_BRANCH = 3
BRANCH_WIDTH = 512
PEER_HEADS = 8
N_KEYS = 128
N_EXPERTS = N_KEYS * N_KEYS
PEER_TOPK = 16
PEER_HALF = 128
PEER_QDIM = 2 * PEER_HALF
PEER_BLOCK = 128
O_K = ATT_WIDTH
O_V = O_K + ATT_KV_WIDTH
O_HY = O_V + ATT_KV_WIDTH
O_MQ = O_HY + (HYENA_ORDER + 1) * HYENA_WIDTH
O_GATE = O_MQ + MEM_WIDTH
IN_WIDTH = O_GATE + N_BRANCH * D_MODEL
ALPHA = (2 * DEPTH) ** 0.25
BETA = (8 * DEPTH) ** -0.25
LN_EPS = 1e-5
NEG_INF = -1e30

kernel_name = 'hybrid_bidir_encoder'


def layer_norm(x, g, b):
    xf = x.astype(jnp.float32)
    mu = jnp.mean(xf, axis=-1, keepdims=True)
    var = jnp.mean(jnp.square(xf - mu), axis=-1, keepdims=True)
    y = (xf - mu) * lax.rsqrt(var + LN_EPS) * g.astype(jnp.float32) + b.astype(jnp.float32)
    return y.astype(x.dtype)


def t5_bucket(rel):
    nb = N_BUCKETS // 2
    max_exact = nb // 2
    ret = jnp.where(rel > 0, nb, 0)
    n = jnp.abs(rel)
    nf = jnp.maximum(n, 1).astype(jnp.float32)
    large = max_exact + (jnp.log(nf / max_exact) / math.log(MAX_DISTANCE / max_exact)
                         * (nb - max_exact)).astype(jnp.int32)
    large = jnp.minimum(large, nb - 1)
    return ret + jnp.where(n < max_exact, n, large)


def window_attention(q, k, v, rel_bias, sink):
    B, S = q.shape[0], q.shape[1]
    nb = S // BLOCK
    G = ATT_HEADS // ATT_KV_HEADS
    qb = q.reshape(B, nb, BLOCK, ATT_KV_HEADS, G, ATT_HEAD_DIM)
    pad = ((0, 0), (BLOCK, BLOCK), (0, 0), (0, 0))
    kp = jnp.pad(k, pad).reshape(B, nb + 2, BLOCK, ATT_KV_HEADS, ATT_HEAD_DIM)
    vp = jnp.pad(v, pad).reshape(B, nb + 2, BLOCK, ATT_KV_HEADS, ATT_HEAD_DIM)
    kb = jnp.concatenate([kp[:, :-2], kp[:, 1:-1], kp[:, 2:]], axis=2)
    vb = jnp.concatenate([vp[:, :-2], vp[:, 1:-1], vp[:, 2:]], axis=2)
    qpos = jnp.arange(BLOCK)
    kpos = jnp.arange(3 * BLOCK) - BLOCK
    rel = kpos[None, :] - qpos[:, None]
    bias = rel_bias[t5_bucket(rel)].astype(jnp.float32)
    bias = bias.transpose(2, 0, 1).reshape(ATT_KV_HEADS, G, BLOCK, 3 * BLOCK)
    abs_k = (jnp.arange(nb) * BLOCK)[:, None] + kpos[None, :]
    valid = (abs_k >= 0) & (abs_k < S)
    mask = valid[:, None, :] & (jnp.abs(rel) <= WINDOW)[None]
    scale = ATT_HEAD_DIM ** -0.5
    s = jnp.einsum('bnqhgd,bnkhd->bnhgqk', qb, kb).astype(jnp.float32) * scale + bias
    s = jnp.where(mask[None, :, None, None], s, NEG_INF)
    sink_l = sink.astype(jnp.float32).reshape(ATT_KV_HEADS, G)[None, None, :, :, None, None]
    m = jnp.maximum(jnp.max(s, axis=-1, keepdims=True), sink_l)
    p = jnp.exp(s - m)
    denom = jnp.sum(p, axis=-1, keepdims=True) + jnp.exp(sink_l - m)
    o = jnp.einsum('bnhgqk,bnkhd->bnqhgd', (p / denom).astype(vb.dtype), vb)
    return o.reshape(B, S, ATT_WIDTH)


def short_conv(u, w, b):
    L = u.shape[1]
    r = SHORT_CONV // 2
    up = jnp.pad(u, ((0, 0), (r, r), (0, 0)))
    out = b
    for j in range(SHORT_CONV):
        out = out + up[:, j:j + L] * w[j]
    return out


def hyena_filters(L, f_w_in, f_w_mid, f_b, f_freq, f_w_out):
    f32 = jnp.float32
    pos = jnp.arange(L, dtype=f32)
    t = pos / max(L - 1, 1)
    w = 2.0 * math.pi * pos / L
    bands = jnp.linspace(1e-4, FILTER_BANDS - 1, FILTER_BANDS, dtype=f32)
    ang = w[:, None] * bands[None, :]
    z = jnp.concatenate([t[:, None], jnp.cos(ang), -jnp.sin(ang)], axis=-1)
    fb = f_b.astype(f32)
    ff = f_freq.astype(f32)
    h = jnp.sin(ff[0] * (z @ f_w_in.astype(f32) + fb[0]))
    for i in range(FILTER_INNER):
        h = jnp.sin(ff[i + 1] * (h @ f_w_mid[i].astype(f32) + fb[i + 1]))
    h = (h @ f_w_out.astype(f32)).reshape(L, HYENA_ORDER, 2, HYENA_WIDTH)
    max_decay = math.log(DECAY_TARGET) / FAST_DECAY_PCT
    min_decay = math.log(DECAY_TARGET) / SLOW_DECAY_PCT
    deltas = jnp.linspace(min_decay, max_decay, HYENA_WIDTH, dtype=f32)
    h = h * jnp.exp(-t[:, None, None, None] * jnp.abs(deltas))
    fwd, bwd = h[:, :, 0], h[:, :, 1]
    two = jnp.concatenate([fwd[:1] + bwd[:1], fwd[1:], jnp.zeros_like(fwd[:1]), bwd[:0:-1]], axis=0)
    two = two / jnp.sum(jnp.abs(two), axis=0, keepdims=True)
    return jnp.fft.rfft(two, axis=0)


def fft_long_conv(z, filt_f, bias):
    L = z.shape[1]
    zf = jnp.fft.rfft(z.astype(jnp.float32), n=2 * L, axis=1)
    y = jnp.fft.irfft(zf * filt_f[None], n=2 * L, axis=1)[:, :L]
    return (y + z.astype(jnp.float32) * bias.astype(jnp.float32)).astype(z.dtype)


def hyena_mixer(u, conv_w, conv_b, f_w_in, f_w_mid, f_b, f_freq, f_w_out, hyena_bias):
    L = u.shape[1]
    uc = short_conv(u, conv_w, conv_b)
    parts = jnp.split(uc, HYENA_ORDER + 1, axis=-1)
    filt = hyena_filters(L, f_w_in, f_w_mid, f_b, f_freq, f_w_out)
    z = parts[0]
    for o in range(HYENA_ORDER):
        z = parts[o + 1] * fft_long_conv(z, filt[:, o], hyena_bias[o])
    return z


def memory_attention(q, mem, w_mem_kv):
    B, S = q.shape[0], q.shape[1]
    M = mem.shape[1]
    kv = mem @ w_mem_kv
    k = kv[..., :MEM_WIDTH].reshape(B, M, MEM_HEADS, MEM_HEAD_DIM)
    v = kv[..., MEM_WIDTH:].reshape(B, M, MEM_HEADS, MEM_HEAD_DIM)
    qh = q.reshape(B, S, MEM_HEADS, MEM_HEAD_DIM)
    s = jnp.einsum('bshd,bmhd->bhsm', qh, k).astype(jnp.float32) * (MEM_HEAD_DIM ** -0.5)
    p = jax.nn.softmax(s, axis=-1).astype(v.dtype)
    o = jnp.einsum('bhsm,bmhd->bshd', p, v)
    return o.reshape(B, S, MEM_WIDTH)


def peer_ffn(x, w_query, sub_keys, expert_u, expert_v):
    B, S, D = x.shape
    T = B * S
    xb = x.reshape(T // PEER_BLOCK, PEER_BLOCK, D)

    def block(xt):
        q = (xt @ w_query).reshape(PEER_BLOCK, PEER_HEADS, 2, PEER_HALF)
        s = jnp.einsum('thcd,hckd->thck', q, sub_keys).astype(jnp.float32)
        s_top, i_top = lax.top_k(s, PEER_TOPK)
        cand = (s_top[:, :, 0, :, None] + s_top[:, :, 1, None, :]).reshape(PEER_BLOCK, PEER_HEADS, PEER_TOPK * PEER_TOPK)
        cand_idx = (i_top[:, :, 0, :, None] * N_KEYS + i_top[:, :, 1, None, :]).reshape(PEER_BLOCK, PEER_HEADS, PEER_TOPK * PEER_TOPK)
        sc, pos = lax.top_k(cand, PEER_TOPK)
        eidx = jnp.take_along_axis(cand_idx, pos, axis=-1)
        g = jax.nn.softmax(sc, axis=-1)
        u = expert_u[eidx]
        act = jax.nn.gelu(jnp.einsum('thkd,td->thk', u, xt).astype(jnp.float32), approximate=False)
        coef = (g * act).astype(xt.dtype)
        return jnp.einsum('thk,thkd->td', coef, expert_v[eidx])

    return lax.map(block, xb).reshape(B, S, D)


def encoder_layer(x, mem, rel_bias, w_in, b_in, conv_w, conv_b, attn_sink, f_w_in, f_w_mid, f_b, f_freq,
                  f_w_out, hyena_bias, w_mem_kv, w_branch, w_out, ln1_g, ln1_b, w_query, sub_keys,
                  expert_u, expert_v, ln2_g, ln2_b):
    B, S, _ = x.shape
    proj = x @ w_in + b_in
    q_a = proj[..., :O_K].reshape(B, S, ATT_HEADS, ATT_HEAD_DIM)
    k_a = proj[..., O_K:O_V].reshape(B, S, ATT_KV_HEADS, ATT_HEAD_DIM)
    v_a = proj[..., O_V:O_HY].reshape(B, S, ATT_KV_HEADS, ATT_HEAD_DIM)
    hy = proj[..., O_HY:O_MQ]
    q_m = proj[..., O_MQ:O_GATE]
    gates = jax.nn.sigmoid(proj[..., O_GATE:].reshape(B, S, N_BRANCH, D_MODEL))
    branches = (
        window_attention(q_a, k_a, v_a, rel_bias, attn_sink),
        hyena_mixer(hy, conv_w, conv_b, f_w_in, f_w_mid, f_b, f_freq, f_w_out, hyena_bias),
        memory_attention(q_m, mem, w_mem_kv),
    )
    merged = gates[:, :, 0] * (branches[0] @ w_branch[0])
    for n in range(1, N_BRANCH):
        merged = merged + gates[:, :, n] * (branches[n] @ w_branch[n])
    x = layer_norm(ALPHA * x + merged @ w_out, ln1_g, ln1_b)
    x = layer_norm(ALPHA * x + peer_ffn(x, w_query, sub_keys, expert_u, expert_v), ln2_g, ln2_b)
    return x


def setup_inputs(seed: int = 0) -> dict:
    key = jax.random.key(seed)
    ks = jax.random.split(key, 32)
    nrm = jax.random.normal
    f32 = jnp.float32
    D = D_MODEL
    HYW = HYENA_WIDTH
    return {
        'x_prompt': nrm(ks[0], (BATCH, SEQ, D), f32),
        'x_sample': nrm(ks[1], (DEC_BATCH, DEC_SEQ, D), f32),
        'mem_prompt': nrm(ks[2], (BATCH, N_MEM, D), f32),
        'mem_sample': nrm(ks[3], (DEC_BATCH, N_MEM, D), f32),
        'rel_bias': 0.5 * nrm(ks[4], (N_BUCKETS, ATT_HEADS), f32),
        'w_in': nrm(ks[5], (DEPTH, D, IN_WIDTH), f32) * D ** -0.5,
        'b_in': 0.02 * nrm(ks[6], (DEPTH, IN_WIDTH), f32),
        'conv_w': nrm(ks[7], (DEPTH, SHORT_CONV, (HYENA_ORDER + 1) * HYW), f32) * SHORT_CONV ** -0.5,
        'conv_b': 0.02 * nrm(ks[8], (DEPTH, (HYENA_ORDER + 1) * HYW), f32),
        'attn_sink': 0.5 * nrm(ks[9], (DEPTH, ATT_HEADS), f32),
        'f_w_in': nrm(ks[10], (DEPTH, FILTER_EMB, FILTER_HIDDEN), f32) * FILTER_EMB ** -0.5,
        'f_w_mid': nrm(ks[11], (DEPTH, FILTER_INNER, FILTER_HIDDEN, FILTER_HIDDEN), f32) * FILTER_HIDDEN ** -0.5,
        'f_b': 0.1 * nrm(ks[12], (DEPTH, FILTER_INNER + 1, FILTER_HIDDEN), f32),
        'f_freq': 1.0 + 0.05 * nrm(ks[13], (DEPTH, FILTER_INNER + 1, FILTER_HIDDEN), f32),
        'f_w_out': nrm(ks[14], (DEPTH, FILTER_HIDDEN, HYENA_ORDER * 2 * HYW), f32) * FILTER_HIDDEN ** -0.5,
        'hyena_bias': nrm(ks[15], (DEPTH, HYENA_ORDER, HYW), f32),
        'w_mem_kv': nrm(ks[16], (DEPTH, D, 2 * MEM_WIDTH), f32) * D ** -0.5,
        'w_branch': nrm(ks[17], (DEPTH, N_BRANCH, BRANCH_WIDTH, D), f32) * (BETA * BRANCH_WIDTH ** -0.5),
        'w_out': nrm(ks[18], (DEPTH, D, D), f32) * (BETA * D ** -0.5),
        'ln1_g': 1.0 + 0.02 * nrm(ks[19], (DEPTH, D), f32),
        'ln1_b': 0.02 * nrm(ks[20], (DEPTH, D), f32),
        'w_query': nrm(ks[21], (DEPTH, D, PEER_HEADS * PEER_QDIM), f32) * D ** -0.5,
        'sub_keys': nrm(ks[22], (DEPTH, PEER_HEADS, 2, N_KEYS, PEER_HALF), f32) * PEER_HALF ** -0.5,
        'expert_u': nrm(ks[23], (DEPTH, N_EXPERTS, D), f32) * D ** -0.5,
        'expert_v': nrm(ks[24], (DEPTH, N_EXPERTS, D), f32) * (BETA * PEER_HEADS ** -0.5),
        'ln2_g': 1.0 + 0.02 * nrm(ks[25], (DEPTH, D), f32),
        'ln2_b': 0.02 * nrm(ks[26], (DEPTH, D), f32),
    }


def reference(x_prompt, x_sample, mem_prompt, mem_sample, rel_bias, w_in, b_in, conv_w, conv_b, attn_sink,
              f_w_in, f_w_mid, f_b, f_freq, f_w_out, hyena_bias, w_mem_kv, w_branch, w_out, ln1_g, ln1_b,
              w_query, sub_keys, expert_u, expert_v, ln2_g, ln2_b):
    def trunk(x, mem):
        for l in range(DEPTH):
            x = encoder_layer(x, mem, rel_bias, w_in[l], b_in[l], conv_w[l], conv_b[l], attn_sink[l],
                              f_w_in[l], f_w_mid[l], f_b[l], f_freq[l], f_w_out[l], hyena_bias[l],
                              w_mem_kv[l], w_branch[l], w_out[l], ln1_g[l], ln1_b[l], w_query[l],
                              sub_keys[l], expert_u[l], expert_v[l], ln2_g[l], ln2_b[l])
        return x

    y_prompt = trunk(x_prompt, mem_prompt)
    y_sample = trunk(x_sample, mem_sample)
    return (y_prompt, y_sample)
```

```cpp
#include <hip/hip_runtime.h>
#include <hip/hip_cooperative_groups.h>
#include <cstdio>
#include <cmath>
namespace cg = cooperative_groups;

#define HD __host__ __device__ __forceinline__
#define DV __device__ __forceinline__

typedef unsigned short bf16_t;
typedef short bf16x8 __attribute__((ext_vector_type(8)));
typedef float f32x4 __attribute__((ext_vector_type(4)));
typedef unsigned u32x4 __attribute__((ext_vector_type(4)));
typedef unsigned u32x2 __attribute__((ext_vector_type(2)));
typedef _Float16 f16_t;

constexpr int NTH = 512;
constexpr int D = 1024, NSEQ = 3, SEQL = 16384, T = NSEQ * SEQL, DEPTH = 2;
constexpr int N_MEM = 256;
constexpr int IN_WIDTH = 5888, O_K = 512, O_V = 640, O_HY = 768, O_MQ = 2304, O_GATE = 2816;
constexpr int HYW = 512, HY3 = 1536;
constexpr int FEMB = 33, FHID = 64;
constexpr int NEXP = 16384;
constexpr float ALPHA = 1.4142135623730951f;
constexpr float LN_EPS = 1e-5f;

constexpr size_t SZ_WT_IN = (size_t)IN_WIDTH * D * 2, SZ_WT_BR = (size_t)3 * D * 512 * 2, SZ_WT_OUT = (size_t)D * D * 2,
                 SZ_WT_Q = (size_t)2048 * D * 2, SZ_WT_MKV = (size_t)D * D * 2, SZ_SK = (size_t)8 * 2 * 128 * 128 * 2;
constexpr size_t OFF_WT_IN = 0, OFF_WT_BR = OFF_WT_IN + SZ_WT_IN, OFF_WT_OUT = OFF_WT_BR + SZ_WT_BR, OFF_WT_Q = OFF_WT_OUT + SZ_WT_OUT,
                 OFF_WT_MKV = OFF_WT_Q + SZ_WT_Q, OFF_SK = OFF_WT_MKV + SZ_WT_MKV, SZ_WL = OFF_SK + SZ_SK;
constexpr size_t WS_W = 0;
constexpr size_t WS_EXP = WS_W + 2 * SZ_WL;
constexpr size_t SZ_EXP1 = (size_t)NEXP * D * 2;
constexpr size_t WS_XB = WS_EXP + 2 * SZ_EXP1;
constexpr size_t WS_QKV = WS_XB + (size_t)T * D * 2;
constexpr size_t WS_HY = WS_QKV + (size_t)T * 768 * 2;
constexpr size_t WS_MEMB = WS_HY + (size_t)T * HY3 * 2;
constexpr size_t WS_KVMEM = WS_MEMB + (size_t)768 * D * 2;
constexpr size_t WS_H3 = WS_KVMEM + (size_t)2 * 768 * D * 2;
constexpr size_t WS_HSCR = WS_H3 + (size_t)2 * 64 * SEQL * 2;
constexpr int MAX_GRID = 256;
constexpr size_t WS_END = WS_HSCR + (size_t)MAX_GRID * 2 * 8192 * 16;
constexpr size_t DO_UCT = 0, DO_QM = (size_t)NSEQ * HY3 * SEQL * 2;

struct Params {
    const float* in[27];
    float* out;
    unsigned char* ws;
    int ph_lo, ph_hi;
};

HD bf16_t f2bf(float f) {
    unsigned u = __builtin_bit_cast(unsigned, f);
    u += 0x7fffu + ((u >> 16) & 1u);
    return (bf16_t)(u >> 16);
}
HD float bf2f(bf16_t h) { return __builtin_bit_cast(float, (unsigned)h << 16); }
HD unsigned pk2(float lo, float hi) { return (unsigned)f2bf(lo) | ((unsigned)f2bf(hi) << 16); }
HD float bflo(unsigned w) { return __builtin_bit_cast(float, w << 16); }
HD float bfhi(unsigned w) { return __builtin_bit_cast(float, w & 0xffff0000u); }

HD float2 cadd(float2 a, float2 b) { return make_float2(a.x + b.x, a.y + b.y); }
HD float2 csub(float2 a, float2 b) { return make_float2(a.x - b.x, a.y - b.y); }
HD float2 cmul(float2 a, float2 b) { return make_float2(a.x * b.x - a.y * b.y, a.x * b.y + a.y * b.x); }
HD float2 cmulc(float2 a, float2 b) { return make_float2(a.x * b.x + a.y * b.y, a.y * b.x - a.x * b.y); }
HD float2 cconj(float2 a) { return make_float2(a.x, -a.y); }

constexpr int FN = 16384;
HD int PI(int p) { return p + ((p >> 5) << 1); }
constexpr int FBUF_F2 = FN + (FN >> 5) * 2;
HD int fpos(int k) { return ((k & 15) << 10) | (((k >> 4) & 15) << 6) | (((k >> 8) & 3) << 4) | (k >> 10); }
HD int frev(int p) { return (p >> 10) | (((p >> 6) & 15) << 4) | (((p >> 4) & 3) << 8) | ((p & 15) << 10); }

template <bool INV> HD void dft4(float2& a, float2& b, float2& c, float2& d) {
    const float2 t0 = cadd(a, c), t1 = csub(a, c), t2 = cadd(b, d), t3 = csub(b, d);
    a = cadd(t0, t2); c = csub(t0, t2);
    if (!INV) { b = make_float2(t1.x + t3.y, t1.y - t3.x); d = make_float2(t1.x - t3.y, t1.y + t3.x); }
    else      { b = make_float2(t1.x - t3.y, t1.y + t3.x); d = make_float2(t1.x + t3.y, t1.y - t3.x); }
}
template <bool INV> HD void dft16(float2 (&x)[16]) {
    const float C1 = 0.92387953251128674f, S1 = 0.38268343236508977f, R2 = 0.70710678118654752f;
#pragma unroll
    for (int a = 0; a < 4; ++a) dft4<INV>(x[a], x[a + 4], x[a + 8], x[a + 12]);
    const float sg = INV ? 1.f : -1.f;
    x[1 + 4] = cmul(x[1 + 4], make_float2(C1, sg * S1));
    x[1 + 8] = cmul(x[1 + 8], make_float2(R2, sg * R2));
    x[1 + 12] = cmul(x[1 + 12], make_float2(S1, sg * C1));
    x[2 + 4] = cmul(x[2 + 4], make_float2(R2, sg * R2));
    x[2 + 8] = cmul(x[2 + 8], make_float2(0.f, sg * 1.f));
    x[2 + 12] = cmul(x[2 + 12], make_float2(-R2, sg * R2));
    x[3 + 4] = cmul(x[3 + 4], make_float2(S1, sg * C1));
    x[3 + 8] = cmul(x[3 + 8], make_float2(-R2, sg * R2));
    x[3 + 12] = cmul(x[3 + 12], make_float2(-C1, -sg * S1));
#pragma unroll
    for (int b = 0; b < 4; ++b) dft4<INV>(x[4 * b], x[4 * b + 1], x[4 * b + 2], x[4 * b + 3]);
}
HD float2 twid(float frac) {
    float s, c;
#if defined(__HIP_DEVICE_COMPILE__)
    sincospif(2.f * frac, &s, &c);
#else
    s = sinf(6.283185307179586f * frac); c = cosf(6.283185307179586f * frac);
#endif
    return make_float2(c, -s);
}
template <bool INV> HD void fft_bfly16(float2* buf, int bf, int n, int stride) {
    const int blk = bf / stride, j = bf - blk * stride, base = blk * n + j;
    float2 x[16];
#pragma unroll
    for (int m = 0; m < 16; ++m) x[m] = buf[PI(base + m * stride)];
    float2 w1 = make_float2(1.f, 0.f);
    if (stride > 1) w1 = twid((float)j / (float)n);
    if (INV && stride > 1) {
        float2 w = cconj(w1);
        const float2 wc = w;
#pragma unroll
        for (int m = 1; m < 16; ++m) { x[m] = cmul(x[m], w); w = cmul(w, wc); }
    }
    dft16<INV>(x);
    if (!INV && stride > 1) {
        float2 w = w1;
#pragma unroll
        for (int q = 1; q < 16; ++q) { const int s = (q >> 2) + 4 * (q & 3); x[s] = cmul(x[s], w); w = cmul(w, w1); }
    }
#pragma unroll
    for (int q = 0; q < 16; ++q) buf[PI(base + q * stride)] = x[(q >> 2) + 4 * (q & 3)];
}
template <bool INV> HD void fft_bfly4(float2* buf, int bf, int n, int stride) {
    const int blk = bf / stride, j = bf - blk * stride, base = blk * n + j;
    float2 x[4];
#pragma unroll
    for (int m = 0; m < 4; ++m) x[m] = buf[PI(base + m * stride)];
    const float2 w1 = twid((float)j / (float)n);
    if (INV) { const float2 wc = cconj(w1); float2 w = wc;
#pragma unroll
        for (int m = 1; m < 4; ++m) { x[m] = cmul(x[m], w); w = cmul(w, wc); } }
    dft4<INV>(x[0], x[1], x[2], x[3]);
    if (!INV) { float2 w = w1;
#pragma unroll
        for (int q = 1; q < 4; ++q) { x[q] = cmul(x[q], w); w = cmul(w, w1); } }
#pragma unroll
    for (int q = 0; q < 4; ++q) buf[PI(base + q * stride)] = x[q];
}
template <bool INV> HD void fft_pass(float2* buf, int p, int tid) {
    const int pp = INV ? 3 - p : p;
    if (pp == 0) {
#pragma unroll 1
        for (int i = 0; i < 2; ++i) fft_bfly16<INV>(buf, tid + NTH * i, 16384, 1024); }
    else if (pp == 1) {
#pragma unroll 1
        for (int i = 0; i < 2; ++i) fft_bfly16<INV>(buf, tid + NTH * i, 1024, 64); }
    else if (pp == 2) {
#pragma unroll 2
        for (int i = 0; i < 8; ++i) fft_bfly4<INV>(buf, tid + NTH * i, 64, 16); }
    else {
#pragma unroll 1
        for (int i = 0; i < 2; ++i) fft_bfly16<INV>(buf, tid + NTH * i, 16, 1); }
}
struct HPair { float2 hk, hl; };
HD void pair_unpack(float2 ck, float2 cl, float2 w, float2& ak, float2& al) {
    const float2 e = make_float2(0.5f * (ck.x + cl.x), 0.5f * (ck.y - cl.y));
    const float2 dd = make_float2(0.5f * (ck.x - cl.x), 0.5f * (ck.y + cl.y));
    const float2 o = make_float2(dd.y, -dd.x);
    const float2 wo = cmul(w, o);
    ak = cadd(e, wo); al = cconj(csub(e, wo));
}
HD void pair_pack(float2 yk, float2 yl, float2 w, float2& dk, float2& dl) {
    const float2 ye = make_float2(0.5f * (yk.x + yl.x), 0.5f * (yk.y - yl.y));
    const float2 dd = make_float2(0.5f * (yk.x - yl.x), 0.5f * (yk.y + yl.y));
    const float2 yo = cmulc(dd, w);
    dk = make_float2(ye.x - yo.y, ye.y + yo.x);
    dl = make_float2(ye.x + yo.y, -ye.y + yo.x);
}
HD void pair_item_pos(int e, int& p, int& k, int& pl) { p = 16 * (e >> 3) + (e & 7); k = frev(p); pl = fpos((FN - k) & (FN - 1)); }
HD HPair pair_filter(const float2* buf, int e, float sc) {
    int p, k, pl; pair_item_pos(e, p, k, pl);
    HPair h;
    if (e == 0) {
        const float2 c0 = buf[PI(0)], c8 = buf[PI(fpos(FN / 2))];
        h.hk = make_float2((c0.x + c0.y) * sc, (c0.x - c0.y) * sc);
        h.hl = make_float2(c8.x * sc, -c8.y * sc);
        return h;
    }
    const float2 ck = buf[PI(p)], cl = buf[PI(pl)];
    float2 ak, al; pair_unpack(ck, cl, twid((float)k / (float)(2 * FN)), ak, al);
    h.hk = make_float2(ak.x * sc, ak.y * sc); h.hl = make_float2(al.x * sc, al.y * sc);
    return h;
}
HD void pair_apply(float2* buf, int e, const HPair& h) {
    int p, k, pl; pair_item_pos(e, p, k, pl);
    if (e == 0) {
        const float2 c0 = buf[PI(0)];
        const float y0 = (c0.x + c0.y) * h.hk.x, yL = (c0.x - c0.y) * h.hk.y;
        buf[PI(0)] = make_float2(0.5f * (y0 + yL), 0.5f * (y0 - yL));
        const int p8 = fpos(FN / 2);
        const float2 c8 = buf[PI(p8)];
        const float2 y8 = cmul(cconj(c8), h.hl);
        buf[PI(p8)] = cconj(y8);
        return;
    }
    const float2 ck = buf[PI(p)], cl = buf[PI(pl)];
    const float2 w = twid((float)k / (float)(2 * FN));
    float2 ak, al; pair_unpack(ck, cl, w, ak, al);
    const float2 yk = cmul(ak, h.hk), yl = cmul(al, h.hl);
    float2 dk, dl; pair_pack(yk, yl, w, dk, dl);
    buf[PI(p)] = dk; buf[PI(pl)] = dl;
}
HD int fidx(int n) { return PI(n >> 1) * 2 + (n & 1); }

HD int t5_bucket(int rel) {
    const int n = rel < 0 ? -rel : rel;
    int b = rel > 0 ? 16 : 0;
    if (n < 8) return b + n;
    int nn = n * n, lg = 0;
    while ((nn >> (lg + 1)) != 0) ++lg;
    int large = lg + 2;
    if (large > 15) large = 15;
    return b + large;
}

#define LAS __attribute__((address_space(3)))
#define GAS __attribute__((address_space(1)))
typedef const Params __attribute__((address_space(4)))* KParams;
DV KParams kparams() { KParams kp = (KParams)__builtin_amdgcn_kernarg_segment_ptr(); asm volatile("" : "+s"(kp)); return kp; }
DV int tid_() { int v = threadIdx.x; asm volatile("" : "+v"(v)); return v; }
DV float wave_sum(float v) {
#pragma unroll
    for (int o = 1; o < 64; o <<= 1) v += __shfl_xor(v, o);
    return v;
}
DV float wave_max(float v) {
#pragma unroll
    for (int o = 1; o < 64; o <<= 1) v = fmaxf(v, __shfl_xor(v, o));
    return v;
}
DV void glds16(const void* g, void* l) {
    __builtin_amdgcn_global_load_lds((const GAS unsigned*)g, (LAS unsigned*)l, 16, 0, 0);
}
DV u32x4 ldg16(const void* p) { return *(const u32x4*)p; }
DV void stg16(void* p, u32x4 v) { *(u32x4*)p = v; }

DV void cvt_job(const float* src, bf16_t* dst, size_t n, int bid, int nblk) {
    const size_t n8 = n / 8;
    for (size_t i = (size_t)bid * NTH + tid_(); i < n8; i += (size_t)nblk * NTH) {
        const f32x4 a = *(const f32x4*)(src + i * 8), b = *(const f32x4*)(src + i * 8 + 4);
        u32x4 o; o.x = pk2(a.x, a.y); o.y = pk2(a.z, a.w); o.z = pk2(b.x, b.y); o.w = pk2(b.z, b.w);
        stg16(dst + i * 8, o);
    }
}
DV void transpose_item(const float* W, int K, int N, bf16_t* WT, int item, float* s  ) {
    const int ntn = N / 64, kb = item / ntn, nb = item - kb * ntn, k0 = kb * 64, n0 = nb * 64, tid = tid_();
    __syncthreads();
#pragma unroll
    for (int i = 0; i < 8; ++i) { const int idx = tid + i * NTH, r = idx >> 6, c = idx & 63; s[r * 65 + c] = W[(size_t)(k0 + r) * N + n0 + c]; }
    __syncthreads();
#pragma unroll
    for (int i = 0; i < 4; ++i) { const int idx = tid + i * NTH, n = idx >> 5, kp = idx & 31;
        *(unsigned*)(WT + (size_t)(n0 + n) * K + k0 + 2 * kp) = pk2(s[(2 * kp) * 65 + n], s[(2 * kp + 1) * 65 + n]); }
}
DV void transpose_job(const float* W, int K, int N, bf16_t* WT, int bid, int nblk, float* s) {
    const int items = (K / 64) * (N / 64);
    for (int it = bid; it < items; it += nblk) transpose_item(W, K, N, WT, it, s);
}
DV void filter_mlp_job(KParams p, int bid, int nblk) {
    const int lane = tid_() & 63, wv = tid_() >> 6;
    f16_t* h3 = (f16_t*)(p->ws + WS_H3);
    for (int it = bid * 8 + wv; it < DEPTH * SEQL; it += nblk * 8) {
        const int l = it / SEQL, pos = it - l * SEQL;
        const float* w_in = p->in[10] + (size_t)l * FEMB * FHID;
        const float* w_mid = p->in[11] + (size_t)l * 2 * FHID * FHID;
        const float* fb = p->in[12] + (size_t)l * 3 * FHID;
        const float* ff = p->in[13] + (size_t)l * 3 * FHID;
        const float tt = (float)pos / (float)(SEQL - 1);
        const float wang = 6.283185307179586f * (float)pos / (float)SEQL;
        float zf = 0.f;
        if (lane == 0) zf = tt;
        else if (lane < 33) { const int bi = (lane - 1) & 15; const float band = 1e-4f + (float)bi * ((15.f - 1e-4f) / 15.f); const float ang = wang * band;
            zf = lane <= 16 ? cosf(ang) : -sinf(ang); }
        float acc = 0.f;
#pragma unroll
        for (int i = 0; i < FEMB; ++i) acc += __shfl(zf, i) * w_in[i * FHID + lane];
        float h = sinf(ff[lane] * (acc + fb[lane]));
#pragma unroll
        for (int q = 0; q < 2; ++q) {
            float a2 = 0.f;
#pragma unroll
            for (int i = 0; i < FHID; ++i) a2 += __shfl(h, i) * w_mid[(q * FHID + i) * FHID + lane];
            h = sinf(ff[(q + 1) * FHID + lane] * (a2 + fb[(q + 1) * FHID + lane]));
        }
        h3[((size_t)l * FHID + lane) * SEQL + pos] = (f16_t)h;
    }
}

constexpr int G_BM = 256, G_BN = 128, G_BK = 32;
constexpr int G_ABYTES = G_BM * G_BK * 2, G_BBYTES = G_BN * G_BK * 2, G_STAGE = G_ABYTES + G_BBYTES;
constexpr int G_LDS = 2 * G_STAGE;
DV void gemm_stage(const bf16_t* A, int lda, const bf16_t* Bt, int ldb, int kt, unsigned char* sbuf) {
    const int tid = tid_();
#pragma unroll
    for (int i = 0; i < 2; ++i) { const int b = tid * 16 + i * 8192, r = b >> 6, c = (b & 63) >> 1;
        glds16(A + (size_t)r * lda + kt * G_BK + c, sbuf + b); }
    { const int b = tid * 16, r = b >> 6, c = (b & 63) >> 1;
        glds16(Bt + (size_t)r * ldb + kt * G_BK + c, sbuf + G_ABYTES + b); }
}
DV void gemm_kloop(f32x4 (&acc)[4][4], const bf16_t* A, int lda, const bf16_t* Bt, int ldb, int nk, unsigned char* smem) {
    const int lane = tid_() & 63, wid = tid_() >> 6, wr = wid >> 1, wc = wid & 1, fr = lane & 15, fq = lane >> 4;
    __syncthreads();
    gemm_stage(A, lda, Bt, ldb, 0, smem);
#pragma unroll 1
    for (int t = 0; t < nk; ++t) {
        unsigned char* cur = smem + (t & 1) * G_STAGE;
        asm volatile("s_waitcnt vmcnt(0)" ::: "memory");
        __syncthreads();
        if (t + 1 < nk) gemm_stage(A, lda, Bt, ldb, t + 1, smem + ((t + 1) & 1) * G_STAGE);
        bf16x8 a[4], b[4];
#pragma unroll
        for (int m = 0; m < 4; ++m) a[m] = *(const bf16x8*)(cur + (wr * 64 + m * 16 + fr) * 64 + fq * 16);
#pragma unroll
        for (int n = 0; n < 4; ++n) b[n] = *(const bf16x8*)(cur + G_ABYTES + (wc * 64 + n * 16 + fr) * 64 + fq * 16);
#pragma unroll
        for (int m = 0; m < 4; ++m)
#pragma unroll
            for (int n = 0; n < 4; ++n) acc[m][n] = __builtin_amdgcn_mfma_f32_16x16x32_bf16(b[n], a[m], acc[m][n], 0, 0, 0);
    }
}
DV void acc_zero(f32x4 (&acc)[4][4]) {
#pragma unroll
    for (int m = 0; m < 4; ++m)
#pragma unroll
        for (int n = 0; n < 4; ++n) acc[m][n] = (f32x4){0.f, 0.f, 0.f, 0.f};
}
struct TileCoord { int row0, col0, wr, wc, fr, fq; };
DV TileCoord tile_coord(int pm, int pn) {
    const int lane = tid_() & 63, wid = tid_() >> 6;
    TileCoord c; c.row0 = pm * G_BM; c.col0 = pn * G_BN; c.wr = wid >> 1; c.wc = wid & 1; c.fr = lane & 15; c.fq = lane >> 4; return c;
}
DV void epi_store_bf16(const f32x4 (&acc)[4][4], const TileCoord& c, bf16_t* O, int ldo, int ocol0, const float* bias  ) {
#pragma unroll
    for (int n = 0; n < 4; ++n) {
        const int cl = c.wc * 64 + n * 16 + c.fq * 4;
        f32x4 bv = (f32x4){0.f, 0.f, 0.f, 0.f};
        if (bias) bv = *(const f32x4*)(bias + cl);
#pragma unroll
        for (int m = 0; m < 4; ++m) {
            const int row = c.row0 + c.wr * 64 + m * 16 + c.fr;
            const f32x4 v = acc[m][n] + bv;
            u32x2 o; o.x = pk2(v.x, v.y); o.y = pk2(v.z, v.w);
            *(u32x2*)(O + (size_t)row * ldo + ocol0 + cl) = o;
        }
    }
}

DV void gemm1_tile(KParams p, int l, int tile, unsigned char* smem) {
    const int npn = O_GATE / G_BN;
    const int pm = tile / npn, pn = tile - pm * npn;
    const TileCoord c = tile_coord(pm, pn);
    const bf16_t* xb = (const bf16_t*)(p->ws + WS_XB);
    const bf16_t* wt = (const bf16_t*)(p->ws + WS_W + l * SZ_WL + OFF_WT_IN);
    f32x4 acc[4][4]; acc_zero(acc);
    gemm_kloop(acc, xb + (size_t)c.row0 * D, D, wt + (size_t)c.col0 * D, D, D / G_BK, smem);
    const float* bias = p->in[6] + (size_t)l * IN_WIDTH + c.col0;
    bf16_t* O; int ldo, oc;
    if (c.col0 < O_HY) { O = (bf16_t*)(p->ws + WS_QKV); ldo = 768; oc = c.col0; }
    else if (c.col0 < O_MQ) { O = (bf16_t*)(p->ws + WS_HY); ldo = HY3; oc = c.col0 - O_HY; }
    else { O = (bf16_t*)((unsigned char*)p->out + DO_QM); ldo = 512; oc = c.col0 - O_MQ; }
    epi_store_bf16(acc, c, O, ldo, oc, bias);
}
DV void kvmem_tile(KParams p, int tile, unsigned char* smem) {
    const int l = tile / 24, r = tile - l * 24, pm = r / 8, pn = r - pm * 8;
    const TileCoord c = tile_coord(pm, pn);
    const bf16_t* A = (const bf16_t*)(p->ws + WS_MEMB);
    const bf16_t* wt = (const bf16_t*)(p->ws + WS_W + l * SZ_WL + OFF_WT_MKV);
    f32x4 acc[4][4]; acc_zero(acc);
    gemm_kloop(acc, A + (size_t)c.row0 * D, D, wt + (size_t)c.col0 * D, D, D / G_BK, smem);
    epi_store_bf16(acc, c, (bf16_t*)(p->ws + WS_KVMEM) + (size_t)l * 768 * D, D, c.col0, nullptr);
}
DV void merge_tile(KParams p, int l, int tile, unsigned char* smem) {
    const int npn = D / G_BN;
    const int pm = tile / npn, pn = tile - pm * npn;
    const TileCoord c = tile_coord(pm, pn);
    const bf16_t* xb = (const bf16_t*)(p->ws + WS_XB);
    const bf16_t* wt_in = (const bf16_t*)(p->ws + WS_W + l * SZ_WL + OFF_WT_IN);
    const bf16_t* wt_br = (const bf16_t*)(p->ws + WS_W + l * SZ_WL + OFF_WT_BR);
    u32x2* mlds = (u32x2*)(smem + G_LDS) + (tid_() >> 6) * 1024 + (tid_() & 63);
#pragma unroll 1
    for (int n = 0; n < 3; ++n) {
        unsigned gp[4][4][2];
        {
            f32x4 ga[4][4]; acc_zero(ga);
            gemm_kloop(ga, xb + (size_t)c.row0 * D, D, wt_in + (size_t)(O_GATE + n * D + c.col0) * D, D, D / G_BK, smem);
            const float* bias = p->in[6] + (size_t)l * IN_WIDTH + O_GATE + n * D + c.col0;
#pragma unroll
            for (int nn = 0; nn < 4; ++nn) {
                const f32x4 bv = *(const f32x4*)(bias + c.wc * 64 + nn * 16 + c.fq * 4);
#pragma unroll
                for (int m = 0; m < 4; ++m) {
                    const f32x4 v = ga[m][nn] + bv;
                    const float s0 = 1.f / (1.f + __expf(-v.x)), s1 = 1.f / (1.f + __expf(-v.y)), s2 = 1.f / (1.f + __expf(-v.z)), s3 = 1.f / (1.f + __expf(-v.w));
                    gp[m][nn][0] = pk2(s0, s1); gp[m][nn][1] = pk2(s2, s3);
                }
            }
        }
        const bf16_t* A; int lda;
        if (n == 0) { A = (const bf16_t*)(p->ws + WS_QKV); lda = 768; }
        else if (n == 1) { A = (const bf16_t*)(p->ws + WS_HY); lda = 512; }
        else { A = (const bf16_t*)((unsigned char*)p->out + DO_QM); lda = 512; }
        f32x4 ba[4][4]; acc_zero(ba);
        gemm_kloop(ba, A + (size_t)c.row0 * lda, lda, wt_br + (size_t)(n * D + c.col0) * 512, 512, 512 / G_BK, smem);
#pragma unroll
        for (int m = 0; m < 4; ++m)
#pragma unroll
            for (int nn = 0; nn < 4; ++nn) {
                f32x4 v;
                v.x = bflo(gp[m][nn][0]) * ba[m][nn].x; v.y = bfhi(gp[m][nn][0]) * ba[m][nn].y;
                v.z = bflo(gp[m][nn][1]) * ba[m][nn].z; v.w = bfhi(gp[m][nn][1]) * ba[m][nn].w;
                if (n > 0) { const u32x2 pv = mlds[(m * 4 + nn) * 64]; v.x += bflo(pv.x); v.y += bfhi(pv.x); v.z += bflo(pv.y); v.w += bfhi(pv.y); }
                u32x2 o; o.x = pk2(v.x, v.y); o.y = pk2(v.z, v.w);
                if (n < 2) mlds[(m * 4 + nn) * 64] = o;
                else { const int row = c.row0 + c.wr * 64 + m * 16 + c.fr, col = c.col0 + c.wc * 64 + nn * 16 + c.fq * 4;
                       *(u32x2*)((bf16_t*)(p->ws + WS_HY) + (size_t)T * 512 + (size_t)row * D + col) = o; }
            }
    }
}
DV void outproj_tile(KParams p, int l, int tile, unsigned char* smem) {
    const int npn = D / G_BN;
    const int pm = tile / npn, pn = tile - pm * npn;
    const TileCoord c = tile_coord(pm, pn);
    const bf16_t* A = (const bf16_t*)(p->ws + WS_HY) + (size_t)T * 512;
    const bf16_t* wt = (const bf16_t*)(p->ws + WS_W + l * SZ_WL + OFF_WT_OUT);
    const bf16_t* xb = (const bf16_t*)(p->ws + WS_XB);
    f32x4 acc[4][4]; acc_zero(acc);
    gemm_kloop(acc, A + (size_t)c.row0 * D, D, wt + (size_t)c.col0 * D, D, D / G_BK, smem);
#pragma unroll
    for (int n = 0; n < 4; ++n) {
        const int col = c.col0 + c.wc * 64 + n * 16 + c.fq * 4;
#pragma unroll
        for (int m = 0; m < 4; ++m) {
            const int row = c.row0 + c.wr * 64 + m * 16 + c.fr;
            const u32x2 xv = *(const u32x2*)(xb + (size_t)row * D + col);
            f32x4 v = acc[m][n];
            v.x += ALPHA * bflo(xv.x); v.y += ALPHA * bfhi(xv.x); v.z += ALPHA * bflo(xv.y); v.w += ALPHA * bfhi(xv.y);
            *(f32x4*)(p->out + (size_t)row * D + col) = v;
        }
    }
}
DV void qpeer_tile(KParams p, int l, int tile, unsigned char* smem) {
    const int npn = 2048 / G_BN;
    const int pm = tile / npn, pn = tile - pm * npn;
    const TileCoord c = tile_coord(pm, pn);
    const bf16_t* A = (const bf16_t*)(p->ws + WS_XB);
    const bf16_t* wt = (const bf16_t*)(p->ws + WS_W + l * SZ_WL + OFF_WT_Q);
    f32x4 acc[4][4]; acc_zero(acc);
    gemm_kloop(acc, A + (size_t)c.row0 * D, D, wt + (size_t)c.col0 * D, D, D / G_BK, smem);
    epi_store_bf16(acc, c, (bf16_t*)p->out, 2048, c.col0, nullptr);
}
DV void ln1_job(KParams p, int l, int bid, int nblk) {
    const int lane = tid_() & 63, wv = tid_() >> 6;
    const float* g = p->in[19] + (size_t)l * D; const float* b = p->in[20] + (size_t)l * D;
    bf16_t* xb = (bf16_t*)(p->ws + WS_XB);
    for (int row = bid * 8 + wv; row < T; row += nblk * 8) {
        const float* xr = p->out + (size_t)row * D;
        f32x4 v[4]; float s = 0.f;
#pragma unroll
        for (int j = 0; j < 4; ++j) { v[j] = *(const f32x4*)(xr + lane * 4 + 256 * j); s += (v[j].x + v[j].y) + (v[j].z + v[j].w); }
        const float mean = wave_sum(s) * (1.f / D); float s2 = 0.f;
#pragma unroll
        for (int j = 0; j < 4; ++j) { v[j] = v[j] - mean; s2 += (v[j].x * v[j].x + v[j].y * v[j].y) + (v[j].z * v[j].z + v[j].w * v[j].w); }
        const float rstd = rsqrtf(wave_sum(s2) * (1.f / D) + LN_EPS);
#pragma unroll
        for (int j = 0; j < 4; ++j) {
            const f32x4 gg = *(const f32x4*)(g + lane * 4 + 256 * j), bb = *(const f32x4*)(b + lane * 4 + 256 * j);
            const f32x4 y = v[j] * rstd * gg + bb;
            u32x2 o; o.x = pk2(y.x, y.y); o.y = pk2(y.z, y.w);
            *(u32x2*)(xb + (size_t)row * D + lane * 4 + 256 * j) = o;
        }
    }
}
DV void shortconv_item(KParams p, int l, int item, float* s  ) {
    const int tid = tid_();
    const int ct = item % 24, r = item / 24, tt = r % 256, seq = r / 256;
    const int t0 = tt * 64, c0 = ct * 64;
    const bf16_t* hy = (const bf16_t*)(p->ws + WS_HY);
    bf16_t* uct = (bf16_t*)((unsigned char*)p->out + DO_UCT);
    __syncthreads();
    for (int idx = tid; idx < 66 * 8; idx += NTH) {
        const int rr = idx >> 3, ch = idx & 7, t = t0 + rr - 1;
        u32x4 v = (u32x4){0u, 0u, 0u, 0u};
        if (t >= 0 && t < SEQL) v = ldg16(hy + ((size_t)seq * SEQL + t) * HY3 + c0 + ch * 8);
        float* d = s + rr * 65 + ch * 8;
        d[0] = bflo(v.x); d[1] = bfhi(v.x); d[2] = bflo(v.y); d[3] = bfhi(v.y); d[4] = bflo(v.z); d[5] = bfhi(v.z); d[6] = bflo(v.w); d[7] = bfhi(v.w);
    }
    __syncthreads();
    const int ch = tid >> 3, tq = tid & 7, cg = c0 + ch;
    const float* cw = p->in[7] + (size_t)l * 3 * HY3; const float cb = p->in[8][(size_t)l * HY3 + cg];
    const float w0 = cw[cg], w1 = cw[HY3 + cg], w2 = cw[2 * HY3 + cg];
    float o[8];
#pragma unroll
    for (int e = 0; e < 8; ++e) { const int rr = tq * 8 + e; o[e] = cb + w0 * s[rr * 65 + ch] + w1 * s[(rr + 1) * 65 + ch] + w2 * s[(rr + 2) * 65 + ch]; }
    u32x4 ov; ov.x = pk2(o[0], o[1]); ov.y = pk2(o[2], o[3]); ov.z = pk2(o[4], o[5]); ov.w = pk2(o[6], o[7]);
    stg16(uct + ((size_t)seq * HY3 + cg) * SEQL + t0 + tq * 8, ov);
}
DV void hyo_transpose_item(KParams p, int item, bf16_t* s  ) {
    const int tid = tid_();
    const int ct = item % 8, r = item / 8, tt = r % 256, seq = r / 256;
    const int t0 = tt * 64, c0 = ct * 64;
    const bf16_t* uct = (const bf16_t*)((unsigned char*)p->out + DO_UCT);
    bf16_t* hyo = (bf16_t*)(p->ws + WS_HY);
    __syncthreads();
    { const int ch = tid >> 3, tq = tid & 7;
      const u32x4 v = ldg16(uct + ((size_t)seq * HY3 + c0 + ch) * SEQL + t0 + tq * 8);
      *(u32x4*)(s + ch * 72 + tq * 8) = v; }
    __syncthreads();
    { const int t = tid >> 3, cq = tid & 7;
      bf16_t e[8];
#pragma unroll
      for (int i = 0; i < 8; ++i) e[i] = s[(cq * 8 + i) * 72 + t];
      u32x4 o; o.x = e[0] | ((unsigned)e[1] << 16); o.y = e[2] | ((unsigned)e[3] << 16); o.z = e[4] | ((unsigned)e[5] << 16); o.w = e[6] | ((unsigned)e[7] << 16);
      stg16(hyo + ((size_t)seq * SEQL + t0 + t) * 512 + c0 + cq * 8, o); }
}

template <bool WIN> struct AttnCfg {
    static constexpr int HDIM = WIN ? 64 : 128, NK = WIN ? 384 : 256, QT = WIN ? 4 : 2, KS = HDIM / 32, DT = HDIM / 16;
    static constexpr int KSTR = HDIM + 8, VSTR = NK + 8;
    static constexpr int K_BYTES = NK * KSTR * 2, V_BYTES = HDIM * VSTR * 2;
};
template <bool WIN> DV void attn_item(KParams p, int l, int item, unsigned char* smem) {
    typedef AttnCfg<WIN> C;
    const int tid = tid_(), lane = tid & 63, w = tid >> 6, fr = lane & 15, fq = lane >> 4;
    bf16_t* Ks = (bf16_t*)smem; bf16_t* Vt = (bf16_t*)(smem + C::K_BYTES); float* biasT = (float*)(smem + C::K_BYTES + C::V_BYTES);
    int seq, blk, hh;
    if (WIN) { hh = item & 1; blk = (item >> 1) & 127; seq = item >> 8; }
    else { hh = item & 3; blk = (item >> 2) % 64; seq = (item >> 2) / 64; }
    __syncthreads();
    if (WIN) {
        const bf16_t* qkv = (const bf16_t*)(p->ws + WS_QKV);
#pragma unroll 2
        for (int i = 0; i < 6; ++i) {
            const int idx = tid + i * NTH, key = idx >> 3, ch = idx & 7, pos = blk * 128 - 128 + key;
            u32x4 kv = (u32x4){0u, 0u, 0u, 0u}, vv = kv;
            if (pos >= 0 && pos < SEQL) { const bf16_t* row = qkv + ((size_t)seq * SEQL + pos) * 768; kv = ldg16(row + O_K + hh * 64 + ch * 8); vv = ldg16(row + O_V + hh * 64 + ch * 8); }
            *(u32x4*)(Ks + key * C::KSTR + ch * 8) = kv;
            bf16_t* vd = Vt + (ch * 8) * C::VSTR + key;
            vd[0] = (bf16_t)vv.x; vd[C::VSTR] = (bf16_t)(vv.x >> 16); vd[2 * C::VSTR] = (bf16_t)vv.y; vd[3 * C::VSTR] = (bf16_t)(vv.y >> 16);
            vd[4 * C::VSTR] = (bf16_t)vv.z; vd[5 * C::VSTR] = (bf16_t)(vv.z >> 16); vd[6 * C::VSTR] = (bf16_t)vv.w; vd[7 * C::VSTR] = (bf16_t)(vv.w >> 16);
        }
        for (int i = tid; i < 4 * 257; i += NTH) { const int g = i / 257, r = i - g * 257; biasT[i] = p->in[4][t5_bucket(r - 128) * 8 + hh * 4 + g]; }
    } else {
        const bf16_t* kvm = (const bf16_t*)(p->ws + WS_KVMEM) + (size_t)l * 768 * D;
#pragma unroll 2
        for (int i = 0; i < 8; ++i) {
            const int idx = tid + i * NTH, key = idx >> 4, ch = idx & 15;
            const bf16_t* row = kvm + ((size_t)seq * N_MEM + key) * D;
            const u32x4 kv = ldg16(row + hh * 128 + ch * 8), vv = ldg16(row + 512 + hh * 128 + ch * 8);
            *(u32x4*)(Ks + key * C::KSTR + ch * 8) = kv;
            bf16_t* vd = Vt + (ch * 8) * C::VSTR + key;
            vd[0] = (bf16_t)vv.x; vd[C::VSTR] = (bf16_t)(vv.x >> 16); vd[2 * C::VSTR] = (bf16_t)vv.y; vd[3 * C::VSTR] = (bf16_t)(vv.y >> 16);
            vd[4 * C::VSTR] = (bf16_t)vv.z; vd[5 * C::VSTR] = (bf16_t)(vv.z >> 16); vd[6 * C::VSTR] = (bf16_t)vv.w; vd[7 * C::VSTR] = (bf16_t)(vv.w >> 16);
        }
    }
    bf16_t* qbase; int ldq, qcol0, wrow0; size_t tok0; float sink = 0.f; int g = 0;
    if (WIN) { g = w >> 1; qbase = (bf16_t*)(p->ws + WS_QKV); ldq = 768; qcol0 = (hh * 4 + g) * 64; wrow0 = (w & 1) * 64; tok0 = (size_t)seq * SEQL + blk * 128;
               sink = p->in[9][(size_t)l * 8 + hh * 4 + g]; }
    else { qbase = (bf16_t*)((unsigned char*)p->out + DO_QM); ldq = 512; qcol0 = hh * 128; wrow0 = w * 32; tok0 = (size_t)seq * SEQL + blk * 256; }
    bf16x8 bq[C::QT][C::KS];
#pragma unroll
    for (int qt = 0; qt < C::QT; ++qt)
#pragma unroll
        for (int ks = 0; ks < C::KS; ++ks) bq[qt][ks] = *(const bf16x8*)(qbase + (tok0 + wrow0 + qt * 16 + fr) * ldq + qcol0 + ks * 32 + fq * 8);
    f32x4 o[C::QT][C::DT]; float m[C::QT], ls[C::QT];
#pragma unroll
    for (int qt = 0; qt < C::QT; ++qt) { m[qt] = WIN ? sink : -1e30f; ls[qt] = (WIN && fq == 0) ? 1.f : 0.f;
#pragma unroll
        for (int dt = 0; dt < C::DT; ++dt) o[qt][dt] = (f32x4){0.f, 0.f, 0.f, 0.f}; }
    const float scale = WIN ? 0.125f : 0.08838834764831845f;
    __syncthreads();
#pragma unroll 1
    for (int kc = 0; kc < C::NK / 32; ++kc) {
        bf16x8 ak[2][C::KS];
#pragma unroll
        for (int kt = 0; kt < 2; ++kt)
#pragma unroll
            for (int ks = 0; ks < C::KS; ++ks) ak[kt][ks] = *(const bf16x8*)(Ks + (kc * 32 + kt * 16 + fr) * C::KSTR + ks * 32 + fq * 8);
        bf16x8 av[C::DT];
#pragma unroll
        for (int dt = 0; dt < C::DT; ++dt) {
            const u32x2 v0 = *(const u32x2*)(Vt + (dt * 16 + fr) * C::VSTR + kc * 32 + fq * 4), v1 = *(const u32x2*)(Vt + (dt * 16 + fr) * C::VSTR + kc * 32 + 16 + fq * 4);
            u32x4 vv; vv.x = v0.x; vv.y = v0.y; vv.z = v1.x; vv.w = v1.y; av[dt] = __builtin_bit_cast(bf16x8, vv);
        }
#pragma unroll
        for (int qt = 0; qt < C::QT; ++qt) {
            const int r0 = wrow0 + qt * 16;
            if (WIN && !(kc * 32 + 31 >= r0 && kc * 32 <= r0 + 271)) continue;
            f32x4 s0 = (f32x4){0.f, 0.f, 0.f, 0.f}, s1 = s0;
#pragma unroll
            for (int ks = 0; ks < C::KS; ++ks) { s0 = __builtin_amdgcn_mfma_f32_16x16x32_bf16(ak[0][ks], bq[qt][ks], s0, 0, 0, 0); s1 = __builtin_amdgcn_mfma_f32_16x16x32_bf16(ak[1][ks], bq[qt][ks], s1, 0, 0, 0); }
            float sv[8];
#pragma unroll
            for (int e = 0; e < 8; ++e) {
                const float raw = (e < 4 ? s0[e & 3] : s1[e & 3]) * scale;
                if (WIN) {
                    const int jk = kc * 32 + (e >> 2) * 16 + fq * 4 + (e & 3), qi = r0 + fr, rel = jk - qi, pos = blk * 128 - 128 + jk;
                    const bool ok = (rel >= 0) && (rel <= 256) && (pos >= 0) && (pos < SEQL);
                    const int ri = rel < 0 ? 0 : (rel > 256 ? 256 : rel);
                    sv[e] = ok ? raw + biasT[g * 257 + ri] : -1e30f;
                } else sv[e] = raw;
            }
            float cm = fmaxf(fmaxf(fmaxf(sv[0], sv[1]), fmaxf(sv[2], sv[3])), fmaxf(fmaxf(sv[4], sv[5]), fmaxf(sv[6], sv[7])));
            cm = fmaxf(cm, __shfl_xor(cm, 16)); cm = fmaxf(cm, __shfl_xor(cm, 32));
            const float mn = fmaxf(m[qt], cm), al = __expf(m[qt] - mn);
            m[qt] = mn;
            float ps = 0.f; float pe[8];
#pragma unroll
            for (int e = 0; e < 8; ++e) { pe[e] = __expf(sv[e] - mn); ps += pe[e]; }
            ls[qt] = ls[qt] * al + ps;
            u32x4 pw; pw.x = pk2(pe[0], pe[1]); pw.y = pk2(pe[2], pe[3]); pw.z = pk2(pe[4], pe[5]); pw.w = pk2(pe[6], pe[7]);
            const bf16x8 pf = __builtin_bit_cast(bf16x8, pw);
#pragma unroll
            for (int dt = 0; dt < C::DT; ++dt) { o[qt][dt] = o[qt][dt] * al; o[qt][dt] = __builtin_amdgcn_mfma_f32_16x16x32_bf16(av[dt], pf, o[qt][dt], 0, 0, 0); }
        }
    }
#pragma unroll
    for (int qt = 0; qt < C::QT; ++qt) {
        float lt = ls[qt]; lt += __shfl_xor(lt, 16); lt += __shfl_xor(lt, 32);
        const float inv = 1.f / lt;
#pragma unroll
        for (int dt = 0; dt < C::DT; ++dt) {
            const f32x4 v = o[qt][dt] * inv;
            u32x2 ov; ov.x = pk2(v.x, v.y); ov.y = pk2(v.z, v.w);
            *(u32x2*)(qbase + (tok0 + wrow0 + qt * 16 + fr) * ldq + qcol0 + dt * 16 + fq * 4) = ov;
        }
    }
}
constexpr int ATT_LDS_WIN = AttnCfg<true>::K_BYTES + AttnCfg<true>::V_BYTES + 4 * 257 * 4;
constexpr int ATT_LDS_MEM = AttnCfg<false>::K_BYTES + AttnCfg<false>::V_BYTES;

constexpr int FBUF_BYTES = FBUF_F2 * 8;
constexpr int HY_LDS = FBUF_BYTES + 128 * 4 + 16 * 4;
typedef _Float16 h2_t __attribute__((ext_vector_type(2)));
DV HPair unpackH(u32x2 v) {
    const h2_t a = __builtin_bit_cast(h2_t, v.x), b = __builtin_bit_cast(h2_t, v.y);
    const float sc = 1.f / (float)FN;
    HPair h; h.hk = make_float2((float)a.x * sc, (float)a.y * sc); h.hl = make_float2((float)b.x * sc, (float)b.y * sc); return h;
}
DV int opaque(int v) { asm volatile("" : "+v"(v)); return v; }
DV void fft_fwd_all(float2* buf, int tid) {
#pragma unroll 1
    for (int ps = 0; ps < 4; ++ps) { fft_pass<false>(buf, ps, opaque(tid)); __syncthreads(); }
}
DV void fft_inv_all(float2* buf, int tid) {
#pragma unroll 1
    for (int ps = 0; ps < 4; ++ps) { fft_pass<true>(buf, ps, opaque(tid)); __syncthreads(); }
}
DV void hyena_item(KParams p, int l, int c, unsigned char* smem) {
    const int tid = tid_(), lane = tid & 63, w = tid >> 6;
    float2* buf = (float2*)smem; float* fbuf = (float*)smem;
    float* wo = (float*)(smem + FBUF_BYTES); float* red = wo + 128;
    const f16_t* h3 = (const f16_t*)(p->ws + WS_H3) + (size_t)l * FHID * SEQL;
    const float* fwo = p->in[14] + (size_t)l * FHID * 2048;
    const float min_decay = -3.0701134573253945f, max_decay = -15.350567286626972f;
    const float delta = fabsf(min_decay + (float)c * ((max_decay - min_decay) / 511.f));
    f32x4* Hs = (f32x4*)(p->ws + WS_HSCR) + (size_t)blockIdx.x * 2 * 8192;
    __syncthreads();
#pragma unroll 1
    for (int o = 0; o < 2; ++o) {
        if (tid < 128) { const int dir = tid >> 6, j = tid & 63; wo[tid] = fwo[(size_t)j * 2048 + o * 1024 + dir * 512 + c]; }
        __syncthreads();
        float asum = 0.f;
#pragma unroll 1
        for (int i = 0; i < 4; ++i) {
            const int pos0 = 8 * (tid + NTH * i);
            float fw[8], bw[8];
#pragma unroll
            for (int e = 0; e < 8; ++e) { fw[e] = 0.f; bw[e] = 0.f; }
#pragma unroll 4
            for (int j = 0; j < FHID; ++j) {
                const u32x4 hv = ldg16(h3 + (size_t)j * SEQL + pos0);
                const float wf = wo[j], wb = wo[64 + j];
                f16_t hh[8]; __builtin_memcpy(hh, &hv, 16);
#pragma unroll
                for (int e = 0; e < 8; ++e) { const float h = (float)hh[e]; fw[e] += h * wf; bw[e] += h * wb; }
            }
#pragma unroll
            for (int e = 0; e < 8; ++e) {
                const int pos = pos0 + e;
                const float dec = __expf(-((float)pos / (float)(SEQL - 1)) * delta);
                const float f = fw[e] * dec, b = bw[e] * dec;
                if (pos == 0) { const float v = f + b; fbuf[fidx(0)] = v; asum += fabsf(v); }
                else { fbuf[fidx(pos)] = f; fbuf[fidx(2 * SEQL - pos)] = b; asum += fabsf(f) + fabsf(b); }
            }
        }
        if (tid == 0) fbuf[fidx(SEQL)] = 0.f;
        asum = wave_sum(asum);
        if (lane == 0) red[w] = asum;
        __syncthreads();
        float norm = 0.f;
#pragma unroll
        for (int i = 0; i < 8; ++i) norm += red[i];
        fft_fwd_all(buf, tid);
        const float sc = 1.f / (norm * (float)FN);
#pragma unroll 2
        for (int i = 0; i < 16; ++i) { const HPair hp = pair_filter(buf, opaque(tid) + NTH * i, sc);
            Hs[o * 8192 + tid + NTH * i] = (f32x4){hp.hk.x, hp.hk.y, hp.hl.x, hp.hl.y}; }
        __syncthreads();
    }
    const float bias0 = p->in[15][(size_t)l * 2 * HYW + c], bias1 = p->in[15][(size_t)l * 2 * HYW + HYW + c];
    bf16_t* uct = (bf16_t*)((unsigned char*)p->out + DO_UCT);
#pragma unroll 1
    for (int s = 0; s < NSEQ; ++s) {
        bf16_t* p0 = uct + ((size_t)s * HY3 + c) * SEQL; const bf16_t* p1 = p0 + (size_t)HYW * SEQL; const bf16_t* p2 = p0 + (size_t)2 * HYW * SEQL;
#pragma unroll
        for (int i = 0; i < 4; ++i) {
            const int ch = tid + NTH * i;
            const u32x4 v = ldg16(p0 + 8 * ch);
            float2* d = buf + PI(4 * ch);
            d[0] = make_float2(bflo(v.x), bfhi(v.x)); d[1] = make_float2(bflo(v.y), bfhi(v.y)); d[2] = make_float2(bflo(v.z), bfhi(v.z)); d[3] = make_float2(bflo(v.w), bfhi(v.w));
            float2* z = buf + PI(8192 + 4 * ch);
            z[0] = make_float2(0.f, 0.f); z[1] = z[0]; z[2] = z[0]; z[3] = z[0];
        }
        __syncthreads();
        fft_fwd_all(buf, tid);
#pragma unroll 2
        for (int i = 0; i < 16; ++i) { const f32x4 hv = Hs[0 * 8192 + tid + NTH * i]; HPair hp; hp.hk = make_float2(hv.x, hv.y); hp.hl = make_float2(hv.z, hv.w);
            pair_apply(buf, opaque(tid) + NTH * i, hp); }
        __syncthreads();
        fft_inv_all(buf, tid);
#pragma unroll
        for (int i = 0; i < 4; ++i) {
            const int ch = tid + NTH * i;
            const u32x4 a = ldg16(p0 + 8 * ch), b = ldg16(p1 + 8 * ch);
            float2* d = buf + PI(4 * ch);
            float2 y0 = d[0], y1 = d[1], y2 = d[2], y3 = d[3];
            y0.x = bflo(b.x) * (y0.x + bflo(a.x) * bias0); y0.y = bfhi(b.x) * (y0.y + bfhi(a.x) * bias0);
            y1.x = bflo(b.y) * (y1.x + bflo(a.y) * bias0); y1.y = bfhi(b.y) * (y1.y + bfhi(a.y) * bias0);
            y2.x = bflo(b.z) * (y2.x + bflo(a.z) * bias0); y2.y = bfhi(b.z) * (y2.y + bfhi(a.z) * bias0);
            y3.x = bflo(b.w) * (y3.x + bflo(a.w) * bias0); y3.y = bfhi(b.w) * (y3.y + bfhi(a.w) * bias0);
            d[0] = y0; d[1] = y1; d[2] = y2; d[3] = y3;
            float2* z = buf + PI(8192 + 4 * ch);
            z[0] = make_float2(0.f, 0.f); z[1] = z[0]; z[2] = z[0]; z[3] = z[0];
            u32x4 ov; ov.x = pk2(y0.x, y0.y); ov.y = pk2(y1.x, y1.y); ov.z = pk2(y2.x, y2.y); ov.w = pk2(y3.x, y3.y);
            stg16(p0 + 8 * ch, ov);
        }
        __syncthreads();
        fft_fwd_all(buf, tid);
#pragma unroll 2
        for (int i = 0; i < 16; ++i) { const f32x4 hv = Hs[1 * 8192 + tid + NTH * i]; HPair hp; hp.hk = make_float2(hv.x, hv.y); hp.hl = make_float2(hv.z, hv.w);
            pair_apply(buf, opaque(tid) + NTH * i, hp); }
        __syncthreads();
        fft_inv_all(buf, tid);
#pragma unroll
        for (int i = 0; i < 4; ++i) {
            const int ch = tid + NTH * i;
            const u32x4 a = ldg16(p0 + 8 * ch), b = ldg16(p2 + 8 * ch);
            const float2* d = buf + PI(4 * ch);
            const float2 y0 = d[0], y1 = d[1], y2 = d[2], y3 = d[3];
            u32x4 ov;
            ov.x = pk2(bflo(b.x) * (y0.x + bflo(a.x) * bias1), bfhi(b.x) * (y0.y + bfhi(a.x) * bias1));
            ov.y = pk2(bflo(b.y) * (y1.x + bflo(a.y) * bias1), bfhi(b.y) * (y1.y + bfhi(a.y) * bias1));
            ov.z = pk2(bflo(b.z) * (y2.x + bflo(a.z) * bias1), bfhi(b.z) * (y2.y + bfhi(a.z) * bias1));
            ov.w = pk2(bflo(b.w) * (y3.x + bflo(a.w) * bias1), bfhi(b.w) * (y3.y + bfhi(a.w) * bias1));
            stg16(p0 + 8 * ch, ov);
        }
        __syncthreads();
    }
}
__device__ static const signed char CI_TAB[52] = {0,0,0,0,0,0,0,0,0,0,0,0,0,0,0,0,1,1,1,1,1,1,1,1,2,2,2,2,2,3,3,3,3,4,4,4,5,5,6,6,7,7,8,9,10,11,12,13,14,15,15,15};
__device__ static const signed char CJ_TAB[52] = {0,1,2,3,4,5,6,7,8,9,10,11,12,13,14,15,0,1,2,3,4,5,6,7,0,1,2,3,4,0,1,2,3,0,1,2,0,1,0,1,0,1,0,0,0,0,0,0,0,0,15,15};
constexpr int CI_C[52] = {0,0,0,0,0,0,0,0,0,0,0,0,0,0,0,0,1,1,1,1,1,1,1,1,2,2,2,2,2,3,3,3,3,4,4,4,5,5,6,6,7,7,8,9,10,11,12,13,14,15,15,15};
constexpr int CJ_C[52] = {0,1,2,3,4,5,6,7,8,9,10,11,12,13,14,15,0,1,2,3,4,5,6,7,0,1,2,3,4,0,1,2,3,0,1,2,0,1,0,1,0,1,0,0,0,0,0,0,0,0,15,15};
DV unsigned f2ord(float f) { const unsigned u = __builtin_bit_cast(unsigned, f); return (u >> 31) ? ~u : (u | 0x80000000u); }
DV float ord2f(unsigned k) { const unsigned u = (k >> 31) ? (k & 0x7fffffffu) : ~k; return __builtin_bit_cast(float, u); }
DV unsigned umax3(unsigned a, unsigned b, unsigned c) { return max(max(a, b), c); }
DV void peer_topk_item(KParams p, int l, int item) {
    const int lane = tid_() & 63, h = tid_() >> 6, fr = lane & 15, fq = lane >> 4;
    const size_t t0 = (size_t)item * 16;
    const bf16_t* qp = (const bf16_t*)p->out;
    const bf16_t* sk = (const bf16_t*)(p->ws + WS_W + l * SZ_WL + OFF_SK);
    unsigned tk[2][16];
#pragma unroll
    for (int c = 0; c < 2; ++c) {
        bf16x8 bq[4];
#pragma unroll
        for (int ks = 0; ks < 4; ++ks) bq[ks] = *(const bf16x8*)(qp + (t0 + fr) * 2048 + h * 256 + c * 128 + ks * 32 + fq * 8);
        unsigned key[32];
        const bf16_t* skc = sk + (size_t)(h * 2 + c) * 128 * 128;
#pragma unroll
        for (int kt = 0; kt < 8; ++kt) {
            f32x4 s = (f32x4){0.f, 0.f, 0.f, 0.f};
#pragma unroll
            for (int ks = 0; ks < 4; ++ks) { const bf16x8 a = *(const bf16x8*)(skc + (size_t)(kt * 16 + fr) * 128 + ks * 32 + fq * 8); s = __builtin_amdgcn_mfma_f32_16x16x32_bf16(a, bq[ks], s, 0, 0, 0); }
#pragma unroll
            for (int j = 0; j < 4; ++j) { const int kidx = kt * 16 + fq * 4 + j; key[kt * 4 + j] = (f2ord(s[j]) & 0xffffff80u) | (unsigned)(127 - kidx); }
        }
#pragma unroll
        for (int r = 0; r < 16; ++r) {
            unsigned mx = 0;
#pragma unroll
            for (int i = 0; i < 32; i += 2) mx = umax3(mx, key[i], key[i + 1]);
            mx = max(mx, (unsigned)__shfl_xor((int)mx, 16)); mx = max(mx, (unsigned)__shfl_xor((int)mx, 32));
            tk[c][r] = mx;
#pragma unroll
            for (int i = 0; i < 32; ++i) key[i] = (key[i] == mx) ? 0u : key[i];
        }
    }
    float v0[16], v1[16];
#pragma unroll
    for (int r = 0; r < 16; ++r) { v0[r] = ord2f(tk[0][r] & 0xffffff80u); v1[r] = ord2f(tk[1][r] & 0xffffff80u); }
    unsigned ck[13]; int ce[13];
#pragma unroll
    for (int s = 0; s < 13; ++s) {
        float sum[4]; int ee[4];
#pragma unroll
        for (int q = 0; q < 4; ++q) { const int i = CI_C[q + 4 * s], j = CJ_C[q + 4 * s]; sum[q] = v0[i] + v1[j];
            ee[q] = (127 - (int)(tk[0][i] & 127u)) * 128 + (127 - (int)(tk[1][j] & 127u)); }
        const float sm = fq == 0 ? sum[0] : (fq == 1 ? sum[1] : (fq == 2 ? sum[2] : sum[3]));
        ce[s] = fq == 0 ? ee[0] : (fq == 1 ? ee[1] : (fq == 2 ? ee[2] : ee[3]));
        ck[s] = (f2ord(sm) & 0xffffffc0u) | (unsigned)(63 - (4 * s)) ;
        ck[s] -= (unsigned)fq;
    }
    float myv[4]; int mye[4]; float w0 = 0.f;
#pragma unroll
    for (int r = 0; r < 16; ++r) {
        unsigned mx = ck[12];
#pragma unroll
        for (int i = 0; i < 12; i += 2) mx = umax3(mx, ck[i], ck[i + 1]);
        mx = max(mx, (unsigned)__shfl_xor((int)mx, 16)); mx = max(mx, (unsigned)__shfl_xor((int)mx, 32));
        int ew = 0;
#pragma unroll
        for (int i = 0; i < 13; ++i) { const bool hit = ck[i] == mx; ew = hit ? ce[i] : ew; ck[i] = hit ? 0u : ck[i]; }
        ew |= __shfl_xor(ew, 16); ew |= __shfl_xor(ew, 32);
        const float val = ord2f(mx & 0xffffffc0u);
        if (r == 0) w0 = val;
        if (fq == (r >> 2)) { myv[r & 3] = val; mye[r & 3] = ew; }
    }
    float ex[4], ps = 0.f;
#pragma unroll
    for (int i = 0; i < 4; ++i) { ex[i] = __expf(myv[i] - w0); ps += ex[i]; }
    ps += __shfl_xor(ps, 16); ps += __shfl_xor(ps, 32);
    const float inv = 1.f / ps;
    int* eidx = (int*)(p->ws + WS_QKV); float* gate = (float*)(p->ws + WS_QKV + (size_t)T * 128 * 4);
    const size_t o = ((t0 + fr) * 8 + h) * 16 + fq * 4;
    *(u32x4*)(eidx + o) = (u32x4){(unsigned)mye[0], (unsigned)mye[1], (unsigned)mye[2], (unsigned)mye[3]};
    *(f32x4*)(gate + o) = (f32x4){ex[0] * inv, ex[1] * inv, ex[2] * inv, ex[3] * inv};
}

typedef __bf16 bf2_t __attribute__((ext_vector_type(2)));
DV float dot2bf(unsigned a, unsigned b, float c) { return __builtin_amdgcn_fdot2_f32_bf16(__builtin_bit_cast(bf2_t, a), __builtin_bit_cast(bf2_t, b), c, false); }
DV float gelu_exact(float x) { return 0.5f * x * (1.f + erff(x * 0.7071067811865476f)); }
DV void peer_gather_token(KParams p, int l, size_t t) {
    const int lane = tid_() & 63;
    const bf16_t* U = (const bf16_t*)(p->ws + WS_EXP); const bf16_t* V = U + (size_t)NEXP * D;
    const int* eidx = (const int*)(p->ws + WS_QKV); const float* gate = (const float*)(p->ws + WS_QKV + (size_t)T * 128 * 4);
    bf16_t* xb = (bf16_t*)(p->ws + WS_XB);
    const u32x4 xa = ldg16(xb + t * D + lane * 16), xc = ldg16(xb + t * D + lane * 16 + 8);
    const unsigned xw[8] = {xa.x, xa.y, xa.z, xa.w, xc.x, xc.y, xc.z, xc.w};
    float acc[16];
#pragma unroll
    for (int i = 0; i < 16; ++i) acc[i] = 0.f;
    const int kk = ((lane >> 5) & 1) * 4 + ((lane >> 4) & 1) * 2 + ((lane >> 3) & 1);
#pragma unroll 1
    for (int bt = 0; bt < 16; ++bt) {
        const int ev = eidx[t * 128 + bt * 8 + (lane & 7)];
        const float gv = gate[t * 128 + bt * 8 + kk];
        u32x4 ua[8], ub[8], va[8], vb[8];
#pragma unroll
        for (int k = 0; k < 8; ++k) {
            const int e = __builtin_amdgcn_readlane(ev, k);
            const bf16_t* ur = U + (size_t)e * D + lane * 16; const bf16_t* vr = V + (size_t)e * D + lane * 16;
            ua[k] = ldg16(ur); ub[k] = ldg16(ur + 8); va[k] = ldg16(vr); vb[k] = ldg16(vr + 8);
        }
        float pd[8];
#pragma unroll
        for (int k = 0; k < 8; ++k) {
            float d = dot2bf(ua[k].x, xw[0], 0.f); d = dot2bf(ua[k].y, xw[1], d); d = dot2bf(ua[k].z, xw[2], d); d = dot2bf(ua[k].w, xw[3], d);
            d = dot2bf(ub[k].x, xw[4], d); d = dot2bf(ub[k].y, xw[5], d); d = dot2bf(ub[k].z, xw[6], d); d = dot2bf(ub[k].w, xw[7], d);
            pd[k] = d;
        }
        float r4[4], r2[2], r1;
        { const bool hi = (lane & 32) != 0;
#pragma unroll
          for (int j = 0; j < 4; ++j) { const float keep = hi ? pd[j + 4] : pd[j], send = hi ? pd[j] : pd[j + 4]; r4[j] = keep + __shfl_xor(send, 32); } }
        { const bool hi = (lane & 16) != 0;
#pragma unroll
          for (int j = 0; j < 2; ++j) { const float keep = hi ? r4[j + 2] : r4[j], send = hi ? r4[j] : r4[j + 2]; r2[j] = keep + __shfl_xor(send, 16); } }
        { const bool hi = (lane & 8) != 0; const float keep = hi ? r2[1] : r2[0], send = hi ? r2[0] : r2[1]; r1 = keep + __shfl_xor(send, 8); }
        r1 += __shfl_xor(r1, 4); r1 += __shfl_xor(r1, 2); r1 += __shfl_xor(r1, 1);
        const float coef = gv * gelu_exact(r1);
#pragma unroll
        for (int k = 0; k < 8; ++k) {
            const int src = ((k >> 2) & 1) * 32 + ((k >> 1) & 1) * 16 + (k & 1) * 8;
            const float ck = __builtin_bit_cast(float, __builtin_amdgcn_readlane(__builtin_bit_cast(int, coef), src));
            acc[0] += ck * bflo(va[k].x); acc[1] += ck * bfhi(va[k].x); acc[2] += ck * bflo(va[k].y); acc[3] += ck * bfhi(va[k].y);
            acc[4] += ck * bflo(va[k].z); acc[5] += ck * bfhi(va[k].z); acc[6] += ck * bflo(va[k].w); acc[7] += ck * bfhi(va[k].w);
            acc[8] += ck * bflo(vb[k].x); acc[9] += ck * bfhi(vb[k].x); acc[10] += ck * bflo(vb[k].y); acc[11] += ck * bfhi(vb[k].y);
            acc[12] += ck * bflo(vb[k].z); acc[13] += ck * bfhi(vb[k].z); acc[14] += ck * bflo(vb[k].w); acc[15] += ck * bfhi(vb[k].w);
        }
    }
    float y[16]; float s = 0.f;
#pragma unroll
    for (int i = 0; i < 8; ++i) { y[2 * i] = ALPHA * bflo(xw[i]) + acc[2 * i]; y[2 * i + 1] = ALPHA * bfhi(xw[i]) + acc[2 * i + 1]; s += y[2 * i] + y[2 * i + 1]; }
    const float mean = wave_sum(s) * (1.f / D); float s2 = 0.f;
#pragma unroll
    for (int i = 0; i < 16; ++i) { y[i] -= mean; s2 += y[i] * y[i]; }
    const float rstd = rsqrtf(wave_sum(s2) * (1.f / D) + LN_EPS);
    const float* g2 = p->in[25] + (size_t)l * D + lane * 16; const float* b2 = p->in[26] + (size_t)l * D + lane * 16;
#pragma unroll
    for (int i = 0; i < 4; ++i) { const f32x4 gg = *(const f32x4*)(g2 + 4 * i), bb = *(const f32x4*)(b2 + 4 * i);
        y[4 * i] = y[4 * i] * rstd * gg.x + bb.x; y[4 * i + 1] = y[4 * i + 1] * rstd * gg.y + bb.y; y[4 * i + 2] = y[4 * i + 2] * rstd * gg.z + bb.z; y[4 * i + 3] = y[4 * i + 3] * rstd * gg.w + bb.w; }
    if (l == DEPTH - 1) {
        float* o = p->out + t * D + lane * 16;
#pragma unroll
        for (int i = 0; i < 4; ++i) *(f32x4*)(o + 4 * i) = (f32x4){y[4 * i], y[4 * i + 1], y[4 * i + 2], y[4 * i + 3]};
    } else {
        u32x4 o0, o1; o0.x = pk2(y[0], y[1]); o0.y = pk2(y[2], y[3]); o0.z = pk2(y[4], y[5]); o0.w = pk2(y[6], y[7]);
        o1.x = pk2(y[8], y[9]); o1.y = pk2(y[10], y[11]); o1.z = pk2(y[12], y[13]); o1.w = pk2(y[14], y[15]);
        stg16(xb + t * D + lane * 16, o0); stg16(xb + t * D + lane * 16 + 8, o1);
    }
}

constexpr int LDS_BYTES = 139776 + 1024;
constexpr int PH_PER_LAYER = 10, NPHASE = 1 + DEPTH * PH_PER_LAYER;
DV void convert_experts(KParams p, int l, int bid, int nblk) {
    cvt_job(p->in[23] + (size_t)l * NEXP * D, (bf16_t*)(p->ws + WS_EXP), (size_t)NEXP * D, bid, nblk);
    cvt_job(p->in[24] + (size_t)l * NEXP * D, (bf16_t*)(p->ws + WS_EXP) + (size_t)NEXP * D, (size_t)NEXP * D, bid, nblk);
}
DV void run_phase0(KParams p, unsigned char* smem) {
    const int bid = blockIdx.x, nblk = gridDim.x;
    cvt_job(p->in[0], (bf16_t*)(p->ws + WS_XB), (size_t)2 * SEQL * D, bid, nblk);
    cvt_job(p->in[1], (bf16_t*)(p->ws + WS_XB) + (size_t)2 * SEQL * D, (size_t)SEQL * D, bid, nblk);
    cvt_job(p->in[2], (bf16_t*)(p->ws + WS_MEMB), (size_t)2 * N_MEM * D, bid, nblk);
    cvt_job(p->in[3], (bf16_t*)(p->ws + WS_MEMB) + (size_t)2 * N_MEM * D, (size_t)N_MEM * D, bid, nblk);
#pragma unroll 1
    for (int l = 0; l < DEPTH; ++l) {
        unsigned char* wl = p->ws + WS_W + l * SZ_WL;
        cvt_job(p->in[22] + (size_t)l * 8 * 2 * 128 * 128, (bf16_t*)(wl + OFF_SK), (size_t)8 * 2 * 128 * 128, bid, nblk);
        transpose_job(p->in[5] + (size_t)l * D * IN_WIDTH, D, IN_WIDTH, (bf16_t*)(wl + OFF_WT_IN), bid, nblk, (float*)smem);
#pragma unroll 1
        for (int n = 0; n < 3; ++n) transpose_job(p->in[17] + ((size_t)l * 3 + n) * 512 * D, 512, D, (bf16_t*)(wl + OFF_WT_BR) + (size_t)n * D * 512, bid, nblk, (float*)smem);
        transpose_job(p->in[18] + (size_t)l * D * D, D, D, (bf16_t*)(wl + OFF_WT_OUT), bid, nblk, (float*)smem);
        transpose_job(p->in[21] + (size_t)l * D * 2048, D, 2048, (bf16_t*)(wl + OFF_WT_Q), bid, nblk, (float*)smem);
        transpose_job(p->in[16] + (size_t)l * D * D, D, D, (bf16_t*)(wl + OFF_WT_MKV), bid, nblk, (float*)smem);
    }
    convert_experts(p, 0, bid, nblk);
    filter_mlp_job(p, bid, nblk);
}
#ifndef ONLY_Q
#define ONLY_Q -1
#endif
template <int Q> DV void run_phase_q(KParams p, int l, unsigned char* smem) {
    const int bid = blockIdx.x, nblk = gridDim.x;
    if (ONLY_Q >= 0 && Q != ONLY_Q) return;
    if (Q == 0) {
        const int n1 = (T / G_BM) * (O_GATE / G_BN), nx = (l == 0) ? 48 : 0;
#pragma unroll 1
        for (int t = bid; t < n1 + nx; t += nblk) { if (t < n1) gemm1_tile(p, l, t, smem); else kvmem_tile(p, t - n1, smem); }
        if (l > 0) convert_experts(p, l, bid, nblk);
    } else if (Q == 1) {
        const int na = 768, nm = 768, ns = NSEQ * 256 * 24;
#pragma unroll 1
        for (int t = bid; t < na + nm + ns; t += nblk) {
            if (t < na) attn_item<true>(p, l, t, smem);
            else if (t < na + nm) attn_item<false>(p, l, t - na, smem);
            else shortconv_item(p, l, t - na - nm, (float*)smem);
        }
    } else if (Q == 2) {
#pragma unroll 1
        for (int c = bid; c < HYW; c += nblk) hyena_item(p, l, c, smem);
    } else if (Q == 3) {
#pragma unroll 1
        for (int t = bid; t < NSEQ * 256 * 8; t += nblk) hyo_transpose_item(p, t, (bf16_t*)smem);
    } else if (Q == 4) {
#pragma unroll 1
        for (int t = bid; t < (T / G_BM) * (D / G_BN); t += nblk) merge_tile(p, l, t, smem);
    } else if (Q == 5) {
#pragma unroll 1
        for (int t = bid; t < (T / G_BM) * (D / G_BN); t += nblk) outproj_tile(p, l, t, smem);
    } else if (Q == 6) ln1_job(p, l, bid, nblk);
    else if (Q == 7) {
#pragma unroll 1
        for (int t = bid; t < (T / G_BM) * (2048 / G_BN); t += nblk) qpeer_tile(p, l, t, smem);
    } else if (Q == 8) {
#pragma unroll 1
        for (int t = bid; t < T / 16; t += nblk) peer_topk_item(p, l, t);
    } else {
        const int wv = tid_() >> 6;
#pragma unroll 1
        for (size_t t = (size_t)bid * 8 + wv; t < (size_t)T; t += (size_t)nblk * 8) peer_gather_token(p, l, t);
    }
}
#define PHASE_STEP(Q) { const int ph = 1 + l * PH_PER_LAYER + Q; if (ph >= p.ph_lo && ph < p.ph_hi) { run_phase_q<Q>(kparams(), l, smem); if (ph + 1 < p.ph_hi) grid.sync(); } }
__global__ void __launch_bounds__(NTH, 2) encoder_fwd(Params p) {
    extern __shared__ __attribute__((aligned(16))) unsigned char smem[];
    cg::grid_group grid = cg::this_grid();
    if (p.ph_lo == 0) { if (ONLY_Q < 0 || ONLY_Q == 100) run_phase0(kparams(), smem); if (1 < p.ph_hi) grid.sync(); }
#pragma unroll 1
    for (int l = 0; l < DEPTH; ++l) {
        PHASE_STEP(0) PHASE_STEP(1) PHASE_STEP(2) PHASE_STEP(3) PHASE_STEP(4) PHASE_STEP(5) PHASE_STEP(6) PHASE_STEP(7) PHASE_STEP(8) PHASE_STEP(9)
    }
}

#ifndef ONE_LAUNCH
#define ONE_LAUNCH 0
#endif
extern "C" void kernel_launch(void* const* d_in, const int* in_sizes, int n_in, void* d_out, int out_size, void* d_ws, size_t ws_size, hipStream_t stream) {
    static int grid = 0;
    if (grid == 0) {
        if (n_in != 27 || out_size != T * D || ws_size < WS_END) { fprintf(stderr, "kernel_launch: unexpected shapes: n_in %d out %d ws %zu (need %zu)\n", n_in, out_size, ws_size, (size_t)WS_END); grid = -1; return; }
        int dev = 0, cus = 0, per_cu = 0;
        hipGetDevice(&dev);
        hipDeviceGetAttribute(&cus, hipDeviceAttributeMultiprocessorCount, dev);
        if (hipFuncSetAttribute((const void*)encoder_fwd, hipFuncAttributeMaxDynamicSharedMemorySize, LDS_BYTES) != hipSuccess) { fprintf(stderr, "kernel_launch: hipFuncSetAttribute failed\n"); grid = -1; return; }
        if (hipOccupancyMaxActiveBlocksPerMultiprocessor(&per_cu, (const void*)encoder_fwd, NTH, LDS_BYTES) != hipSuccess || per_cu < 1) { fprintf(stderr, "kernel_launch: occupancy query failed (%d)\n", per_cu); grid = -1; return; }
        grid = cus < MAX_GRID ? cus : MAX_GRID;
        fprintf(stderr, "kernel_launch: cus %d per_cu %d grid %d ws %zu need %zu\n", cus, per_cu, grid, ws_size, (size_t)WS_END);
    }
    if (grid < 0) return;
    Params p{};
    for (int i = 0; i < 27; ++i) p.in[i] = (const float*)d_in[i];
    p.out = (float*)d_out; p.ws = (unsigned char*)d_ws;
#if ONE_LAUNCH
    p.ph_lo = 0; p.ph_hi = NPHASE;
    void* args[] = {&p};
    hipError_t e = hipLaunchCooperativeKernel((const void*)encoder_fwd, dim3(grid), dim3(NTH), args, LDS_BYTES, stream);
    if (e != hipSuccess) fprintf(stderr, "cooperative launch failed: %s (grid %d)\n", hipGetErrorString(e), grid);
#else
    for (int ph = 0; ph < NPHASE; ++ph) {
        p.ph_lo = ph; p.ph_hi = ph + 1;
        hipLaunchKernelGGL(encoder_fwd, dim3(grid), dim3(NTH), LDS_BYTES, stream, p);
    }
#endif
}
```

```cpp
#include <hip/hip_runtime.h>
#include <hip/hip_cooperative_groups.h>
#include <cstdio>
#include <cmath>
namespace cg = cooperative_groups;

#define HD __host__ __device__ __forceinline__
#define DV __device__ __forceinline__

typedef unsigned short bf16_t;
typedef short bf16x8 __attribute__((ext_vector_type(8)));
typedef float f32x4 __attribute__((ext_vector_type(4)));
typedef unsigned u32x4 __attribute__((ext_vector_type(4)));
typedef unsigned u32x2 __attribute__((ext_vector_type(2)));
typedef _Float16 f16_t;

constexpr int NTH = 512;
constexpr int D = 1024, NSEQ = 3, SEQL = 16384, T = NSEQ * SEQL, DEPTH = 2;
constexpr int N_MEM = 256;
constexpr int IN_WIDTH = 5888, O_K = 512, O_V = 640, O_HY = 768, O_MQ = 2304, O_GATE = 2816;
constexpr int HYW = 512, HY3 = 1536;
constexpr int FEMB = 33, FHID = 64;
constexpr int NEXP = 16384;
constexpr float ALPHA = 1.4142135623730951f;
constexpr float LN_EPS = 1e-5f;

constexpr size_t SZ_WT_IN = (size_t)IN_WIDTH * D * 2, SZ_WT_BR = (size_t)3 * D * 512 * 2, SZ_WT_OUT = (size_t)D * D * 2,
                 SZ_WT_Q = (size_t)2048 * D * 2, SZ_WT_MKV = (size_t)D * D * 2, SZ_SK = (size_t)8 * 2 * 128 * 128 * 2;
constexpr size_t OFF_WT_IN = 0, OFF_WT_BR = OFF_WT_IN + SZ_WT_IN, OFF_WT_OUT = OFF_WT_BR + SZ_WT_BR, OFF_WT_Q = OFF_WT_OUT + SZ_WT_OUT,
                 OFF_WT_MKV = OFF_WT_Q + SZ_WT_Q, OFF_SK = OFF_WT_MKV + SZ_WT_MKV, SZ_WL = OFF_SK + SZ_SK;
constexpr size_t WS_W = 0;
constexpr size_t WS_EXP = WS_W + 2 * SZ_WL;
constexpr size_t SZ_EXP1 = (size_t)NEXP * D * 2;
constexpr size_t WS_XB = WS_EXP + 2 * SZ_EXP1;
constexpr size_t WS_QKV = WS_XB + (size_t)T * D * 2;
constexpr size_t WS_HY = WS_QKV + (size_t)T * 768 * 2;
constexpr size_t WS_MEMB = WS_HY + (size_t)T * HY3 * 2;
constexpr size_t WS_KVMEM = WS_MEMB + (size_t)768 * D * 2;
constexpr size_t WS_H3 = WS_KVMEM + (size_t)2 * 768 * D * 2;
constexpr size_t WS_HSCR = WS_H3 + (size_t)2 * 64 * SEQL * 2;
constexpr int MAX_GRID = 256;
constexpr size_t WS_END = WS_HSCR + (size_t)MAX_GRID * 2 * 8192 * 16;
constexpr size_t DO_UCT = 0, DO_QM = (size_t)NSEQ * HY3 * SEQL * 2;

struct Params {
    const float* in[27];
    float* out;
    unsigned char* ws;
    int ph_lo, ph_hi;
};

HD bf16_t f2bf(float f) {
    unsigned u = __builtin_bit_cast(unsigned, f);
    u += 0x7fffu + ((u >> 16) & 1u);
    return (bf16_t)(u >> 16);
}
HD float bf2f(bf16_t h) { return __builtin_bit_cast(float, (unsigned)h << 16); }
HD unsigned pk2(float lo, float hi) { return (unsigned)f2bf(lo) | ((unsigned)f2bf(hi) << 16); }
HD float bflo(unsigned w) { return __builtin_bit_cast(float, w << 16); }
HD float bfhi(unsigned w) { return __builtin_bit_cast(float, w & 0xffff0000u); }

HD float2 cadd(float2 a, float2 b) { return make_float2(a.x + b.x, a.y + b.y); }
HD float2 csub(float2 a, float2 b) { return make_float2(a.x - b.x, a.y - b.y); }
HD float2 cmul(float2 a, float2 b) { return make_float2(a.x * b.x - a.y * b.y, a.x * b.y + a.y * b.x); }
HD float2 cmulc(float2 a, float2 b) { return make_float2(a.x * b.x + a.y * b.y, a.y * b.x - a.x * b.y); }
HD float2 cconj(float2 a) { return make_float2(a.x, -a.y); }

constexpr int FN = 16384;
HD int PI(int p) { return p + ((p >> 5) << 1); }
constexpr int FBUF_F2 = FN + (FN >> 5) * 2;
HD int fpos(int k) { return ((k & 15) << 10) | (((k >> 4) & 15) << 6) | (((k >> 8) & 3) << 4) | (k >> 10); }
HD int frev(int p) { return (p >> 10) | (((p >> 6) & 15) << 4) | (((p >> 4) & 3) << 8) | ((p & 15) << 10); }

template <bool INV> HD void dft4(float2& a, float2& b, float2& c, float2& d) {
    const float2 t0 = cadd(a, c), t1 = csub(a, c), t2 = cadd(b, d), t3 = csub(b, d);
    a = cadd(t0, t2); c = csub(t0, t2);
    if (!INV) { b = make_float2(t1.x + t3.y, t1.y - t3.x); d = make_float2(t1.x - t3.y, t1.y + t3.x); }
    else      { b = make_float2(t1.x - t3.y, t1.y + t3.x); d = make_float2(t1.x + t3.y, t1.y - t3.x); }
}
template <bool INV> HD void dft16(float2 (&x)[16]) {
    const float C1 = 0.92387953251128674f, S1 = 0.38268343236508977f, R2 = 0.70710678118654752f;
#pragma unroll
    for (int a = 0; a < 4; ++a) dft4<INV>(x[a], x[a + 4], x[a + 8], x[a + 12]);
    const float sg = INV ? 1.f : -1.f;
    x[1 + 4] = cmul(x[1 + 4], make_float2(C1, sg * S1));
    x[1 + 8] = cmul(x[1 + 8], make_float2(R2, sg * R2));
    x[1 + 12] = cmul(x[1 + 12], make_float2(S1, sg * C1));
    x[2 + 4] = cmul(x[2 + 4], make_float2(R2, sg * R2));
    x[2 + 8] = cmul(x[2 + 8], make_float2(0.f, sg * 1.f));
    x[2 + 12] = cmul(x[2 + 12], make_float2(-R2, sg * R2));
    x[3 + 4] = cmul(x[3 + 4], make_float2(S1, sg * C1));
    x[3 + 8] = cmul(x[3 + 8], make_float2(-R2, sg * R2));
    x[3 + 12] = cmul(x[3 + 12], make_float2(-C1, -sg * S1));
#pragma unroll
    for (int b = 0; b < 4; ++b) dft4<INV>(x[4 * b], x[4 * b + 1], x[4 * b + 2], x[4 * b + 3]);
}
HD float2 twid(float frac) {
    float s, c;
#if defined(__HIP_DEVICE_COMPILE__)
    sincospif(2.f * frac, &s, &c);
#else
    s = sinf(6.283185307179586f * frac); c = cosf(6.283185307179586f * frac);
#endif
    return make_float2(c, -s);
}
template <bool INV> HD void fft_bfly16(float2* buf, int bf, int n, int stride) {
    const int blk = bf / stride, j = bf - blk * stride, base = blk * n + j;
    float2 x[16];
#pragma unroll
    for (int m = 0; m < 16; ++m) x[m] = buf[PI(base + m * stride)];
    float2 w1 = make_float2(1.f, 0.f);
    if (stride > 1) w1 = twid((float)j / (float)n);
    if (INV && stride > 1) {
        float2 w = cconj(w1);
        const float2 wc = w;
#pragma unroll
        for (int m = 1; m < 16; ++m) { x[m] = cmul(x[m], w); w = cmul(w, wc); }
    }
    dft16<INV>(x);
    if (!INV && stride > 1) {
        float2 w = w1;
#pragma unroll
        for (int q = 1; q < 16; ++q) { const int s = (q >> 2) + 4 * (q & 3); x[s] = cmul(x[s], w); w = cmul(w, w1); }
    }
#pragma unroll
    for (int q = 0; q < 16; ++q) buf[PI(base + q * stride)] = x[(q >> 2) + 4 * (q & 3)];
}
template <bool INV> HD void fft_bfly4(float2* buf, int bf, int n, int stride) {
    const int blk = bf / stride, j = bf - blk * stride, base = blk * n + j;
    float2 x[4];
#pragma unroll
    for (int m = 0; m < 4; ++m) x[m] = buf[PI(base + m * stride)];
    const float2 w1 = twid((float)j / (float)n);
    if (INV) { const float2 wc = cconj(w1); float2 w = wc;
#pragma unroll
        for (int m = 1; m < 4; ++m) { x[m] = cmul(x[m], w); w = cmul(w, wc); } }
    dft4<INV>(x[0], x[1], x[2], x[3]);
    if (!INV) { float2 w = w1;
#pragma unroll
        for (int q = 1; q < 4; ++q) { x[q] = cmul(x[q], w); w = cmul(w, w1); } }
#pragma unroll
    for (int q = 0; q < 4; ++q) buf[PI(base + q * stride)] = x[q];
}
template <bool INV> HD void fft_pass(float2* buf, int p, int tid) {
    const int pp = INV ? 3 - p : p;
    if (pp == 0) {
#pragma unroll 1
        for (int i = 0; i < 2; ++i) fft_bfly16<INV>(buf, tid + NTH * i, 16384, 1024); }
    else if (pp == 1) {
#pragma unroll 1
        for (int i = 0; i < 2; ++i) fft_bfly16<INV>(buf, tid + NTH * i, 1024, 64); }
    else if (pp == 2) {
#pragma unroll 2
        for (int i = 0; i < 8; ++i) fft_bfly4<INV>(buf, tid + NTH * i, 64, 16); }
    else {
#pragma unroll 1
        for (int i = 0; i < 2; ++i) fft_bfly16<INV>(buf, tid + NTH * i, 16, 1); }
}
struct HPair { float2 hk, hl; };
HD void pair_unpack(float2 ck, float2 cl, float2 w, float2& ak, float2& al) {
    const float2 e = make_float2(0.5f * (ck.x + cl.x), 0.5f * (ck.y - cl.y));
    const float2 dd = make_float2(0.5f * (ck.x - cl.x), 0.5f * (ck.y + cl.y));
    const float2 o = make_float2(dd.y, -dd.x);
    const float2 wo = cmul(w, o);
    ak = cadd(e, wo); al = cconj(csub(e, wo));
}
HD void pair_pack(float2 yk, float2 yl, float2 w, float2& dk, float2& dl) {
    const float2 ye = make_float2(0.5f * (yk.x + yl.x), 0.5f * (yk.y - yl.y));
    const float2 dd = make_float2(0.5f * (yk.x - yl.x), 0.5f * (yk.y + yl.y));
    const float2 yo = cmulc(dd, w);
    dk = make_float2(ye.x - yo.y, ye.y + yo.x);
    dl = make_float2(ye.x + yo.y, -ye.y + yo.x);
}
HD void pair_item_pos(int e, int& p, int& k, int& pl) { p = 16 * (e >> 3) + (e & 7); k = frev(p); pl = fpos((FN - k) & (FN - 1)); }
HD HPair pair_filter(const float2* buf, int e, float sc) {
    int p, k, pl; pair_item_pos(e, p, k, pl);
    HPair h;
    if (e == 0) {
        const float2 c0 = buf[PI(0)], c8 = buf[PI(fpos(FN / 2))];
        h.hk = make_float2((c0.x + c0.y) * sc, (c0.x - c0.y) * sc);
        h.hl = make_float2(c8.x * sc, -c8.y * sc);
        return h;
    }
    const float2 ck = buf[PI(p)], cl = buf[PI(pl)];
    float2 ak, al; pair_unpack(ck, cl, twid((float)k / (float)(2 * FN)), ak, al);
    h.hk = make_float2(ak.x * sc, ak.y * sc); h.hl = make_float2(al.x * sc, al.y * sc);
    return h;
}
HD void pair_apply(float2* buf, int e, const HPair& h) {
    int p, k, pl; pair_item_pos(e, p, k, pl);
    if (e == 0) {
        const float2 c0 = buf[PI(0)];
        const float y0 = (c0.x + c0.y) * h.hk.x, yL = (c0.x - c0.y) * h.hk.y;
        buf[PI(0)] = make_float2(0.5f * (y0 + yL), 0.5f * (y0 - yL));
        const int p8 = fpos(FN / 2);
        const float2 c8 = buf[PI(p8)];
        const float2 y8 = cmul(cconj(c8), h.hl);
        buf[PI(p8)] = cconj(y8);
        return;
    }
    const float2 ck = buf[PI(p)], cl = buf[PI(pl)];
    const float2 w = twid((float)k / (float)(2 * FN));
    float2 ak, al; pair_unpack(ck, cl, w, ak, al);
    const float2 yk = cmul(ak, h.hk), yl = cmul(al, h.hl);
    float2 dk, dl; pair_pack(yk, yl, w, dk, dl);
    buf[PI(p)] = dk; buf[PI(pl)] = dl;
}
HD int fidx(int n) { return PI(n >> 1) * 2 + (n & 1); }

HD int t5_bucket(int rel) {
    const int n = rel < 0 ? -rel : rel;
    int b = rel > 0 ? 16 : 0;
    if (n < 8) return b + n;
    int nn = n * n, lg = 0;
    while ((nn >> (lg + 1)) != 0) ++lg;
    int large = lg + 2;
    if (large > 15) large = 15;
    return b + large;
}

#define LAS __attribute__((address_space(3)))
#define GAS __attribute__((address_space(1)))
typedef const Params __attribute__((address_space(4)))* KParams;
DV KParams kparams() { KParams kp = (KParams)__builtin_amdgcn_kernarg_segment_ptr(); asm volatile("" : "+s"(kp)); return kp; }
DV int tid_() { int v = threadIdx.x; asm volatile("" : "+v"(v)); return v; }
DV float wave_sum(float v) {
#pragma unroll
    for (int o = 1; o < 64; o <<= 1) v += __shfl_xor(v, o);
    return v;
}
DV float wave_max(float v) {
#pragma unroll
    for (int o = 1; o < 64; o <<= 1) v = fmaxf(v, __shfl_xor(v, o));
    return v;
}
DV void glds16(const void* g, void* l) {
    __builtin_amdgcn_global_load_lds((const GAS unsigned*)g, (LAS unsigned*)l, 16, 0, 0);
}
DV u32x4 ldg16(const void* p) { return *(const u32x4*)p; }
DV void stg16(void* p, u32x4 v) { *(u32x4*)p = v; }

DV void cvt_job(const float* src, bf16_t* dst, size_t n, int bid, int nblk) {
    const size_t n8 = n / 8;
    for (size_t i = (size_t)bid * NTH + tid_(); i < n8; i += (size_t)nblk * NTH) {
        const f32x4 a = *(const f32x4*)(src + i * 8), b = *(const f32x4*)(src + i * 8 + 4);
        u32x4 o; o.x = pk2(a.x, a.y); o.y = pk2(a.z, a.w); o.z = pk2(b.x, b.y); o.w = pk2(b.z, b.w);
        stg16(dst + i * 8, o);
    }
}
DV void transpose_item(const float* W, int K, int N, bf16_t* WT, int item, float* s  ) {
    const int ntn = N / 64, kb = item / ntn, nb = item - kb * ntn, k0 = kb * 64, n0 = nb * 64, tid = tid_();
    __syncthreads();
#pragma unroll
    for (int i = 0; i < 8; ++i) { const int idx = tid + i * NTH, r = idx >> 6, c = idx & 63; s[r * 65 + c] = W[(size_t)(k0 + r) * N + n0 + c]; }
    __syncthreads();
#pragma unroll
    for (int i = 0; i < 4; ++i) { const int idx = tid + i * NTH, n = idx >> 5, kp = idx & 31;
        *(unsigned*)(WT + (size_t)(n0 + n) * K + k0 + 2 * kp) = pk2(s[(2 * kp) * 65 + n], s[(2 * kp + 1) * 65 + n]); }
}
DV void transpose_job(const float* W, int K, int N, bf16_t* WT, int bid, int nblk, float* s) {
    const int items = (K / 64) * (N / 64);
    for (int it = bid; it < items; it += nblk) transpose_item(W, K, N, WT, it, s);
}
DV void filter_mlp_job(KParams p, int bid, int nblk) {
    const int lane = tid_() & 63, wv = tid_() >> 6;
    f16_t* h3 = (f16_t*)(p->ws + WS_H3);
    for (int it = bid * 8 + wv; it < DEPTH * SEQL; it += nblk * 8) {
        const int l = it / SEQL, pos = it - l * SEQL;
        const float* w_in = p->in[10] + (size_t)l * FEMB * FHID;
        const float* w_mid = p->in[11] + (size_t)l * 2 * FHID * FHID;
        const float* fb = p->in[12] + (size_t)l * 3 * FHID;
        const float* ff = p->in[13] + (size_t)l * 3 * FHID;
        const float tt = (float)pos / (float)(SEQL - 1);
        const float wang = 6.283185307179586f * (float)pos / (float)SEQL;
        float zf = 0.f;
        if (lane == 0) zf = tt;
        else if (lane < 33) { const int bi = (lane - 1) & 15; const float band = 1e-4f + (float)bi * ((15.f - 1e-4f) / 15.f); const float ang = wang * band;
            zf = lane <= 16 ? cosf(ang) : -sinf(ang); }
        float acc = 0.f;
#pragma unroll
        for (int i = 0; i < FEMB; ++i) acc += __shfl(zf, i) * w_in[i * FHID + lane];
        float h = sinf(ff[lane] * (acc + fb[lane]));
#pragma unroll
        for (int q = 0; q < 2; ++q) {
            float a2 = 0.f;
#pragma unroll
            for (int i = 0; i < FHID; ++i) a2 += __shfl(h, i) * w_mid[(q * FHID + i) * FHID + lane];
            h = sinf(ff[(q + 1) * FHID + lane] * (a2 + fb[(q + 1) * FHID + lane]));
        }
        h3[((size_t)l * FHID + lane) * SEQL + pos] = (f16_t)h;
    }
}

constexpr int G_BM = 256, G_BN = 128, G_BK = 32;
constexpr int G_ABYTES = G_BM * G_BK * 2, G_BBYTES = G_BN * G_BK * 2, G_STAGE = G_ABYTES + G_BBYTES;
constexpr int G_LDS = 2 * G_STAGE;
DV void gemm_stage(const bf16_t* A, int lda, const bf16_t* Bt, int ldb, int kt, unsigned char* sbuf) {
    const int tid = tid_();
#pragma unroll
    for (int i = 0; i < 2; ++i) { const int b = tid * 16 + i * 8192, r = b >> 6, c = (b & 63) >> 1;
        glds16(A + (size_t)r * lda + kt * G_BK + c, sbuf + b); }
    { const int b = tid * 16, r = b >> 6, c = (b & 63) >> 1;
        glds16(Bt + (size_t)r * ldb + kt * G_BK + c, sbuf + G_ABYTES + b); }
}
DV void gemm_kloop(f32x4 (&acc)[4][4], const bf16_t* A, int lda, const bf16_t* Bt, int ldb, int nk, unsigned char* smem) {
    const int lane = tid_() & 63, wid = tid_() >> 6, wr = wid >> 1, wc = wid & 1, fr = lane & 15, fq = lane >> 4;
    __syncthreads();
    gemm_stage(A, lda, Bt, ldb, 0, smem);
#pragma unroll 1
    for (int t = 0; t < nk; ++t) {
        unsigned char* cur = smem + (t & 1) * G_STAGE;
        asm volatile("s_waitcnt vmcnt(0)" ::: "memory");
        __syncthreads();
        if (t + 1 < nk) gemm_stage(A, lda, Bt, ldb, t + 1, smem + ((t + 1) & 1) * G_STAGE);
        bf16x8 a[4], b[4];
#pragma unroll
        for (int m = 0; m < 4; ++m) a[m] = *(const bf16x8*)(cur + (wr * 64 + m * 16 + fr) * 64 + fq * 16);
#pragma unroll
        for (int n = 0; n < 4; ++n) b[n] = *(const bf16x8*)(cur + G_ABYTES + (wc * 64 + n * 16 + fr) * 64 + fq * 16);
#pragma unroll
        for (int m = 0; m < 4; ++m)
#pragma unroll
            for (int n = 0; n < 4; ++n) acc[m][n] = __builtin_amdgcn_mfma_f32_16x16x32_bf16(b[n], a[m], acc[m][n], 0, 0, 0);
    }
}
DV void acc_zero(f32x4 (&acc)[4][4]) {
#pragma unroll
    for (int m = 0; m < 4; ++m)
#pragma unroll
        for (int n = 0; n < 4; ++n) acc[m][n] = (f32x4){0.f, 0.f, 0.f, 0.f};
}
struct TileCoord { int row0, col0, wr, wc, fr, fq; };
DV TileCoord tile_coord(int pm, int pn) {
    const int lane = tid_() & 63, wid = tid_() >> 6;
    TileCoord c; c.row0 = pm * G_BM; c.col0 = pn * G_BN; c.wr = wid >> 1; c.wc = wid & 1; c.fr = lane & 15; c.fq = lane >> 4; return c;
}
DV void epi_store_bf16(const f32x4 (&acc)[4][4], const TileCoord& c, bf16_t* O, int ldo, int ocol0, const float* bias  ) {
#pragma unroll
    for (int n = 0; n < 4; ++n) {
        const int cl = c.wc * 64 + n * 16 + c.fq * 4;
        f32x4 bv = (f32x4){0.f, 0.f, 0.f, 0.f};
        if (bias) bv = *(const f32x4*)(bias + cl);
#pragma unroll
        for (int m = 0; m < 4; ++m) {
            const int row = c.row0 + c.wr * 64 + m * 16 + c.fr;
            const f32x4 v = acc[m][n] + bv;
            u32x2 o; o.x = pk2(v.x, v.y); o.y = pk2(v.z, v.w);
            *(u32x2*)(O + (size_t)row * ldo + ocol0 + cl) = o;
        }
    }
}

DV void gemm1_tile(KParams p, int l, int tile, unsigned char* smem) {
    const int npn = O_GATE / G_BN;
    const int pm = tile / npn, pn = tile - pm * npn;
    const TileCoord c = tile_coord(pm, pn);
    const bf16_t* xb = (const bf16_t*)(p->ws + WS_XB);
    const bf16_t* wt = (const bf16_t*)(p->ws + WS_W + l * SZ_WL + OFF_WT_IN);
    f32x4 acc[4][4]; acc_zero(acc);
    gemm_kloop(acc, xb + (size_t)c.row0 * D, D, wt + (size_t)c.col0 * D, D, D / G_BK, smem);
    const float* bias = p->in[6] + (size_t)l * IN_WIDTH + c.col0;
    bf16_t* O; int ldo, oc;
    if (c.col0 < O_HY) { O = (bf16_t*)(p->ws + WS_QKV); ldo = 768; oc = c.col0; }
    else if (c.col0 < O_MQ) { O = (bf16_t*)(p->ws + WS_HY); ldo = HY3; oc = c.col0 - O_HY; }
    else { O = (bf16_t*)((unsigned char*)p->out + DO_QM); ldo = 512; oc = c.col0 - O_MQ; }
    epi_store_bf16(acc, c, O, ldo, oc, bias);
}
DV void kvmem_tile(KParams p, int tile, unsigned char* smem) {
    const int l = tile / 24, r = tile - l * 24, pm = r / 8, pn = r - pm * 8;
    const TileCoord c = tile_coord(pm, pn);
    const bf16_t* A = (const bf16_t*)(p->ws + WS_MEMB);
    const bf16_t* wt = (const bf16_t*)(p->ws + WS_W + l * SZ_WL + OFF_WT_MKV);
    f32x4 acc[4][4]; acc_zero(acc);
    gemm_kloop(acc, A + (size_t)c.row0 * D, D, wt + (size_t)c.col0 * D, D, D / G_BK, smem);
    epi_store_bf16(acc, c, (bf16_t*)(p->ws + WS_KVMEM) + (size_t)l * 768 * D, D, c.col0, nullptr);
}
DV void merge_tile(KParams p, int l, int tile, unsigned char* smem) {
    const int npn = D / G_BN;
    const int pm = tile / npn, pn = tile - pm * npn;
    const TileCoord c = tile_coord(pm, pn);
    const bf16_t* xb = (const bf16_t*)(p->ws + WS_XB);
    const bf16_t* wt_in = (const bf16_t*)(p->ws + WS_W + l * SZ_WL + OFF_WT_IN);
    const bf16_t* wt_br = (const bf16_t*)(p->ws + WS_W + l * SZ_WL + OFF_WT_BR);
    u32x2* mlds = (u32x2*)(smem + G_LDS) + (tid_() >> 6) * 1024 + (tid_() & 63);
#pragma unroll 1
    for (int n = 0; n < 3; ++n) {
        unsigned gp[4][4][2];
        {
            f32x4 ga[4][4]; acc_zero(ga);
            gemm_kloop(ga, xb + (size_t)c.row0 * D, D, wt_in + (size_t)(O_GATE + n * D + c.col0) * D, D, D / G_BK, smem);
            const float* bias = p->in[6] + (size_t)l * IN_WIDTH + O_GATE + n * D + c.col0;
#pragma unroll
            for (int nn = 0; nn < 4; ++nn) {
                const f32x4 bv = *(const f32x4*)(bias + c.wc * 64 + nn * 16 + c.fq * 4);
#pragma unroll
                for (int m = 0; m < 4; ++m) {
                    const f32x4 v = ga[m][nn] + bv;
                    const float s0 = 1.f / (1.f + __expf(-v.x)), s1 = 1.f / (1.f + __expf(-v.y)), s2 = 1.f / (1.f + __expf(-v.z)), s3 = 1.f / (1.f + __expf(-v.w));
                    gp[m][nn][0] = pk2(s0, s1); gp[m][nn][1] = pk2(s2, s3);
                }
            }
        }
        const bf16_t* A; int lda;
        if (n == 0) { A = (const bf16_t*)(p->ws + WS_QKV); lda = 768; }
        else if (n == 1) { A = (const bf16_t*)(p->ws + WS_HY); lda = 512; }
        else { A = (const bf16_t*)((unsigned char*)p->out + DO_QM); lda = 512; }
        f32x4 ba[4][4]; acc_zero(ba);
        gemm_kloop(ba, A + (size_t)c.row0 * lda, lda, wt_br + (size_t)(n * D + c.col0) * 512, 512, 512 / G_BK, smem);
#pragma unroll
        for (int m = 0; m < 4; ++m)
#pragma unroll
            for (int nn = 0; nn < 4; ++nn) {
                f32x4 v;
                v.x = bflo(gp[m][nn][0]) * ba[m][nn].x; v.y = bfhi(gp[m][nn][0]) * ba[m][nn].y;
                v.z = bflo(gp[m][nn][1]) * ba[m][nn].z; v.w = bfhi(gp[m][nn][1]) * ba[m][nn].w;
                if (n > 0) { const u32x2 pv = mlds[(m * 4 + nn) * 64]; v.x += bflo(pv.x); v.y += bfhi(pv.x); v.z += bflo(pv.y); v.w += bfhi(pv.y); }
                u32x2 o; o.x = pk2(v.x, v.y); o.y = pk2(v.z, v.w);
                if (n < 2) mlds[(m * 4 + nn) * 64] = o;
                else { const int row = c.row0 + c.wr * 64 + m * 16 + c.fr, col = c.col0 + c.wc * 64 + nn * 16 + c.fq * 4;
                       *(u32x2*)((bf16_t*)(p->ws + WS_HY) + (size_t)T * 512 + (size_t)row * D + col) = o; }
            }
    }
}
DV void outproj_tile(KParams p, int l, int tile, unsigned char* smem) {
    const int npn = D / G_BN;
    const int pm = tile / npn, pn = tile - pm * npn;
    const TileCoord c = tile_coord(pm, pn);
    const bf16_t* A = (const bf16_t*)(p->ws + WS_HY) + (size_t)T * 512;
    const bf16_t* wt = (const bf16_t*)(p->ws + WS_W + l * SZ_WL + OFF_WT_OUT);
    const bf16_t* xb = (const bf16_t*)(p->ws + WS_XB);
    f32x4 acc[4][4]; acc_zero(acc);
    gemm_kloop(acc, A + (size_t)c.row0 * D, D, wt + (size_t)c.col0 * D, D, D / G_BK, smem);
#pragma unroll
    for (int n = 0; n < 4; ++n) {
        const int col = c.col0 + c.wc * 64 + n * 16 + c.fq * 4;
#pragma unroll
        for (int m = 0; m < 4; ++m) {
            const int row = c.row0 + c.wr * 64 + m * 16 + c.fr;
            const u32x2 xv = *(const u32x2*)(xb + (size_t)row * D + col);
            f32x4 v = acc[m][n];
            v.x += ALPHA * bflo(xv.x); v.y += ALPHA * bfhi(xv.x); v.z += ALPHA * bflo(xv.y); v.w += ALPHA * bfhi(xv.y);
            *(f32x4*)(p->out + (size_t)row * D + col) = v;
        }
    }
}
DV void qpeer_tile(KParams p, int l, int tile, unsigned char* smem) {
    const int npn = 2048 / G_BN;
    const int pm = tile / npn, pn = tile - pm * npn;
    const TileCoord c = tile_coord(pm, pn);
    const bf16_t* A = (const bf16_t*)(p->ws + WS_XB);
    const bf16_t* wt = (const bf16_t*)(p->ws + WS_W + l * SZ_WL + OFF_WT_Q);
    f32x4 acc[4][4]; acc_zero(acc);
    gemm_kloop(acc, A + (size_t)c.row0 * D, D, wt + (size_t)c.col0 * D, D, D / G_BK, smem);
    epi_store_bf16(acc, c, (bf16_t*)p->out, 2048, c.col0, nullptr);
}
DV void ln1_job(KParams p, int l, int bid, int nblk) {
    const int lane = tid_() & 63, wv = tid_() >> 6;
    const float* g = p->in[19] + (size_t)l * D; const float* b = p->in[20] + (size_t)l * D;
    bf16_t* xb = (bf16_t*)(p->ws + WS_XB);
    for (int row = bid * 8 + wv; row < T; row += nblk * 8) {
        const float* xr = p->out + (size_t)row * D;
        f32x4 v[4]; float s = 0.f;
#pragma unroll
        for (int j = 0; j < 4; ++j) { v[j] = *(const f32x4*)(xr + lane * 4 + 256 * j); s += (v[j].x + v[j].y) + (v[j].z + v[j].w); }
        const float mean = wave_sum(s) * (1.f / D); float s2 = 0.f;
#pragma unroll
        for (int j = 0; j < 4; ++j) { v[j] = v[j] - mean; s2 += (v[j].x * v[j].x + v[j].y * v[j].y) + (v[j].z * v[j].z + v[j].w * v[j].w); }
        const float rstd = rsqrtf(wave_sum(s2) * (1.f / D) + LN_EPS);
#pragma unroll
        for (int j = 0; j < 4; ++j) {
            const f32x4 gg = *(const f32x4*)(g + lane * 4 + 256 * j), bb = *(const f32x4*)(b + lane * 4 + 256 * j);
            const f32x4 y = v[j] * rstd * gg + bb;
            u32x2 o; o.x = pk2(y.x, y.y); o.y = pk2(y.z, y.w);
            *(u32x2*)(xb + (size_t)row * D + lane * 4 + 256 * j) = o;
        }
    }
}
DV void shortconv_item(KParams p, int l, int item, float* s  ) {
    const int tid = tid_();
    const int ct = item % 24, r = item / 24, tt = r % 256, seq = r / 256;
    const int t0 = tt * 64, c0 = ct * 64;
    const bf16_t* hy = (const bf16_t*)(p->ws + WS_HY);
    bf16_t* uct = (bf16_t*)((unsigned char*)p->out + DO_UCT);
    __syncthreads();
    for (int idx = tid; idx < 66 * 8; idx += NTH) {
        const int rr = idx >> 3, ch = idx & 7, t = t0 + rr - 1;
        u32x4 v = (u32x4){0u, 0u, 0u, 0u};
        if (t >= 0 && t < SEQL) v = ldg16(hy + ((size_t)seq * SEQL + t) * HY3 + c0 + ch * 8);
        float* d = s + rr * 65 + ch * 8;
        d[0] = bflo(v.x); d[1] = bfhi(v.x); d[2] = bflo(v.y); d[3] = bfhi(v.y); d[4] = bflo(v.z); d[5] = bfhi(v.z); d[6] = bflo(v.w); d[7] = bfhi(v.w);
    }
    __syncthreads();
    const int ch = tid >> 3, tq = tid & 7, cg = c0 + ch;
    const float* cw = p->in[7] + (size_t)l * 3 * HY3; const float cb = p->in[8][(size_t)l * HY3 + cg];
    const float w0 = cw[cg], w1 = cw[HY3 + cg], w2 = cw[2 * HY3 + cg];
    float o[8];
#pragma unroll
    for (int e = 0; e < 8; ++e) { const int rr = tq * 8 + e; o[e] = cb + w0 * s[rr * 65 + ch] + w1 * s[(rr + 1) * 65 + ch] + w2 * s[(rr + 2) * 65 + ch]; }
    u32x4 ov; ov.x = pk2(o[0], o[1]); ov.y = pk2(o[2], o[3]); ov.z = pk2(o[4], o[5]); ov.w = pk2(o[6], o[7]);
    stg16(uct + ((size_t)seq * HY3 + cg) * SEQL + t0 + tq * 8, ov);
}
DV void hyo_transpose_item(KParams p, int item, bf16_t* s  ) {
    const int tid = tid_();
    const int ct = item % 8, r = item / 8, tt = r % 256, seq = r / 256;
    const int t0 = tt * 64, c0 = ct * 64;
    const bf16_t* uct = (const bf16_t*)((unsigned char*)p->out + DO_UCT);
    bf16_t* hyo = (bf16_t*)(p->ws + WS_HY);
    __syncthreads();
    { const int ch = tid >> 3, tq = tid & 7;
      const u32x4 v = ldg16(uct + ((size_t)seq * HY3 + c0 + ch) * SEQL + t0 + tq * 8);
      *(u32x4*)(s + ch * 72 + tq * 8) = v; }
    __syncthreads();
    { const int t = tid >> 3, cq = tid & 7;
      bf16_t e[8];
#pragma unroll
      for (int i = 0; i < 8; ++i) e[i] = s[(cq * 8 + i) * 72 + t];
      u32x4 o; o.x = e[0] | ((unsigned)e[1] << 16); o.y = e[2] | ((unsigned)e[3] << 16); o.z = e[4] | ((unsigned)e[5] << 16); o.w = e[6] | ((unsigned)e[7] << 16);
      stg16(hyo + ((size_t)seq * SEQL + t0 + t) * 512 + c0 + cq * 8, o); }
}

template <bool WIN> struct AttnCfg {
    static constexpr int HDIM = WIN ? 64 : 128, NK = WIN ? 384 : 256, QT = WIN ? 4 : 2, KS = HDIM / 32, DT = HDIM / 16;
    static constexpr int KSTR = HDIM + 8, VSTR = NK + 8;
    static constexpr int K_BYTES = NK * KSTR * 2, V_BYTES = HDIM * VSTR * 2;
};
template <bool WIN> DV void attn_item(KParams p, int l, int item, unsigned char* smem) {
    typedef AttnCfg<WIN> C;
    const int tid = tid_(), lane = tid & 63, w = tid >> 6, fr = lane & 15, fq = lane >> 4;
    bf16_t* Ks = (bf16_t*)smem; bf16_t* Vt = (bf16_t*)(smem + C::K_BYTES); float* biasT = (float*)(smem + C::K_BYTES + C::V_BYTES);
    int seq, blk, hh;
    if (WIN) { hh = item & 1; blk = (item >> 1) & 127; seq = item >> 8; }
    else { hh = item & 3; blk = (item >> 2) % 64; seq = (item >> 2) / 64; }
    __syncthreads();
    if (WIN) {
        const bf16_t* qkv = (const bf16_t*)(p->ws + WS_QKV);
#pragma unroll 2
        for (int i = 0; i < 6; ++i) {
            const int idx = tid + i * NTH, key = idx >> 3, ch = idx & 7, pos = blk * 128 - 128 + key;
            u32x4 kv = (u32x4){0u, 0u, 0u, 0u}, vv = kv;
            if (pos >= 0 && pos < SEQL) { const bf16_t* row = qkv + ((size_t)seq * SEQL + pos) * 768; kv = ldg16(row + O_K + hh * 64 + ch * 8); vv = ldg16(row + O_V + hh * 64 + ch * 8); }
            *(u32x4*)(Ks + key * C::KSTR + ch * 8) = kv;
            bf16_t* vd = Vt + (ch * 8) * C::VSTR + key;
            vd[0] = (bf16_t)vv.x; vd[C::VSTR] = (bf16_t)(vv.x >> 16); vd[2 * C::VSTR] = (bf16_t)vv.y; vd[3 * C::VSTR] = (bf16_t)(vv.y >> 16);
            vd[4 * C::VSTR] = (bf16_t)vv.z; vd[5 * C::VSTR] = (bf16_t)(vv.z >> 16); vd[6 * C::VSTR] = (bf16_t)vv.w; vd[7 * C::VSTR] = (bf16_t)(vv.w >> 16);
        }
        for (int i = tid; i < 4 * 257; i += NTH) { const int g = i / 257, r = i - g * 257; biasT[i] = p->in[4][t5_bucket(r - 128) * 8 + hh * 4 + g]; }
    } else {
        const bf16_t* kvm = (const bf16_t*)(p->ws + WS_KVMEM) + (size_t)l * 768 * D;
#pragma unroll 2
        for (int i = 0; i < 8; ++i) {
            const int idx = tid + i * NTH, key = idx >> 4, ch = idx & 15;
            const bf16_t* row = kvm + ((size_t)seq * N_MEM + key) * D;
            const u32x4 kv = ldg16(row + hh * 128 + ch * 8), vv = ldg16(row + 512 + hh * 128 + ch * 8);
            *(u32x4*)(Ks + key * C::KSTR + ch * 8) = kv;
            bf16_t* vd = Vt + (ch * 8) * C::VSTR + key;
            vd[0] = (bf16_t)vv.x; vd[C::VSTR] = (bf16_t)(vv.x >> 16); vd[2 * C::VSTR] = (bf16_t)vv.y; vd[3 * C::VSTR] = (bf16_t)(vv.y >> 16);
            vd[4 * C::VSTR] = (bf16_t)vv.z; vd[5 * C::VSTR] = (bf16_t)(vv.z >> 16); vd[6 * C::VSTR] = (bf16_t)vv.w; vd[7 * C::VSTR] = (bf16_t)(vv.w >> 16);
        }
    }
    bf16_t* qbase; int ldq, qcol0, wrow0; size_t tok0; float sink = 0.f; int g = 0;
    if (WIN) { g = w >> 1; qbase = (bf16_t*)(p->ws + WS_QKV); ldq = 768; qcol0 = (hh * 4 + g) * 64; wrow0 = (w & 1) * 64; tok0 = (size_t)seq * SEQL + blk * 128;
               sink = p->in[9][(size_t)l * 8 + hh * 4 + g]; }
    else { qbase = (bf16_t*)((unsigned char*)p->out + DO_QM); ldq = 512; qcol0 = hh * 128; wrow0 = w * 32; tok0 = (size_t)seq * SEQL + blk * 256; }
    bf16x8 bq[C::QT][C::KS];
#pragma unroll
    for (int qt = 0; qt < C::QT; ++qt)
#pragma unroll
        for (int ks = 0; ks < C::KS; ++ks) bq[qt][ks] = *(const bf16x8*)(qbase + (tok0 + wrow0 + qt * 16 + fr) * ldq + qcol0 + ks * 32 + fq * 8);
    f32x4 o[C::QT][C::DT]; float m[C::QT], ls[C::QT];
#pragma unroll
    for (int qt = 0; qt < C::QT; ++qt) { m[qt] = WIN ? sink : -1e30f; ls[qt] = (WIN && fq == 0) ? 1.f : 0.f;
#pragma unroll
        for (int dt = 0; dt < C::DT; ++dt) o[qt][dt] = (f32x4){0.f, 0.f, 0.f, 0.f}; }
    const float scale = WIN ? 0.125f : 0.08838834764831845f;
    __syncthreads();
#pragma unroll 1
    for (int kc = 0; kc < C::NK / 32; ++kc) {
        bf16x8 ak[2][C::KS];
#pragma unroll
        for (int kt = 0; kt < 2; ++kt)
#pragma unroll
            for (int ks = 0; ks < C::KS; ++ks) ak[kt][ks] = *(const bf16x8*)(Ks + (kc * 32 + kt * 16 + fr) * C::KSTR + ks * 32 + fq * 8);
        bf16x8 av[C::DT];
#pragma unroll
        for (int dt = 0; dt < C::DT; ++dt) {
            const u32x2 v0 = *(const u32x2*)(Vt + (dt * 16 + fr) * C::VSTR + kc * 32 + fq * 4), v1 = *(const u32x2*)(Vt + (dt * 16 + fr) * C::VSTR + kc * 32 + 16 + fq * 4);
            u32x4 vv; vv.x = v0.x; vv.y = v0.y; vv.z = v1.x; vv.w = v1.y; av[dt] = __builtin_bit_cast(bf16x8, vv);
        }
#pragma unroll
        for (int qt = 0; qt < C::QT; ++qt) {
            const int r0 = wrow0 + qt * 16;
            if (WIN && !(kc * 32 + 31 >= r0 && kc * 32 <= r0 + 271)) continue;
            f32x4 s0 = (f32x4){0.f, 0.f, 0.f, 0.f}, s1 = s0;
#pragma unroll
            for (int ks = 0; ks < C::KS; ++ks) { s0 = __builtin_amdgcn_mfma_f32_16x16x32_bf16(ak[0][ks], bq[qt][ks], s0, 0, 0, 0); s1 = __builtin_amdgcn_mfma_f32_16x16x32_bf16(ak[1][ks], bq[qt][ks], s1, 0, 0, 0); }
            float sv[8];
#pragma unroll
            for (int e = 0; e < 8; ++e) {
                const float raw = (e < 4 ? s0[e & 3] : s1[e & 3]) * scale;
                if (WIN) {
                    const int jk = kc * 32 + (e >> 2) * 16 + fq * 4 + (e & 3), qi = r0 + fr, rel = jk - qi, pos = blk * 128 - 128 + jk;
                    const bool ok = (rel >= 0) && (rel <= 256) && (pos >= 0) && (pos < SEQL);
                    const int ri = rel < 0 ? 0 : (rel > 256 ? 256 : rel);
                    sv[e] = ok ? raw + biasT[g * 257 + ri] : -1e30f;
                } else sv[e] = raw;
            }
            float cm = fmaxf(fmaxf(fmaxf(sv[0], sv[1]), fmaxf(sv[2], sv[3])), fmaxf(fmaxf(sv[4], sv[5]), fmaxf(sv[6], sv[7])));
            cm = fmaxf(cm, __shfl_xor(cm, 16)); cm = fmaxf(cm, __shfl_xor(cm, 32));
            const float mn = fmaxf(m[qt], cm), al = __expf(m[qt] - mn);
            m[qt] = mn;
            float ps = 0.f; float pe[8];
#pragma unroll
            for (int e = 0; e < 8; ++e) { pe[e] = __expf(sv[e] - mn); ps += pe[e]; }
            ls[qt] = ls[qt] * al + ps;
            u32x4 pw; pw.x = pk2(pe[0], pe[1]); pw.y = pk2(pe[2], pe[3]); pw.z = pk2(pe[4], pe[5]); pw.w = pk2(pe[6], pe[7]);
            const bf16x8 pf = __builtin_bit_cast(bf16x8, pw);
#pragma unroll
            for (int dt = 0; dt < C::DT; ++dt) { o[qt][dt] = o[qt][dt] * al; o[qt][dt] = __builtin_amdgcn_mfma_f32_16x16x32_bf16(av[dt], pf, o[qt][dt], 0, 0, 0); }
        }
    }
#pragma unroll
    for (int qt = 0; qt < C::QT; ++qt) {
        float lt = ls[qt]; lt += __shfl_xor(lt, 16); lt += __shfl_xor(lt, 32);
        const float inv = 1.f / lt;
#pragma unroll
        for (int dt = 0; dt < C::DT; ++dt) {
            const f32x4 v = o[qt][dt] * inv;
            u32x2 ov; ov.x = pk2(v.x, v.y); ov.y = pk2(v.z, v.w);
            *(u32x2*)(qbase + (tok0 + wrow0 + qt * 16 + fr) * ldq + qcol0 + dt * 16 + fq * 4) = ov;
        }
    }
}
constexpr int ATT_LDS_WIN = AttnCfg<true>::K_BYTES + AttnCfg<true>::V_BYTES + 4 * 257 * 4;
constexpr int ATT_LDS_MEM = AttnCfg<false>::K_BYTES + AttnCfg<false>::V_BYTES;

constexpr int FBUF_BYTES = FBUF_F2 * 8;
constexpr int HY_LDS = FBUF_BYTES + 128 * 4 + 16 * 4;
typedef _Float16 h2_t __attribute__((ext_vector_type(2)));
DV HPair unpackH(u32x2 v) {
    const h2_t a = __builtin_bit_cast(h2_t, v.x), b = __builtin_bit_cast(h2_t, v.y);
    const float sc = 1.f / (float)FN;
    HPair h; h.hk = make_float2((float)a.x * sc, (float)a.y * sc); h.hl = make_float2((float)b.x * sc, (float)b.y * sc); return h;
}
DV int opaque(int v) { asm volatile("" : "+v"(v)); return v; }
DV void fft_fwd_all(float2* buf, int tid) {
#pragma unroll 1
    for (int ps = 0; ps < 4; ++ps) { fft_pass<false>(buf, ps, opaque(tid)); __syncthreads(); }
}
DV void fft_inv_all(float2* buf, int tid) {
#pragma unroll 1
    for (int ps = 0; ps < 4; ++ps) { fft_pass<true>(buf, ps, opaque(tid)); __syncthreads(); }
}
DV void hyena_item(KParams p, int l, int c, unsigned char* smem) {
    const int tid = tid_(), lane = tid & 63, w = tid >> 6;
    float2* buf = (float2*)smem; float* fbuf = (float*)smem;
    float* wo = (float*)(smem + FBUF_BYTES); float* red = wo + 128;
    const f16_t* h3 = (const f16_t*)(p->ws + WS_H3) + (size_t)l * FHID * SEQL;
    const float* fwo = p->in[14] + (size_t)l * FHID * 2048;
    const float min_decay = -3.0701134573253945f, max_decay = -15.350567286626972f;
    const float delta = fabsf(min_decay + (float)c * ((max_decay - min_decay) / 511.f));
    f32x4* Hs = (f32x4*)(p->ws + WS_HSCR) + (size_t)blockIdx.x * 2 * 8192;
    __syncthreads();
#pragma unroll 1
    for (int o = 0; o < 2; ++o) {
        if (tid < 128) { const int dir = tid >> 6, j = tid & 63; wo[tid] = fwo[(size_t)j * 2048 + o * 1024 + dir * 512 + c]; }
        __syncthreads();
        float asum = 0.f;
#pragma unroll 1
        for (int i = 0; i < 4; ++i) {
            const int pos0 = 8 * (tid + NTH * i);
            float fw[8], bw[8];
#pragma unroll
            for (int e = 0; e < 8; ++e) { fw[e] = 0.f; bw[e] = 0.f; }
#pragma unroll 4
            for (int j = 0; j < FHID; ++j) {
                const u32x4 hv = ldg16(h3 + (size_t)j * SEQL + pos0);
                const float wf = wo[j], wb = wo[64 + j];
                f16_t hh[8]; __builtin_memcpy(hh, &hv, 16);
#pragma unroll
                for (int e = 0; e < 8; ++e) { const float h = (float)hh[e]; fw[e] += h * wf; bw[e] += h * wb; }
            }
#pragma unroll
            for (int e = 0; e < 8; ++e) {
                const int pos = pos0 + e;
                const float dec = __expf(-((float)pos / (float)(SEQL - 1)) * delta);
                const float f = fw[e] * dec, b = bw[e] * dec;
                if (pos == 0) { const float v = f + b; fbuf[fidx(0)] = v; asum += fabsf(v); }
                else { fbuf[fidx(pos)] = f; fbuf[fidx(2 * SEQL - pos)] = b; asum += fabsf(f) + fabsf(b); }
            }
        }
        if (tid == 0) fbuf[fidx(SEQL)] = 0.f;
        asum = wave_sum(asum);
        if (lane == 0) red[w] = asum;
        __syncthreads();
        float norm = 0.f;
#pragma unroll
        for (int i = 0; i < 8; ++i) norm += red[i];
        fft_fwd_all(buf, tid);
        const float sc = 1.f / (norm * (float)FN);
#pragma unroll 2
        for (int i = 0; i < 16; ++i) { const HPair hp = pair_filter(buf, opaque(tid) + NTH * i, sc);
            Hs[o * 8192 + tid + NTH * i] = (f32x4){hp.hk.x, hp.hk.y, hp.hl.x, hp.hl.y}; }
        __syncthreads();
    }
    const float bias0 = p->in[15][(size_t)l * 2 * HYW + c], bias1 = p->in[15][(size_t)l * 2 * HYW + HYW + c];
    bf16_t* uct = (bf16_t*)((unsigned char*)p->out + DO_UCT);
#pragma unroll 1
    for (int s = 0; s < NSEQ; ++s) {
        bf16_t* p0 = uct + ((size_t)s * HY3 + c) * SEQL; const bf16_t* p1 = p0 + (size_t)HYW * SEQL; const bf16_t* p2 = p0 + (size_t)2 * HYW * SEQL;
#pragma unroll
        for (int i = 0; i < 4; ++i) {
            const int ch = tid + NTH * i;
            const u32x4 v = ldg16(p0 + 8 * ch);
            float2* d = buf + PI(4 * ch);
            d[0] = make_float2(bflo(v.x), bfhi(v.x)); d[1] = make_float2(bflo(v.y), bfhi(v.y)); d[2] = make_float2(bflo(v.z), bfhi(v.z)); d[3] = make_float2(bflo(v.w), bfhi(v.w));
            float2* z = buf + PI(8192 + 4 * ch);
            z[0] = make_float2(0.f, 0.f); z[1] = z[0]; z[2] = z[0]; z[3] = z[0];
        }
        __syncthreads();
        fft_fwd_all(buf, tid);
#pragma unroll 2
        for (int i = 0; i < 16; ++i) { const f32x4 hv = Hs[0 * 8192 + tid + NTH * i]; HPair hp; hp.hk = make_float2(hv.x, hv.y); hp.hl = make_float2(hv.z, hv.w);
            pair_apply(buf, opaque(tid) + NTH * i, hp); }
        __syncthreads();
        fft_inv_all(buf, tid);
#pragma unroll
        for (int i = 0; i < 4; ++i) {
            const int ch = tid + NTH * i;
            const u32x4 a = ldg16(p0 + 8 * ch), b = ldg16(p1 + 8 * ch);
            float2* d = buf + PI(4 * ch);
            float2 y0 = d[0], y1 = d[1], y2 = d[2], y3 = d[3];
            y0.x = bflo(b.x) * (y0.x + bflo(a.x) * bias0); y0.y = bfhi(b.x) * (y0.y + bfhi(a.x) * bias0);
            y1.x = bflo(b.y) * (y1.x + bflo(a.y) * bias0); y1.y = bfhi(b.y) * (y1.y + bfhi(a.y) * bias0);
            y2.x = bflo(b.z) * (y2.x + bflo(a.z) * bias0); y2.y = bfhi(b.z) * (y2.y + bfhi(a.z) * bias0);
            y3.x = bflo(b.w) * (y3.x + bflo(a.w) * bias0); y3.y = bfhi(b.w) * (y3.y + bfhi(a.w) * bias0);
            d[0] = y0; d[1] = y1; d[2] = y2; d[3] = y3;
            float2* z = buf + PI(8192 + 4 * ch);
            z[0] = make_float2(0.f, 0.f); z[1] = z[0]; z[2] = z[0]; z[3] = z[0];
            u32x4 ov; ov.x = pk2(y0.x, y0.y); ov.y = pk2(y1.x, y1.y); ov.z = pk2(y2.x, y2.y); ov.w = pk2(y3.x, y3.y);
            stg16(p0 + 8 * ch, ov);
        }
        __syncthreads();
        fft_fwd_all(buf, tid);
#pragma unroll 2
        for (int i = 0; i < 16; ++i) { const f32x4 hv = Hs[1 * 8192 + tid + NTH * i]; HPair hp; hp.hk = make_float2(hv.x, hv.y); hp.hl = make_float2(hv.z, hv.w);
            pair_apply(buf, opaque(tid) + NTH * i, hp); }
        __syncthreads();
        fft_inv_all(buf, tid);
#pragma unroll
        for (int i = 0; i < 4; ++i) {
            const int ch = tid + NTH * i;
            const u32x4 a = ldg16(p0 + 8 * ch), b = ldg16(p2 + 8 * ch);
            const float2* d = buf + PI(4 * ch);
            const float2 y0 = d[0], y1 = d[1], y2 = d[2], y3 = d[3];
            u32x4 ov;
            ov.x = pk2(bflo(b.x) * (y0.x + bflo(a.x) * bias1), bfhi(b.x) * (y0.y + bfhi(a.x) * bias1));
            ov.y = pk2(bflo(b.y) * (y1.x + bflo(a.y) * bias1), bfhi(b.y) * (y1.y + bfhi(a.y) * bias1));
            ov.z = pk2(bflo(b.z) * (y2.x + bflo(a.z) * bias1), bfhi(b.z) * (y2.y + bfhi(a.z) * bias1));
            ov.w = pk2(bflo(b.w) * (y3.x + bflo(a.w) * bias1), bfhi(b.w) * (y3.y + bfhi(a.w) * bias1));
            stg16(p0 + 8 * ch, ov);
        }
        __syncthreads();
    }
}
__device__ static const signed char CI_TAB[52] = {0,0,0,0,0,0,0,0,0,0,0,0,0,0,0,0,1,1,1,1,1,1,1,1,2,2,2,2,2,3,3,3,3,4,4,4,5,5,6,6,7,7,8,9,10,11,12,13,14,15,15,15};
__device__ static const signed char CJ_TAB[52] = {0,1,2,3,4,5,6,7,8,9,10,11,12,13,14,15,0,1,2,3,4,5,6,7,0,1,2,3,4,0,1,2,3,0,1,2,0,1,0,1,0,1,0,0,0,0,0,0,0,0,15,15};
constexpr int CI_C[52] = {0,0,0,0,0,0,0,0,0,0,0,0,0,0,0,0,1,1,1,1,1,1,1,1,2,2,2,2,2,3,3,3,3,4,4,4,5,5,6,6,7,7,8,9,10,11,12,13,14,15,15,15};
constexpr int CJ_C[52] = {0,1,2,3,4,5,6,7,8,9,10,11,12,13,14,15,0,1,2,3,4,5,6,7,0,1,2,3,4,0,1,2,3,0,1,2,0,1,0,1,0,1,0,0,0,0,0,0,0,0,15,15};
DV unsigned f2ord(float f) { const unsigned u = __builtin_bit_cast(unsigned, f); return (u >> 31) ? ~u : (u | 0x80000000u); }
DV float ord2f(unsigned k) { const unsigned u = (k >> 31) ? (k & 0x7fffffffu) : ~k; return __builtin_bit_cast(float, u); }
DV unsigned umax3(unsigned a, unsigned b, unsigned c) { return max(max(a, b), c); }
DV void peer_topk_item(KParams p, int l, int item) {
    const int lane = tid_() & 63, h = tid_() >> 6, fr = lane & 15, fq = lane >> 4;
    const size_t t0 = (size_t)item * 16;
    const bf16_t* qp = (const bf16_t*)p->out;
    const bf16_t* sk = (const bf16_t*)(p->ws + WS_W + l * SZ_WL + OFF_SK);
    unsigned tk[2][16];
#pragma unroll
    for (int c = 0; c < 2; ++c) {
        bf16x8 bq[4];
#pragma unroll
        for (int ks = 0; ks < 4; ++ks) bq[ks] = *(const bf16x8*)(qp + (t0 + fr) * 2048 + h * 256 + c * 128 + ks * 32 + fq * 8);
        unsigned key[32];
        const bf16_t* skc = sk + (size_t)(h * 2 + c) * 128 * 128;
#pragma unroll
        for (int kt = 0; kt < 8; ++kt) {
            f32x4 s = (f32x4){0.f, 0.f, 0.f, 0.f};
#pragma unroll
            for (int ks = 0; ks < 4; ++ks) { const bf16x8 a = *(const bf16x8*)(skc + (size_t)(kt * 16 + fr) * 128 + ks * 32 + fq * 8); s = __builtin_amdgcn_mfma_f32_16x16x32_bf16(a, bq[ks], s, 0, 0, 0); }
#pragma unroll
            for (int j = 0; j < 4; ++j) { const int kidx = kt * 16 + fq * 4 + j; key[kt * 4 + j] = (f2ord(s[j]) & 0xffffff80u) | (unsigned)(127 - kidx); }
        }
#pragma unroll
        for (int r = 0; r < 16; ++r) {
            unsigned mx = 0;
#pragma unroll
            for (int i = 0; i < 32; i += 2) mx = umax3(mx, key[i], key[i + 1]);
            mx = max(mx, (unsigned)__shfl_xor((int)mx, 16)); mx = max(mx, (unsigned)__shfl_xor((int)mx, 32));
            tk[c][r] = mx;
#pragma unroll
            for (int i = 0; i < 32; ++i) key[i] = (key[i] == mx) ? 0u : key[i];
        }
    }
    float v0[16], v1[16];
#pragma unroll
    for (int r = 0; r < 16; ++r) { v0[r] = ord2f(tk[0][r] & 0xffffff80u); v1[r] = ord2f(tk[1][r] & 0xffffff80u); }
    unsigned ck[13]; int ce[13];
#pragma unroll
    for (int s = 0; s < 13; ++s) {
        float sum[4]; int ee[4];
#pragma unroll
        for (int q = 0; q < 4; ++q) { const int i = CI_C[q + 4 * s], j = CJ_C[q + 4 * s]; sum[q] = v0[i] + v1[j];
            ee[q] = (127 - (int)(tk[0][i] & 127u)) * 128 + (127 - (int)(tk[1][j] & 127u)); }
        const float sm = fq == 0 ? sum[0] : (fq == 1 ? sum[1] : (fq == 2 ? sum[2] : sum[3]));
        ce[s] = fq == 0 ? ee[0] : (fq == 1 ? ee[1] : (fq == 2 ? ee[2] : ee[3]));
        ck[s] = (f2ord(sm) & 0xffffffc0u) | (unsigned)(63 - (4 * s)) ;
        ck[s] -= (unsigned)fq;
    }
    float myv[4]; int mye[4]; float w0 = 0.f;
#pragma unroll
    for (int r = 0; r < 16; ++r) {
        unsigned mx = ck[12];
#pragma unroll
        for (int i = 0; i < 12; i += 2) mx = umax3(mx, ck[i], ck[i + 1]);
        mx = max(mx, (unsigned)__shfl_xor((int)mx, 16)); mx = max(mx, (unsigned)__shfl_xor((int)mx, 32));
        int ew = 0;
#pragma unroll
        for (int i = 0; i < 13; ++i) { const bool hit = ck[i] == mx; ew = hit ? ce[i] : ew; ck[i] = hit ? 0u : ck[i]; }
        ew |= __shfl_xor(ew, 16); ew |= __shfl_xor(ew, 32);
        const float val = ord2f(mx & 0xffffffc0u);
        if (r == 0) w0 = val;
        if (fq == (r >> 2)) { myv[r & 3] = val; mye[r & 3] = ew; }
    }
    float ex[4], ps = 0.f;
#pragma unroll
    for (int i = 0; i < 4; ++i) { ex[i] = __expf(myv[i] - w0); ps += ex[i]; }
    ps += __shfl_xor(ps, 16); ps += __shfl_xor(ps, 32);
    const float inv = 1.f / ps;
    int* eidx = (int*)(p->ws + WS_QKV); float* gate = (float*)(p->ws + WS_QKV + (size_t)T * 128 * 4);
    const size_t o = ((t0 + fr) * 8 + h) * 16 + fq * 4;
    *(u32x4*)(eidx + o) = (u32x4){(unsigned)mye[0], (unsigned)mye[1], (unsigned)mye[2], (unsigned)mye[3]};
    *(f32x4*)(gate + o) = (f32x4){ex[0] * inv, ex[1] * inv, ex[2] * inv, ex[3] * inv};
}

typedef __bf16 bf2_t __attribute__((ext_vector_type(2)));
DV float dot2bf(unsigned a, unsigned b, float c) { return __builtin_amdgcn_fdot2_f32_bf16(__builtin_bit_cast(bf2_t, a), __builtin_bit_cast(bf2_t, b), c, false); }
DV float gelu_exact(float x) { return 0.5f * x * (1.f + erff(x * 0.7071067811865476f)); }
DV void peer_gather_token(KParams p, int l, size_t t) {
    const int lane = tid_() & 63;
    const bf16_t* U = (const bf16_t*)(p->ws + WS_EXP); const bf16_t* V = U + (size_t)NEXP * D;
    const int* eidx = (const int*)(p->ws + WS_QKV); const float* gate = (const float*)(p->ws + WS_QKV + (size_t)T * 128 * 4);
    bf16_t* xb = (bf16_t*)(p->ws + WS_XB);
    const u32x4 xa = ldg16(xb + t * D + lane * 16), xc = ldg16(xb + t * D + lane * 16 + 8);
    const unsigned xw[8] = {xa.x, xa.y, xa.z, xa.w, xc.x, xc.y, xc.z, xc.w};
    float acc[16];
#pragma unroll
    for (int i = 0; i < 16; ++i) acc[i] = 0.f;
    const int kk = ((lane >> 5) & 1) * 4 + ((lane >> 4) & 1) * 2 + ((lane >> 3) & 1);
#pragma unroll 1
    for (int bt = 0; bt < 16; ++bt) {
        const int ev = eidx[t * 128 + bt * 8 + (lane & 7)];
        const float gv = gate[t * 128 + bt * 8 + kk];
        u32x4 ua[8], ub[8], va[8], vb[8];
#pragma unroll
        for (int k = 0; k < 8; ++k) {
            const int e = __builtin_amdgcn_readlane(ev, k);
            const bf16_t* ur = U + (size_t)e * D + lane * 16; const bf16_t* vr = V + (size_t)e * D + lane * 16;
            ua[k] = ldg16(ur); ub[k] = ldg16(ur + 8); va[k] = ldg16(vr); vb[k] = ldg16(vr + 8);
        }
        float pd[8];
#pragma unroll
        for (int k = 0; k < 8; ++k) {
            float d = dot2bf(ua[k].x, xw[0], 0.f); d = dot2bf(ua[k].y, xw[1], d); d = dot2bf(ua[k].z, xw[2], d); d = dot2bf(ua[k].w, xw[3], d);
            d = dot2bf(ub[k].x, xw[4], d); d = dot2bf(ub[k].y, xw[5], d); d = dot2bf(ub[k].z, xw[6], d); d = dot2bf(ub[k].w, xw[7], d);
            pd[k] = d;
        }
        float r4[4], r2[2], r1;
        { const bool hi = (lane & 32) != 0;
#pragma unroll
          for (int j = 0; j < 4; ++j) { const float keep = hi ? pd[j + 4] : pd[j], send = hi ? pd[j] : pd[j + 4]; r4[j] = keep + __shfl_xor(send, 32); } }
        { const bool hi = (lane & 16) != 0;
#pragma unroll
          for (int j = 0; j < 2; ++j) { const float keep = hi ? r4[j + 2] : r4[j], send = hi ? r4[j] : r4[j + 2]; r2[j] = keep + __shfl_xor(send, 16); } }
        { const bool hi = (lane & 8) != 0; const float keep = hi ? r2[1] : r2[0], send = hi ? r2[0] : r2[1]; r1 = keep + __shfl_xor(send, 8); }
        r1 += __shfl_xor(r1, 4); r1 += __shfl_xor(r1, 2); r1 += __shfl_xor(r1, 1);
        const float coef = gv * gelu_exact(r1);
#pragma unroll
        for (int k = 0; k < 8; ++k) {
            const int src = ((k >> 2) & 1) * 32 + ((k >> 1) & 1) * 16 + (k & 1) * 8;
            const float ck = __builtin_bit_cast(float, __builtin_amdgcn_readlane(__builtin_bit_cast(int, coef), src));
            acc[0] += ck * bflo(va[k].x); acc[1] += ck * bfhi(va[k].x); acc[2] += ck * bflo(va[k].y); acc[3] += ck * bfhi(va[k].y);
            acc[4] += ck * bflo(va[k].z); acc[5] += ck * bfhi(va[k].z); acc[6] += ck * bflo(va[k].w); acc[7] += ck * bfhi(va[k].w);
            acc[8] += ck * bflo(vb[k].x); acc[9] += ck * bfhi(vb[k].x); acc[10] += ck * bflo(vb[k].y); acc[11] += ck * bfhi(vb[k].y);
            acc[12] += ck * bflo(vb[k].z); acc[13] += ck * bfhi(vb[k].z); acc[14] += ck * bflo(vb[k].w); acc[15] += ck * bfhi(vb[k].w);
        }
    }
    float y[16]; float s = 0.f;
#pragma unroll
    for (int i = 0; i < 8; ++i) { y[2 * i] = ALPHA * bflo(xw[i]) + acc[2 * i]; y[2 * i + 1] = ALPHA * bfhi(xw[i]) + acc[2 * i + 1]; s += y[2 * i] + y[2 * i + 1]; }
    const float mean = wave_sum(s) * (1.f / D); float s2 = 0.f;
#pragma unroll
    for (int i = 0; i < 16; ++i) { y[i] -= mean; s2 += y[i] * y[i]; }
    const float rstd = rsqrtf(wave_sum(s2) * (1.f / D) + LN_EPS);
    const float* g2 = p->in[25] + (size_t)l * D + lane * 16; const float* b2 = p->in[26] + (size_t)l * D + lane * 16;
#pragma unroll
    for (int i = 0; i < 4; ++i) { const f32x4 gg = *(const f32x4*)(g2 + 4 * i), bb = *(const f32x4*)(b2 + 4 * i);
        y[4 * i] = y[4 * i] * rstd * gg.x + bb.x; y[4 * i + 1] = y[4 * i + 1] * rstd * gg.y + bb.y; y[4 * i + 2] = y[4 * i + 2] * rstd * gg.z + bb.z; y[4 * i + 3] = y[4 * i + 3] * rstd * gg.w + bb.w; }
    if (l == DEPTH - 1) {
        float* o = p->out + t * D + lane * 16;
#pragma unroll
        for (int i = 0; i < 4; ++i) *(f32x4*)(o + 4 * i) = (f32x4){y[4 * i], y[4 * i + 1], y[4 * i + 2], y[4 * i + 3]};
    } else {
        u32x4 o0, o1; o0.x = pk2(y[0], y[1]); o0.y = pk2(y[2], y[3]); o0.z = pk2(y[4], y[5]); o0.w = pk2(y[6], y[7]);
        o1.x = pk2(y[8], y[9]); o1.y = pk2(y[10], y[11]); o1.z = pk2(y[12], y[13]); o1.w = pk2(y[14], y[15]);
        stg16(xb + t * D + lane * 16, o0); stg16(xb + t * D + lane * 16 + 8, o1);
    }
}

constexpr int LDS_BYTES = 139776 + 1024;
constexpr int PH_PER_LAYER = 10, NPHASE = 1 + DEPTH * PH_PER_LAYER;
DV void convert_experts(KParams p, int l, int bid, int nblk) {
    cvt_job(p->in[23] + (size_t)l * NEXP * D, (bf16_t*)(p->ws + WS_EXP), (size_t)NEXP * D, bid, nblk);
    cvt_job(p->in[24] + (size_t)l * NEXP * D, (bf16_t*)(p->ws + WS_EXP) + (size_t)NEXP * D, (size_t)NEXP * D, bid, nblk);
}
DV void run_phase0(KParams p, unsigned char* smem) {
    const int bid = blockIdx.x, nblk = gridDim.x;
    cvt_job(p->in[0], (bf16_t*)(p->ws + WS_XB), (size_t)2 * SEQL * D, bid, nblk);
    cvt_job(p->in[1], (bf16_t*)(p->ws + WS_XB) + (size_t)2 * SEQL * D, (size_t)SEQL * D, bid, nblk);
    cvt_job(p->in[2], (bf16_t*)(p->ws + WS_MEMB), (size_t)2 * N_MEM * D, bid, nblk);
    cvt_job(p->in[3], (bf16_t*)(p->ws + WS_MEMB) + (size_t)2 * N_MEM * D, (size_t)N_MEM * D, bid, nblk);
#pragma unroll 1
    for (int l = 0; l < DEPTH; ++l) {
        unsigned char* wl = p->ws + WS_W + l * SZ_WL;
        cvt_job(p->in[22] + (size_t)l * 8 * 2 * 128 * 128, (bf16_t*)(wl + OFF_SK), (size_t)8 * 2 * 128 * 128, bid, nblk);
        transpose_job(p->in[5] + (size_t)l * D * IN_WIDTH, D, IN_WIDTH, (bf16_t*)(wl + OFF_WT_IN), bid, nblk, (float*)smem);
#pragma unroll 1
        for (int n = 0; n < 3; ++n) transpose_job(p->in[17] + ((size_t)l * 3 + n) * 512 * D, 512, D, (bf16_t*)(wl + OFF_WT_BR) + (size_t)n * D * 512, bid, nblk, (float*)smem);
        transpose_job(p->in[18] + (size_t)l * D * D, D, D, (bf16_t*)(wl + OFF_WT_OUT), bid, nblk, (float*)smem);
        transpose_job(p->in[21] + (size_t)l * D * 2048, D, 2048, (bf16_t*)(wl + OFF_WT_Q), bid, nblk, (float*)smem);
        transpose_job(p->in[16] + (size_t)l * D * D, D, D, (bf16_t*)(wl + OFF_WT_MKV), bid, nblk, (float*)smem);
    }
    convert_experts(p, 0, bid, nblk);
    filter_mlp_job(p, bid, nblk);
}
#ifndef ONLY_Q
#define ONLY_Q -1
#endif
template <int Q> DV void run_phase_q(KParams p, int l, unsigned char* smem) {
    const int bid = blockIdx.x, nblk = gridDim.x;
    if (ONLY_Q >= 0 && Q != ONLY_Q) return;
    if (Q == 0) {
        const int n1 = (T / G_BM) * (O_GATE / G_BN), nx = (l == 0) ? 48 : 0;
#pragma unroll 1
        for (int t = bid; t < n1 + nx; t += nblk) { if (t < n1) gemm1_tile(p, l, t, smem); else kvmem_tile(p, t - n1, smem); }
        if (l > 0) convert_experts(p, l, bid, nblk);
    } else if (Q == 1) {
        const int na = 768, nm = 768, ns = NSEQ * 256 * 24;
#pragma unroll 1
        for (int t = bid; t < na + nm + ns; t += nblk) {
            if (t < na) attn_item<true>(p, l, t, smem);
            else if (t < na + nm) attn_item<false>(p, l, t - na, smem);
            else shortconv_item(p, l, t - na - nm, (float*)smem);
        }
    } else if (Q == 2) {
#pragma unroll 1
        for (int c = bid; c < HYW; c += nblk) hyena_item(p, l, c, smem);
    } else if (Q == 3) {
#pragma unroll 1
        for (int t = bid; t < NSEQ * 256 * 8; t += nblk) hyo_transpose_item(p, t, (bf16_t*)smem);
    } else if (Q == 4) {
#pragma unroll 1
        for (int t = bid; t < (T / G_BM) * (D / G_BN); t += nblk) merge_tile(p, l, t, smem);
    } else if (Q == 5) {
#pragma unroll 1
        for (int t = bid; t < (T / G_BM) * (D / G_BN); t += nblk) outproj_tile(p, l, t, smem);
    } else if (Q == 6) ln1_job(p, l, bid, nblk);
    else if (Q == 7) {
#pragma unroll 1
        for (int t = bid; t < (T / G_BM) * (2048 / G_BN); t += nblk) qpeer_tile(p, l, t, smem);
    } else if (Q == 8) {
#pragma unroll 1
        for (int t = bid; t < T / 16; t += nblk) peer_topk_item(p, l, t);
    } else {
        const int wv = tid_() >> 6;
#pragma unroll 1
        for (size_t t = (size_t)bid * 8 + wv; t < (size_t)T; t += (size_t)nblk * 8) peer_gather_token(p, l, t);
    }
}
#define PHASE_STEP(Q) { const int ph = 1 + l * PH_PER_LAYER + Q; if (ph >= p.ph_lo && ph < p.ph_hi) { run_phase_q<Q>(kparams(), l, smem); if (ph + 1 < p.ph_hi) grid.sync(); } }
__global__ void __launch_bounds__(NTH, 2) encoder_fwd(Params p) {
    extern __shared__ __attribute__((aligned(16))) unsigned char smem[];
    cg::grid_group grid = cg::this_grid();
    if (p.ph_lo == 0) { if (ONLY_Q < 0 || ONLY_Q == 100) run_phase0(kparams(), smem); if (1 < p.ph_hi) grid.sync(); }
#pragma unroll 1
    for (int l = 0; l < DEPTH; ++l) {
        PHASE_STEP(0) PHASE_STEP(1) PHASE_STEP(2) PHASE_STEP(3) PHASE_STEP(4) PHASE_STEP(5) PHASE_STEP(6) PHASE_STEP(7) PHASE_STEP(8) PHASE_STEP(9)
    }
}

#ifndef ONE_LAUNCH
#define ONE_LAUNCH 1
#endif
extern "C" void kernel_launch(void* const* d_in, const int* in_sizes, int n_in, void* d_out, int out_size, void* d_ws, size_t ws_size, hipStream_t stream) {
    static int grid = 0;
    if (grid == 0) {
        if (n_in != 27 || out_size != T * D || ws_size < WS_END) { fprintf(stderr, "kernel_launch: unexpected shapes: n_in %d out %d ws %zu (need %zu)\n", n_in, out_size, ws_size, (size_t)WS_END); grid = -1; return; }
        int dev = 0, cus = 0, per_cu = 0;
        hipGetDevice(&dev);
        hipDeviceGetAttribute(&cus, hipDeviceAttributeMultiprocessorCount, dev);
        if (hipFuncSetAttribute((const void*)encoder_fwd, hipFuncAttributeMaxDynamicSharedMemorySize, LDS_BYTES) != hipSuccess) { fprintf(stderr, "kernel_launch: hipFuncSetAttribute failed\n"); grid = -1; return; }
        if (hipOccupancyMaxActiveBlocksPerMultiprocessor(&per_cu, (const void*)encoder_fwd, NTH, LDS_BYTES) != hipSuccess || per_cu < 1) { fprintf(stderr, "kernel_launch: occupancy query failed (%d)\n", per_cu); grid = -1; return; }
        grid = cus < MAX_GRID ? cus : MAX_GRID;
        fprintf(stderr, "kernel_launch: cus %d per_cu %d grid %d ws %zu need %zu\n", cus, per_cu, grid, ws_size, (size_t)WS_END);
    }
    if (grid < 0) return;
    Params p{};
    for (int i = 0; i < 27; ++i) p.in[i] = (const float*)d_in[i];
    p.out = (float*)d_out; p.ws = (unsigned char*)d_ws;
#if ONE_LAUNCH
    p.ph_lo = 0; p.ph_hi = NPHASE;
    void* args[] = {&p};
    hipError_t e = hipLaunchCooperativeKernel((const void*)encoder_fwd, dim3(grid), dim3(NTH), args, LDS_BYTES, stream);
    if (e != hipSuccess) fprintf(stderr, "cooperative launch failed: %s (grid %d)\n", hipGetErrorString(e), grid);
#else
    for (int ph = 0; ph < NPHASE; ++ph) {
        p.ph_lo = ph; p.ph_hi = ph + 1;
        hipLaunchKernelGGL(encoder_fwd, dim3(grid), dim3(NTH), LDS_BYTES, stream, p);
    }
#endif
}
```

```cpp
#include <hip/hip_runtime.h>
#include <hip/hip_cooperative_groups.h>
#include <cstdio>
#include <cmath>
namespace cg = cooperative_groups;

#define HD __host__ __device__ __forceinline__
#define DV __device__ __forceinline__

typedef unsigned short bf16_t;
typedef short bf16x8 __attribute__((ext_vector_type(8)));
typedef float f32x4 __attribute__((ext_vector_type(4)));
typedef unsigned u32x4 __attribute__((ext_vector_type(4)));
typedef unsigned u32x2 __attribute__((ext_vector_type(2)));
typedef _Float16 f16_t;

constexpr int NTH = 512;
constexpr int D = 1024, NSEQ = 3, SEQL = 16384, T = NSEQ * SEQL, DEPTH = 2;
constexpr int N_MEM = 256;
constexpr int IN_WIDTH = 5888, O_K = 512, O_V = 640, O_HY = 768, O_MQ = 2304, O_GATE = 2816;
constexpr int HYW = 512, HY3 = 1536;
constexpr int FEMB = 33, FHID = 64;
constexpr int NEXP = 16384;
constexpr float ALPHA = 1.4142135623730951f;
constexpr float LN_EPS = 1e-5f;

constexpr size_t SZ_WT_IN = (size_t)IN_WIDTH * D * 2, SZ_WT_BR = (size_t)3 * D * 512 * 2, SZ_WT_OUT = (size_t)D * D * 2,
                 SZ_WT_Q = (size_t)2048 * D * 2, SZ_WT_MKV = (size_t)D * D * 2, SZ_SK = (size_t)8 * 2 * 128 * 128 * 2;
constexpr size_t OFF_WT_IN = 0, OFF_WT_BR = OFF_WT_IN + SZ_WT_IN, OFF_WT_OUT = OFF_WT_BR + SZ_WT_BR, OFF_WT_Q = OFF_WT_OUT + SZ_WT_OUT,
                 OFF_WT_MKV = OFF_WT_Q + SZ_WT_Q, OFF_SK = OFF_WT_MKV + SZ_WT_MKV, SZ_WL = OFF_SK + SZ_SK;
constexpr size_t WS_W = 0;
constexpr size_t WS_EXP = WS_W + 2 * SZ_WL;
constexpr size_t SZ_EXP1 = (size_t)NEXP * D + (size_t)NEXP * 4;
constexpr size_t WS_XB = WS_EXP + 4 * SZ_EXP1;
constexpr size_t WS_QKV = WS_XB + (size_t)T * D * 2;
constexpr size_t WS_HY = WS_QKV + (size_t)T * 768 * 2;
constexpr size_t WS_MEMB = WS_HY + (size_t)T * HY3 * 2;
constexpr size_t WS_KVMEM = WS_MEMB + (size_t)768 * D * 2;
constexpr size_t WS_H3 = WS_KVMEM + (size_t)2 * 768 * D * 2;
constexpr size_t WS_WOT = WS_H3 + (size_t)2 * 64 * SEQL * 2;
constexpr size_t WS_FILT = WS_WOT + (size_t)2 * 2048 * 64 * 2;
constexpr int MAX_GRID = 256;
constexpr size_t WS_HSCR = WS_HY;
static_assert((size_t)MAX_GRID * 2 * 8192 * 16 <= (size_t)T * HY3 * 2, "HSCR overlay");
constexpr size_t WS_TS = WS_FILT + (size_t)2048 * SEQL * 2;
constexpr size_t WS_TW = WS_TS + 1024;
constexpr size_t WS_BAR = WS_TW + (size_t)16384 * 8;
constexpr size_t WS_END = WS_BAR + 16384;
constexpr size_t WS_EIDX = WS_QKV;
constexpr size_t WS_GATE = WS_EIDX + (size_t)T * 128 * 2;
constexpr size_t WS_COEF = WS_GATE + (size_t)T * 128 * 4;
constexpr size_t WS_EIDXN = WS_COEF + (size_t)T * 128 * 2;
constexpr size_t WS_X8 = WS_HY;
static_assert(WS_EIDXN + (size_t)T * 128 * 2 <= WS_HY, "eidx copy overflows the qkv region");
static_assert(WS_COEF + (size_t)T * 128 * 4 <= WS_HY, "PEER buffers overlay qkv");
constexpr size_t DO_UCT = 0, DO_QM = (size_t)NSEQ * HY3 * SEQL * 2;

struct Params {
    const float* in[27];
    float* out;
    unsigned char* ws;
    int ph_lo, ph_hi;
};

HD bf16_t f2bf(float f) {
    unsigned u = __builtin_bit_cast(unsigned, f);
    u += 0x7fffu + ((u >> 16) & 1u);
    return (bf16_t)(u >> 16);
}
HD float bf2f(bf16_t h) { return __builtin_bit_cast(float, (unsigned)h << 16); }
typedef __bf16 bf16x2_hw __attribute__((ext_vector_type(2)));
typedef float f32x2_cv __attribute__((ext_vector_type(2)));
HD unsigned pk2(float lo, float hi) {
#if defined(__HIP_DEVICE_COMPILE__)
    return __builtin_bit_cast(unsigned, __builtin_convertvector((f32x2_cv){lo, hi}, bf16x2_hw));
#else
    return (unsigned)f2bf(lo) | ((unsigned)f2bf(hi) << 16);
#endif
}
HD float bflo(unsigned w) { return __builtin_bit_cast(float, w << 16); }
HD float bfhi(unsigned w) { return __builtin_bit_cast(float, w & 0xffff0000u); }

HD float2 cadd(float2 a, float2 b) { return make_float2(a.x + b.x, a.y + b.y); }
HD float2 csub(float2 a, float2 b) { return make_float2(a.x - b.x, a.y - b.y); }
HD float2 cmul(float2 a, float2 b) { return make_float2(a.x * b.x - a.y * b.y, a.x * b.y + a.y * b.x); }
HD float2 cmulc(float2 a, float2 b) { return make_float2(a.x * b.x + a.y * b.y, a.y * b.x - a.x * b.y); }
HD float2 cconj(float2 a) { return make_float2(a.x, -a.y); }

constexpr int FN = 16384;
HD int PI(int p) { return p + ((p >> 5) << 1); }
constexpr int FBUF_F2 = FN + (FN >> 5) * 2;
HD int fpos(int k) { return ((k & 15) << 10) | (((k >> 4) & 15) << 6) | (((k >> 8) & 3) << 4) | (k >> 10); }
HD int frev(int p) { return (p >> 10) | (((p >> 6) & 15) << 4) | (((p >> 4) & 3) << 8) | ((p & 15) << 10); }

typedef float v2f __attribute__((ext_vector_type(2)));
typedef _Float16 h2 __attribute__((ext_vector_type(2)));
template <class V> HD V mk2(float a, float b);
template <> HD v2f mk2<v2f>(float a, float b) { return (v2f){a, b}; }
template <> HD h2 mk2<h2>(float a, float b) { return (h2){(_Float16)a, (_Float16)b}; }
HD v2f tof(v2f a) { return a; }
HD v2f tof(h2 a) { return (v2f){(float)a.x, (float)a.y}; }
template <class V> HD V vswap(V a) { return __builtin_shufflevector(a, a, 1, 0); }
template <class V> HD V cmulv(V a, V w) { const V wr = __builtin_shufflevector(w, w, 0, 0); V wi = w; wi.x = -w.y; wi.y = w.y; return a * wr + vswap(a) * wi; }
template <class V> HD V rot_mi(V a) { return vswap(a) * mk2<V>(1.f, -1.f); }
template <class V> HD V rot_pi(V a) { return vswap(a) * mk2<V>(-1.f, 1.f); }
template <bool INV, class V> HD void dft4(V& a, V& b, V& c, V& d) {
    const V t0 = a + c, t1 = a - c, t2 = b + d, t3 = b - d;
    a = t0 + t2; c = t0 - t2;
    if (!INV) { b = t1 + rot_mi(t3); d = t1 + rot_pi(t3); }
    else      { b = t1 + rot_pi(t3); d = t1 + rot_mi(t3); }
}
template <bool INV, class V> HD void dft16(V (&x)[16]) {
    const float C1 = 0.92387953251128674f, S1 = 0.38268343236508977f, R2 = 0.70710678118654752f;
#pragma unroll
    for (int a = 0; a < 4; ++a) dft4<INV, V>(x[a], x[a + 4], x[a + 8], x[a + 12]);
    const float sg = INV ? 1.f : -1.f;
    x[1 + 4] = cmulv(x[1 + 4], mk2<V>(C1, sg * S1));
    x[1 + 8] = cmulv(x[1 + 8], mk2<V>(R2, sg * R2));
    x[1 + 12] = cmulv(x[1 + 12], mk2<V>(S1, sg * C1));
    x[2 + 4] = cmulv(x[2 + 4], mk2<V>(R2, sg * R2));
    x[2 + 8] = INV ? rot_pi(x[2 + 8]) : rot_mi(x[2 + 8]);
    x[2 + 12] = cmulv(x[2 + 12], mk2<V>(-R2, sg * R2));
    x[3 + 4] = cmulv(x[3 + 4], mk2<V>(S1, sg * C1));
    x[3 + 8] = cmulv(x[3 + 8], mk2<V>(-R2, sg * R2));
    x[3 + 12] = cmulv(x[3 + 12], mk2<V>(-C1, -sg * S1));
#pragma unroll
    for (int b = 0; b < 4; ++b) dft4<INV, V>(x[4 * b], x[4 * b + 1], x[4 * b + 2], x[4 * b + 3]);
}
HD float2 twid(float frac) {
    float s, c;
#if defined(__HIP_DEVICE_COMPILE__)
    sincospif(2.f * frac, &s, &c);
#else
    s = sinf(6.283185307179586f * frac); c = cosf(6.283185307179586f * frac);
#endif
    return make_float2(c, -s);
}
HD float2 twnf(const float2* tw, int j, int n) {
#if defined(__HIP_DEVICE_COMPILE__)
    return tw[j * (32768 / n)];
#else
    (void)tw; return twid((float)j / (float)n);
#endif
}
HD int PIx(v2f*, int p) { return p + ((p >> 5) << 1); }
HD int PIx(h2*, int p) { return p + ((p >> 6) << 2); }
constexpr int FBUF_H2 = FN + (FN >> 6) * 4;
template <int STRIDE> HD constexpr int poffx(v2f*, int m) { return STRIDE >= 32 ? m * (STRIDE + 2 * (STRIDE / 32)) : (STRIDE == 16 ? 16 * m + 2 * (m >> 1) : m); }
template <int STRIDE> HD constexpr int poffx(h2*, int m) { return STRIDE >= 64 ? m * (STRIDE + 4 * (STRIDE / 64)) : m * STRIDE; }
template <class V> HD void wpowers(V w1, V (&w)[16]) {
    w[1] = w1; w[2] = cmulv(w1, w1); w[3] = cmulv(w[2], w1); w[4] = cmulv(w[2], w[2]);
    w[5] = cmulv(w[4], w1); w[6] = cmulv(w[4], w[2]); w[7] = cmulv(w[4], w[3]); w[8] = cmulv(w[4], w[4]);
#pragma unroll
    for (int i = 1; i < 8; ++i) w[8 + i] = cmulv(w[8], w[i]);
}
template <bool INV, int N, int STRIDE, class V> HD void bfly16_core(V (&x)[16], unsigned j, const float2* tw) {
    if (STRIDE > 1) {
        const float2 t = twnf(tw, (int)j, N);
        V w[16]; wpowers(mk2<V>(t.x, INV ? -t.y : t.y), w);
        if (INV) {
#pragma unroll
            for (int m = 1; m < 16; ++m) x[m] = cmulv(x[m], w[m]);
            dft16<INV, V>(x);
        } else {
            dft16<INV, V>(x);
#pragma unroll
            for (int q = 1; q < 16; ++q) { const int s = (q >> 2) + 4 * (q & 3); x[s] = cmulv(x[s], w[q]); }
        }
    } else dft16<INV, V>(x);
}
template <bool INV, int N, int STRIDE, class V> HD void fft_bfly16(V* buf, unsigned bf, const float2* tw) {
    const unsigned blk = bf / STRIDE, j = bf % STRIDE, base = blk * N + j;
    V* b = buf + PIx((V*)nullptr, (int)base);
    V x[16];
#pragma unroll
    for (int m = 0; m < 16; ++m) x[m] = b[poffx<STRIDE>((V*)nullptr, m)];
    bfly16_core<INV, N, STRIDE, V>(x, j, tw);
#pragma unroll
    for (int q = 0; q < 16; ++q) b[poffx<STRIDE>((V*)nullptr, q)] = x[(q >> 2) + 4 * (q & 3)];
}
template <bool INV, int N, int STRIDE, class V> HD void fft_bfly4(V* buf, unsigned bf, const float2* tw) {
    const unsigned blk = bf / STRIDE, j = bf % STRIDE, base = blk * N + j;
    V* b = buf + PIx((V*)nullptr, (int)base);
    V x[4];
#pragma unroll
    for (int m = 0; m < 4; ++m) x[m] = b[poffx<STRIDE>((V*)nullptr, m)];
    const float2 t = twnf(tw, (int)j, N);
    const V w1 = mk2<V>(t.x, INV ? -t.y : t.y), w2 = cmulv(w1, w1), w3 = cmulv(w2, w1);
    if (INV) { x[1] = cmulv(x[1], w1); x[2] = cmulv(x[2], w2); x[3] = cmulv(x[3], w3); }
    dft4<INV, V>(x[0], x[1], x[2], x[3]);
    if (!INV) { x[1] = cmulv(x[1], w1); x[2] = cmulv(x[2], w2); x[3] = cmulv(x[3], w3); }
#pragma unroll
    for (int q = 0; q < 4; ++q) b[poffx<STRIDE>((V*)nullptr, q)] = x[q];
}
#ifndef HYV
#define HYV h2
#endif
template <class V> struct YScale { static constexpr float v = 1.f; };
template <> struct YScale<h2> { static constexpr float v = 128.f; };
constexpr float HY_YS = YScale<HYV>::v;
HD unsigned ldpairw(const bf16_t* p, unsigned bf, int m) { return *(const unsigned*)(p + 2 * (bf + 1024u * (unsigned)m)); }
HD v2f pairf(unsigned w) { return (v2f){bflo(w), bfhi(w)}; }
HD void hy_load8(const bf16_t* p, unsigned bf, unsigned (&w)[8]) {
#pragma unroll
    for (int m = 0; m < 8; ++m) w[m] = ldpairw(p, bf, m);
}
template <class V> HD void hy_step_a(V* buf, unsigned bf, const unsigned (&pa)[8], const float2* tw) {
    V x[16];
#pragma unroll
    for (int m = 0; m < 8; ++m) x[m] = mk2<V>(bflo(pa[m]), bfhi(pa[m]));
#pragma unroll
    for (int m = 8; m < 16; ++m) x[m] = mk2<V>(0.f, 0.f);
    bfly16_core<false, 16384, 1024, V>(x, bf, tw);
    V* b = buf + PIx((V*)nullptr, (int)bf);
#pragma unroll
    for (int q = 0; q < 16; ++q) b[poffx<1024>((V*)nullptr, q)] = x[(q >> 2) + 4 * (q & 3)];
}
template <class V> HD void hy_step_b(V* buf, unsigned bf, const unsigned (&pa)[8], const unsigned (&pb)[8], float bias0, float ys, v2f (&z1)[8], const float2* tw) {
    V* b = buf + PIx((V*)nullptr, (int)bf);
    V x[16];
#pragma unroll
    for (int m = 0; m < 16; ++m) x[m] = b[poffx<1024>((V*)nullptr, m)];
    bfly16_core<true, 16384, 1024, V>(x, bf, tw);
    V y[16];
#pragma unroll
    for (int q = 0; q < 8; ++q) { const v2f a = pairf(pa[q]), c = pairf(pb[q]); z1[q] = c * (tof(x[(q >> 2) + 4 * (q & 3)]) * ys + a * bias0); y[q] = mk2<V>(z1[q].x, z1[q].y); }
#pragma unroll
    for (int q = 8; q < 16; ++q) y[q] = mk2<V>(0.f, 0.f);
    bfly16_core<false, 16384, 1024, V>(y, bf, tw);
#pragma unroll
    for (int q = 0; q < 16; ++q) b[poffx<1024>((V*)nullptr, q)] = y[(q >> 2) + 4 * (q & 3)];
}
template <class V> HD void hy_step_c(const V* buf, unsigned bf, const unsigned (&pc)[8], const v2f (&z1)[8], float bias1, float ys, bf16_t* outp, const float2* tw) {
    const V* b = buf + PIx((V*)nullptr, (int)bf);
    V x[16];
#pragma unroll
    for (int m = 0; m < 16; ++m) x[m] = b[poffx<1024>((V*)nullptr, m)];
    bfly16_core<true, 16384, 1024, V>(x, bf, tw);
#pragma unroll
    for (int q = 0; q < 8; ++q) { const v2f c = pairf(pc[q]); const v2f o = c * (tof(x[(q >> 2) + 4 * (q & 3)]) * ys + z1[q] * bias1);
        *(unsigned*)(outp + 2 * (bf + 1024u * (unsigned)q)) = pk2(o.x, o.y); }
}
template <bool INV, class V> HD void fft_pass(V* buf, int p, int tid, const float2* tw = nullptr) {
    const int pp = INV ? 3 - p : p;
    if (pp == 0) {
#pragma unroll 2
        for (int i = 0; i < 2; ++i) fft_bfly16<INV, 16384, 1024, V>(buf, (unsigned)(tid + NTH * i), tw); }
    else if (pp == 1) {
#pragma unroll 2
        for (int i = 0; i < 2; ++i) fft_bfly16<INV, 1024, 64, V>(buf, (unsigned)(tid + NTH * i), tw); }
    else if (pp == 2) {
#pragma unroll 2
        for (int i = 0; i < 8; ++i) fft_bfly4<INV, 64, 16, V>(buf, (unsigned)(tid + NTH * i), tw); }
    else {
#pragma unroll 2
        for (int i = 0; i < 2; ++i) fft_bfly16<INV, 16, 1, V>(buf, (unsigned)(tid + NTH * i), tw); }
}
struct HPair { float2 hk, hl; };
HD void pair_unpack(float2 ck, float2 cl, float2 w, float2& ak, float2& al) {
    const float2 e = make_float2(0.5f * (ck.x + cl.x), 0.5f * (ck.y - cl.y));
    const float2 dd = make_float2(0.5f * (ck.x - cl.x), 0.5f * (ck.y + cl.y));
    const float2 o = make_float2(dd.y, -dd.x);
    const float2 wo = cmul(w, o);
    ak = cadd(e, wo); al = cconj(csub(e, wo));
}
HD void pair_pack(float2 yk, float2 yl, float2 w, float2& dk, float2& dl) {
    const float2 ye = make_float2(0.5f * (yk.x + yl.x), 0.5f * (yk.y - yl.y));
    const float2 dd = make_float2(0.5f * (yk.x - yl.x), 0.5f * (yk.y + yl.y));
    const float2 yo = cmulc(dd, w);
    dk = make_float2(ye.x - yo.y, ye.y + yo.x);
    dl = make_float2(ye.x + yo.y, -ye.y + yo.x);
}
HD void pair_item_pos(int e, int& p, int& k, int& pl) { p = 16 * (e >> 3) + (e & 7); k = frev(p); pl = fpos((FN - k) & (FN - 1)); }
HD float2 twn2(const float2* t12, int k) {
#if defined(__HIP_DEVICE_COMPILE__)
    return cmul(t12[k & 255], t12[256 + (k >> 8)]);
#else
    (void)t12; return twid((float)k / (float)(2 * FN));
#endif
}
HD float2 ldc(const v2f* b, int p) { const v2f v = b[PIx((v2f*)nullptr, p)]; return make_float2(v.x, v.y); }
HD float2 ldc(const h2* b, int p) { const h2 v = b[PIx((h2*)nullptr, p)]; return make_float2((float)v.x, (float)v.y); }
HD void stc(v2f* b, int p, float2 v) { b[PIx((v2f*)nullptr, p)] = (v2f){v.x, v.y}; }
HD void stc(h2* b, int p, float2 v) { b[PIx((h2*)nullptr, p)] = mk2<h2>(v.x, v.y); }
HD HPair pair_filter(const v2f* buf, int e, float sc, const float2* tw = nullptr) {
    int p, k, pl; pair_item_pos(e, p, k, pl);
    HPair h;
    if (e == 0) {
        const float2 c0 = ldc(buf, 0), c8 = ldc(buf, fpos(FN / 2));
        h.hk = make_float2((c0.x + c0.y) * sc, (c0.x - c0.y) * sc);
        h.hl = make_float2(c8.x * sc, -c8.y * sc);
        return h;
    }
    const float2 ck = ldc(buf, p), cl = ldc(buf, pl);
    float2 ak, al; pair_unpack(ck, cl, twn2(tw, k), ak, al);
    h.hk = make_float2(ak.x * sc, ak.y * sc); h.hl = make_float2(al.x * sc, al.y * sc);
    return h;
}
template <class V> HD void pair_apply(V* buf, int e, const HPair& h, const float2* tw = nullptr) {
    int p, k, pl; pair_item_pos(e, p, k, pl);
    if (e == 0) {
        const float2 c0 = ldc(buf, 0);
        const float y0 = (c0.x + c0.y) * h.hk.x, yL = (c0.x - c0.y) * h.hk.y;
        stc(buf, 0, make_float2(0.5f * (y0 + yL), 0.5f * (y0 - yL)));
        const int p8 = fpos(FN / 2);
        const float2 c8 = ldc(buf, p8);
        const float2 y8 = cmul(cconj(c8), h.hl);
        stc(buf, p8, cconj(y8));
        return;
    }
    const float2 ck = ldc(buf, p), cl = ldc(buf, pl);
    const float2 w = twn2(tw, k);
    float2 ak, al; pair_unpack(ck, cl, w, ak, al);
    const float2 yk = cmul(ak, h.hk), yl = cmul(al, h.hl);
    float2 dk, dl; pair_pack(yk, yl, w, dk, dl);
    stc(buf, p, dk); stc(buf, pl, dl);
}
HD int fidx(int n) { return PI(n >> 1) * 2 + (n & 1); }

template <int N> HD void bitonic_sort_desc(unsigned (&k)[N]) {
#pragma unroll
    for (int size = 2; size <= N; size <<= 1)
#pragma unroll
        for (int stride = size >> 1; stride > 0; stride >>= 1)
#pragma unroll
            for (int i = 0; i < N; ++i) { const int j = i ^ stride;
                if (j > i) { const bool up = (i & size) != 0;
                    const unsigned a = k[i], b = k[j], mx = a > b ? a : b, mn = a > b ? b : a;
                    k[i] = up ? mn : mx; k[j] = up ? mx : mn; } }
}
template <int N> HD void bitonic_merge_desc(unsigned (&k)[N]) {
#pragma unroll
    for (int stride = N >> 1; stride > 0; stride >>= 1)
#pragma unroll
        for (int i = 0; i < N; ++i) { const int j = i ^ stride;
            if (j > i) { const unsigned a = k[i], b = k[j]; k[i] = a > b ? a : b; k[j] = a > b ? b : a; } }
}
HD int t5_bucket(int rel) {
    const int n = rel < 0 ? -rel : rel;
    int b = rel > 0 ? 16 : 0;
    if (n < 8) return b + n;
    int nn = n * n, lg = 0;
    while ((nn >> (lg + 1)) != 0) ++lg;
    int large = lg + 2;
    if (large > 15) large = 15;
    return b + large;
}

#define LAS __attribute__((address_space(3)))
#define GAS __attribute__((address_space(1)))
typedef const Params __attribute__((address_space(4)))* KParams;
DV KParams kparams() { KParams kp = (KParams)__builtin_amdgcn_kernarg_segment_ptr(); asm volatile("" : "+s"(kp)); return kp; }
DV int opaque_s(int v) { asm volatile("" : "+s"(v)); return v; }
DV int tid_() { int v = threadIdx.x; asm volatile("" : "+v"(v)); return v; }
DV int wave_() { return __builtin_amdgcn_readfirstlane(tid_() >> 6); }
DV float wave_sum(float v) {
#pragma unroll
    for (int o = 1; o < 64; o <<= 1) v += __shfl_xor(v, o);
    return v;
}
DV float wave_max(float v) {
#pragma unroll
    for (int o = 1; o < 64; o <<= 1) v = fmaxf(v, __shfl_xor(v, o));
    return v;
}
DV void glds16(const void* g, void* l) {
    __builtin_amdgcn_global_load_lds((const GAS unsigned*)g, (LAS unsigned*)l, 16, 0, 0);
}
DV u32x4 ldg16(const void* p) { return *(const u32x4*)p; }
DV void stg16(void* p, u32x4 v) { *(u32x4*)p = v; }

DV void cvt_job(const float* src, bf16_t* dst, size_t n, int bid, int nblk) {
    const size_t n8 = n / 8;
    for (size_t i = (size_t)bid * NTH + tid_(); i < n8; i += (size_t)nblk * NTH) {
        const f32x4 a = *(const f32x4*)(src + i * 8), b = *(const f32x4*)(src + i * 8 + 4);
        u32x4 o; o.x = pk2(a.x, a.y); o.y = pk2(a.z, a.w); o.z = pk2(b.x, b.y); o.w = pk2(b.z, b.w);
        stg16(dst + i * 8, o);
    }
}
DV void transpose_item(const float* W, int K, int N, bf16_t* WT, int item, float* s  ) {
    const int ntn = N / 64, kb = item / ntn, nb = item - kb * ntn, k0 = kb * 64, n0 = nb * 64, tid = tid_();
    __syncthreads();
#pragma unroll
    for (int i = 0; i < 8; ++i) { const int idx = tid + i * NTH, r = idx >> 6, c = idx & 63; s[r * 65 + c] = W[(size_t)(k0 + r) * N + n0 + c]; }
    __syncthreads();
#pragma unroll
    for (int i = 0; i < 4; ++i) { const int idx = tid + i * NTH, n = idx >> 5, kp = idx & 31;
        *(unsigned*)(WT + (size_t)(n0 + n) * K + k0 + 2 * kp) = pk2(s[(2 * kp) * 65 + n], s[(2 * kp + 1) * 65 + n]); }
}
DV void transpose_job(const float* W, int K, int N, bf16_t* WT, int bid, int nblk, float* s) {
    const int items = (K / 64) * (N / 64);
    for (int it = bid; it < items; it += nblk) transpose_item(W, K, N, WT, it, s);
}
DV void filter_mlp_job(KParams p, int bid, int nblk) {
    const int lane = tid_() & 63, wv = wave_();
    bf16_t* h3 = (bf16_t*)(p->ws + WS_H3);
    const int gw = bid * 8 + wv, nw = nblk * 8, l = gw & 1;
    const float* w_in = p->in[10] + (size_t)l * FEMB * FHID;
    const float* w_mid = p->in[11] + (size_t)l * 2 * FHID * FHID;
    const float* fb = p->in[12] + (size_t)l * 3 * FHID;
    const float* ff = p->in[13] + (size_t)l * 3 * FHID;
    unsigned wi[17], wm[2][FHID / 2];
#pragma unroll
    for (int i = 0; i < 16; ++i) wi[i] = pk2(w_in[(2 * i) * FHID + lane], w_in[(2 * i + 1) * FHID + lane]);
    wi[16] = pk2(w_in[32 * FHID + lane], 0.f);
#pragma unroll
    for (int q = 0; q < 2; ++q)
#pragma unroll
        for (int i = 0; i < FHID / 2; ++i) wm[q][i] = pk2(w_mid[(q * FHID + 2 * i) * FHID + lane], w_mid[(q * FHID + 2 * i + 1) * FHID + lane]);
    const float b0 = fb[lane], b1 = fb[FHID + lane], b2 = fb[2 * FHID + lane], f0 = ff[lane], f1 = ff[FHID + lane], f2 = ff[2 * FHID + lane];
#pragma unroll 1
    for (int pos = gw >> 1; pos < SEQL; pos += nw >> 1) {
        const float tt = (float)pos / (float)(SEQL - 1);
        const float wang = 6.283185307179586f * (float)pos / (float)SEQL;
        float zf = 0.f;
        if (lane == 0) zf = tt;
        else if (lane < 33) { const int bi = (lane - 1) & 15; const float band = 1e-4f + (float)bi * ((15.f - 1e-4f) / 15.f); const float ang = wang * band;
            zf = lane <= 16 ? __cosf(ang) : -__sinf(ang); }
        float acc = 0.f;
#pragma unroll
        for (int i = 0; i < 16; ++i) { acc += __shfl(zf, 2 * i) * bflo(wi[i]); acc += __shfl(zf, 2 * i + 1) * bfhi(wi[i]); }
        acc += __shfl(zf, 32) * bflo(wi[16]);
        float h = __sinf(f0 * (acc + b0));
        float a2 = 0.f;
#pragma unroll
        for (int i = 0; i < FHID / 2; ++i) { a2 += __shfl(h, 2 * i) * bflo(wm[0][i]); a2 += __shfl(h, 2 * i + 1) * bfhi(wm[0][i]); }
        h = __sinf(f1 * (a2 + b1));
        a2 = 0.f;
#pragma unroll
        for (int i = 0; i < FHID / 2; ++i) { a2 += __shfl(h, 2 * i) * bflo(wm[1][i]); a2 += __shfl(h, 2 * i + 1) * bfhi(wm[1][i]); }
        h = __sinf(f2 * (a2 + b2));
        h3[((size_t)l * SEQL + pos) * FHID + lane] = f2bf(h);
    }
}

constexpr int G_BM = 256, G_BN = 128, G_BK = 32;
constexpr int G_ABYTES = G_BM * G_BK * 2, G_BBYTES = G_BN * G_BK * 2, G_STAGE = G_ABYTES + G_BBYTES;
constexpr int G_LDS = 2 * G_STAGE;
DV void gemm_stage(const bf16_t* A, int lda, const bf16_t* Bt, int ldb, int kt, unsigned char* sbuf) {
    const int tid = tid_();
#pragma unroll
    for (int i = 0; i < 2; ++i) { const int b = tid * 16 + i * 8192, r = b >> 6, c = (b & 63) >> 1;
        glds16(A + (size_t)r * lda + kt * G_BK + c, sbuf + b); }
    { const int b = tid * 16, r = b >> 6, c = (b & 63) >> 1;
        glds16(Bt + (size_t)r * ldb + kt * G_BK + c, sbuf + G_ABYTES + b); }
}
DV void gemm_kloop(f32x4 (&acc)[4][4], const bf16_t* A, int lda, const bf16_t* Bt, int ldb, int nk, unsigned char* smem) {
    const int lane = tid_() & 63, wid = wave_(), wr = wid >> 1, wc = wid & 1, fr = lane & 15, fq = lane >> 4;
    __syncthreads();
    gemm_stage(A, lda, Bt, ldb, 0, smem);
#pragma unroll 1
    for (int t = 0; t < nk; ++t) {
        unsigned char* cur = smem + (t & 1) * G_STAGE;
        asm volatile("s_waitcnt vmcnt(0)" ::: "memory");
        __syncthreads();
        if (t + 1 < nk) gemm_stage(A, lda, Bt, ldb, t + 1, smem + ((t + 1) & 1) * G_STAGE);
        bf16x8 a[4], b[4];
#pragma unroll
        for (int m = 0; m < 4; ++m) a[m] = *(const bf16x8*)(cur + (wr * 64 + m * 16 + fr) * 64 + fq * 16);
#pragma unroll
        for (int n = 0; n < 4; ++n) b[n] = *(const bf16x8*)(cur + G_ABYTES + (wc * 64 + n * 16 + fr) * 64 + fq * 16);
#pragma unroll
        for (int m = 0; m < 4; ++m)
#pragma unroll
            for (int n = 0; n < 4; ++n) acc[m][n] = __builtin_amdgcn_mfma_f32_16x16x32_bf16(b[n], a[m], acc[m][n], 0, 0, 0);
    }
}
DV void acc_zero(f32x4 (&acc)[4][4]) {
#pragma unroll
    for (int m = 0; m < 4; ++m)
#pragma unroll
        for (int n = 0; n < 4; ++n) acc[m][n] = (f32x4){0.f, 0.f, 0.f, 0.f};
}
struct TileCoord { int row0, col0, wr, wc, fr, fq; };
DV TileCoord tile_coord(int pm, int pn) {
    const int lane = tid_() & 63, wid = wave_();
    TileCoord c; c.row0 = pm * G_BM; c.col0 = pn * G_BN; c.wr = wid >> 1; c.wc = wid & 1; c.fr = lane & 15; c.fq = lane >> 4; return c;
}
DV void epi_store_bf16(const f32x4 (&acc)[4][4], const TileCoord& c, bf16_t* O, int ldo, int ocol0, const float* bias  ) {
#pragma unroll
    for (int n = 0; n < 4; ++n) {
        const int cl = c.wc * 64 + n * 16 + c.fq * 4;
        f32x4 bv = (f32x4){0.f, 0.f, 0.f, 0.f};
        if (bias) bv = *(const f32x4*)(bias + cl);
#pragma unroll
        for (int m = 0; m < 4; ++m) {
            const int row = c.row0 + c.wr * 64 + m * 16 + c.fr;
            const f32x4 v = acc[m][n] + bv;
            u32x2 o; o.x = pk2(v.x, v.y); o.y = pk2(v.z, v.w);
            *(u32x2*)(O + (size_t)row * ldo + ocol0 + cl) = o;
        }
    }
}

DV void filt_tile(KParams p, int l, int tile, unsigned char* smem) {
    const int pm = tile >> 7, pn = tile & 127;
    const TileCoord c = tile_coord(pm, pn);
    const bf16_t* A = (const bf16_t*)(p->ws + WS_WOT) + (size_t)l * 2048 * FHID;
    const bf16_t* Bt = (const bf16_t*)(p->ws + WS_H3) + (size_t)l * SEQL * FHID;
    f32x4 acc[4][4]; acc_zero(acc);
    gemm_kloop(acc, A + (size_t)c.row0 * FHID, FHID, Bt + (size_t)c.col0 * FHID, FHID, FHID / G_BK, smem);
    epi_store_bf16(acc, c, (bf16_t*)(p->ws + WS_FILT), SEQL, c.col0, nullptr);
}
DV void ln_job(const float* gq, const float* bq, const bf16_t* src, bf16_t* dstb, float* dstf, int bid, int nblk, unsigned char* dst8 = nullptr) {
    const int lane = tid_() & 63, wv = wave_();
    const size_t step = (size_t)nblk * 8;
    f32x4 gg[4], bb[4];
#pragma unroll
    for (int i = 0; i < 4; ++i) { gg[i] = *(const f32x4*)(gq + lane * 16 + 4 * i); bb[i] = *(const f32x4*)(bq + lane * 16 + 4 * i); }
#pragma unroll 1
    for (size_t row0 = (size_t)bid * 8 + wv; row0 < (size_t)T; row0 += 2 * step) {
        const bool two = row0 + step < (size_t)T; const size_t row1 = two ? row0 + step : row0;
        u32x4 raw[2][2];
        raw[0][0] = ldg16(src + row0 * D + lane * 16); raw[0][1] = ldg16(src + row0 * D + lane * 16 + 8);
        raw[1][0] = ldg16(src + row1 * D + lane * 16); raw[1][1] = ldg16(src + row1 * D + lane * 16 + 8);
#pragma unroll
        for (int k = 0; k < 2; ++k) {
            if (k == 1 && !two) break;
            const size_t row = k ? row1 : row0;
            float v[16];
#pragma unroll
            for (int h = 0; h < 2; ++h) { const u32x4 w = raw[k][h];
                v[8 * h + 0] = bflo(w.x); v[8 * h + 1] = bfhi(w.x); v[8 * h + 2] = bflo(w.y); v[8 * h + 3] = bfhi(w.y); v[8 * h + 4] = bflo(w.z); v[8 * h + 5] = bfhi(w.z); v[8 * h + 6] = bflo(w.w); v[8 * h + 7] = bfhi(w.w); }
            float sm = 0.f;
#pragma unroll
            for (int i = 0; i < 16; ++i) sm += v[i];
            const float mean = wave_sum(sm) * (1.f / D); float s2 = 0.f;
#pragma unroll
            for (int i = 0; i < 16; ++i) { v[i] -= mean; s2 += v[i] * v[i]; }
            const float rstd = rsqrtf(wave_sum(s2) * (1.f / D) + LN_EPS);
#pragma unroll
            for (int i = 0; i < 16; ++i) v[i] = v[i] * rstd * gg[i >> 2][i & 3] + bb[i >> 2][i & 3];
            if (dstb) { u32x4 o0, o1; o0.x = pk2(v[0], v[1]); o0.y = pk2(v[2], v[3]); o0.z = pk2(v[4], v[5]); o0.w = pk2(v[6], v[7]);
                o1.x = pk2(v[8], v[9]); o1.y = pk2(v[10], v[11]); o1.z = pk2(v[12], v[13]); o1.w = pk2(v[14], v[15]);
                stg16(dstb + row * D + lane * 16, o0); stg16(dstb + row * D + lane * 16 + 8, o1);
                if (dst8) {
                    int hw[4];
#pragma unroll
                    for (int i = 0; i < 4; ++i) { int h = 0; h = __builtin_amdgcn_cvt_pk_fp8_f32(v[4 * i], v[4 * i + 1], h, false); h = __builtin_amdgcn_cvt_pk_fp8_f32(v[4 * i + 2], v[4 * i + 3], h, true); hw[i] = h; }
                    stg16(dst8 + row * D + lane * 16, (u32x4){(unsigned)hw[0], (unsigned)hw[1], (unsigned)hw[2], (unsigned)hw[3]}); } }
            else {
#pragma unroll
                for (int i = 0; i < 4; ++i) *(f32x4*)(dstf + row * D + lane * 16 + 4 * i) = (f32x4){v[4 * i], v[4 * i + 1], v[4 * i + 2], v[4 * i + 3]}; }
        }
    }
}
DV void ln1_job(KParams p, int l, int bid, int nblk) { ln_job(p->in[19] + (size_t)l * D, p->in[20] + (size_t)l * D, (const bf16_t*)p->out, (bf16_t*)(p->ws + WS_XB), nullptr, bid, nblk, p->ws + WS_X8); }
namespace pg8 {
constexpr int BM = 256, BK = 64, HALF = 128, HTB = HALF * BK * 2  , STAGE_BYTES = 8 * HTB, NXCD = 8, WGM = 8;
DV int lds_byte(int r, int c) { const int st = (r >> 4) * 2 + (c >> 5), rr = r & 15, cc = c & 31, ob = rr * 64 + cc * 2; return st * 1024 + (ob ^ (((ob >> 9) & 1) << 5)); }
DV void stage_rc(int b, int& R, int& C) { const int st = b / 1024, sb = b % 1024, swz = sb ^ (((sb >> 9) & 1) << 5); R = (st >> 1) * 16 + swz / 64; C = (st & 1) * 32 + (swz % 64) / 2; }
DV int perm32(int rho) { const int n = rho >> 4, i = rho & 15; return 8 * (i >> 2) + 4 * n + (i & 3); }
struct UnitX { const char* A; const char* B; unsigned lda2, ldb2; int nt, tag, pm, pn; };
DV bool static_tile(int nM, int nN, int G, int c, int i, int& pm, int& pn) {
    const int nwg = nM * nN; const long L = (long)i * G + c; if (L >= nwg) return false;
    int wgid = (int)L; { const int q = nwg / NXCD, r = nwg % NXCD, xcd = wgid % NXCD, off = wgid / NXCD; wgid = (xcd < r ? xcd * (q + 1) : r * (q + 1) + (xcd - r) * q) + off; }
    const int nig = WGM * nN, gid = wgid / nig, fm = gid * WGM, gsz = (nM - fm) < WGM ? (nM - fm) : WGM;
    pm = fm + ((wgid % nig) % gsz); pn = (wgid % nig) / gsz; return true;
}
template <class Epi, class Sched>
DV void gemm_stream(LAS unsigned char* lds, const Sched& S, Epi& E) {
    const int tid = tid_(), wid = __builtin_amdgcn_readfirstlane(tid >> 6), lane = tid & 63, wr = wid >> 2, wc = wid & 3, fr = lane & 15, fq = lane >> 4;
    unsigned rA[2], rB[2], c2[2];
#pragma unroll
    for (int i = 0; i < 2; ++i) { int R, C; stage_rc(tid * 16 + i * 8192, R, C); rA[i] = (unsigned)R; rB[i] = (unsigned)(Epi::PERM ? ((R & ~31) + perm32(R & 31)) : R); c2[i] = (unsigned)C * 2u; }
    const size_t kstep = (size_t)(BK * 2);
    const unsigned ldsw = (unsigned)wid * 1024u;
    const int aoff = lds_byte(wr * 64 + fr, fq * 8), boff = lds_byte(wc * 32 + fr, fq * 8);
#define PG8_SA(b, h) (((b) * 2 + (h)) * HTB)
#define PG8_SB(b, h) ((4 + (b) * 2 + (h)) * HTB)
#define PG8_STAGE(bufoff, gbase, voff) do { _Pragma("unroll") for (int _i = 0; _i < 2; ++_i) \
        __builtin_amdgcn_global_load_lds((const GAS unsigned*)((const char*)(gbase) + (voff)[_i]), (LAS unsigned*)(lds + (bufoff) + ldsw + _i * 8192), 16, 0, 0); } while (0)
#define PG8_LDA(dst, b, h) do { _Pragma("unroll") for (int m = 0; m < 4; ++m) _Pragma("unroll") for (int k = 0; k < 2; ++k) dst[m][k] = *(const LAS bf16x8*)(lds + PG8_SA(b, h) + aoff + m * 2048 + k * 1024); } while (0)
#define PG8_LDB(dst, b, h) do { _Pragma("unroll") for (int n = 0; n < 2; ++n) _Pragma("unroll") for (int k = 0; k < 2; ++k) dst[n][k] = *(const LAS bf16x8*)(lds + PG8_SB(b, h) + boff + n * 2048 + k * 1024); } while (0)
#define PG8_MMA(ai, bj, At, Bt) do { __builtin_amdgcn_s_setprio(1); _Pragma("unroll") for (int m = 0; m < 4; ++m) _Pragma("unroll") for (int n = 0; n < 2; ++n) _Pragma("unroll") for (int k = 0; k < 2; ++k) \
        acc[ai][bj][m][n] = __builtin_amdgcn_mfma_f32_16x16x32_bf16(Bt[n][k], At[m][k], acc[ai][bj][m][n], 0, 0, 0); __builtin_amdgcn_s_setprio(0); } while (0)
#define PG8_WAIT_V(n) asm volatile("s_waitcnt vmcnt(" #n ")" ::: "memory")
#define PG8_WAIT_L(n) asm volatile("s_waitcnt lgkmcnt(" #n ")" ::: "memory")
#define PG8_BAR __builtin_amdgcn_s_barrier()
#define PG8_SCHED __builtin_amdgcn_sched_barrier(0)
    UnitX cur, nxt; int ui = 0;
    if (!S.next(0, cur)) return;
    f32x4 acc[2][2][4][2];
#pragma unroll
    for (int a = 0; a < 2; ++a)
#pragma unroll
        for (int b = 0; b < 2; ++b)
#pragma unroll
            for (int m = 0; m < 4; ++m)
#pragma unroll
                for (int n = 0; n < 2; ++n) acc[a][b][m][n] = (f32x4){0.f, 0.f, 0.f, 0.f};
    bf16x8 At[4][2], B0[2][2], B1[2][2];
    const char* cA = cur.A; const char* cB = cur.B;
    unsigned clda = cur.lda2, cldb = cur.ldb2;
    {
        unsigned vA[2], vB[2];
#pragma unroll
        for (int i = 0; i < 2; ++i) { vA[i] = rA[i] * clda + c2[i]; vB[i] = rB[i] * cldb + c2[i]; }
        const size_t hA = (size_t)HALF * clda, hB = (size_t)HALF * cldb;
        PG8_STAGE(PG8_SB(0, 0), cB, vB); PG8_STAGE(PG8_SA(0, 0), cA, vA); PG8_STAGE(PG8_SB(0, 1), cB + hB, vB); PG8_STAGE(PG8_SA(0, 1), cA + hA, vA);
        if (wr == 1) PG8_BAR;
        PG8_WAIT_V(4); PG8_BAR;
        PG8_STAGE(PG8_SB(1, 0), cB + kstep, vB); PG8_STAGE(PG8_SA(1, 0), cA + kstep, vA); PG8_STAGE(PG8_SB(1, 1), cB + hB + kstep, vB);
        PG8_WAIT_V(6); PG8_BAR;
    }
    for (;;) {
        const bool has_next = S.next(ui + 1, nxt);
        const char* nA = has_next ? nxt.A : cA; const char* nB = has_next ? nxt.B : cB;
        const unsigned nlda = has_next ? nxt.lda2 : clda, nldb = has_next ? nxt.ldb2 : cldb;
        const int nt = cur.nt;
#pragma unroll 1
        for (int t = 0; t < nt; t += 2) {
            const bool last = (t == nt - 2);
            const char* a1 = cA + (size_t)(t + 1) * kstep;
            const char* a2 = last ? nA : cA + (size_t)(t + 2) * kstep; const char* b2 = last ? nB : cB + (size_t)(t + 2) * kstep;
            const char* a3 = a2 + kstep; const char* b3 = b2 + kstep;
            const unsigned xlda = last ? nlda : clda, xldb = last ? nldb : cldb;
            unsigned vA[2], xA[2], xB[2];
#pragma unroll
            for (int i = 0; i < 2; ++i) { vA[i] = rA[i] * clda + c2[i]; xA[i] = rA[i] * xlda + c2[i]; xB[i] = rB[i] * xldb + c2[i]; }
            const size_t hA = (size_t)HALF * clda, xhA = (size_t)HALF * xlda, xhB = (size_t)HALF * xldb;
            PG8_LDB(B0, 0, 0); PG8_SCHED; PG8_LDA(At, 0, 0); PG8_STAGE(PG8_SA(1, 1), a1 + hA, vA);
            PG8_WAIT_L(8); PG8_BAR; PG8_WAIT_L(0); PG8_MMA(0, 0, At, B0); PG8_BAR; PG8_SCHED;
            PG8_LDB(B1, 0, 1); PG8_STAGE(PG8_SB(0, 0), b2, xB);
            PG8_BAR; PG8_WAIT_L(0); PG8_MMA(0, 1, At, B1); PG8_BAR;
            PG8_LDA(At, 0, 1); PG8_STAGE(PG8_SA(0, 0), a2, xA);
            PG8_BAR; PG8_WAIT_L(0); PG8_MMA(1, 0, At, B0); PG8_BAR; PG8_SCHED;
            PG8_STAGE(PG8_SB(0, 1), b2 + xhB, xB);
            PG8_WAIT_V(6); PG8_BAR; PG8_MMA(1, 1, At, B1); PG8_BAR;
            PG8_LDB(B0, 1, 0); PG8_SCHED; PG8_LDA(At, 1, 0); PG8_STAGE(PG8_SA(0, 1), a2 + xhA, xA);
            PG8_WAIT_L(8); PG8_BAR; PG8_WAIT_L(0); PG8_MMA(0, 0, At, B0); PG8_BAR; PG8_SCHED;
            PG8_LDB(B1, 1, 1); PG8_STAGE(PG8_SB(1, 0), b3, xB);
            PG8_BAR; PG8_WAIT_L(0); PG8_MMA(0, 1, At, B1); PG8_BAR;
            PG8_LDA(At, 1, 1); PG8_STAGE(PG8_SA(1, 0), a3, xA);
            PG8_BAR; PG8_WAIT_L(0); PG8_MMA(1, 0, At, B0); PG8_BAR; PG8_SCHED;
            PG8_STAGE(PG8_SB(1, 1), b3 + xhB, xB);
            PG8_WAIT_V(6); PG8_BAR; PG8_MMA(1, 1, At, B1); PG8_BAR;
        }
        E(acc, cur, wr, wc, fr, fq);
        if (!has_next) break;
#pragma unroll
        for (int a = 0; a < 2; ++a)
#pragma unroll
            for (int b = 0; b < 2; ++b)
#pragma unroll
                for (int m = 0; m < 4; ++m)
#pragma unroll
                    for (int n = 0; n < 2; ++n) acc[a][b][m][n] = (f32x4){0.f, 0.f, 0.f, 0.f};
        cur = nxt; cA = nA; cB = nB; clda = nlda; cldb = nldb; ++ui;
    }
    PG8_WAIT_V(0);
    if (wr == 0) PG8_BAR;
    PG8_BAR;
#undef PG8_SA
#undef PG8_SB
#undef PG8_STAGE
#undef PG8_LDA
#undef PG8_LDB
#undef PG8_MMA
#undef PG8_WAIT_V
#undef PG8_WAIT_L
#undef PG8_BAR
#undef PG8_SCHED
}
}
DV void pg8_store_bf16_perm(const f32x4 (&acc)[2][2][4][2], bf16_t* O  , int ldo, const float* bias  , int wr, int wc, int fr, int fq) {
    const int col0 = wc * 32 + 8 * fq;
    f32x4 bv[2][2];
#pragma unroll
    for (int bj = 0; bj < 2; ++bj)
#pragma unroll
        for (int n = 0; n < 2; ++n) bv[bj][n] = bias ? *(const f32x4*)(bias + col0 + bj * 128 + 4 * n) : (f32x4){0.f, 0.f, 0.f, 0.f};
#pragma unroll
    for (int ai = 0; ai < 2; ++ai)
#pragma unroll
        for (int m = 0; m < 4; ++m) { bf16_t* rowp = O + (size_t)(ai * 128 + wr * 64 + m * 16 + fr) * ldo + col0;
#pragma unroll
            for (int bj = 0; bj < 2; ++bj) { const f32x4 v0 = acc[ai][bj][m][0] + bv[bj][0], v1 = acc[ai][bj][m][1] + bv[bj][1];
                u32x4 w; w.x = pk2(v0.x, v0.y); w.y = pk2(v0.z, v0.w); w.z = pk2(v1.x, v1.y); w.w = pk2(v1.z, v1.w);
                *(u32x4*)(rowp + bj * 128) = w; } }
}
struct EpiG1 { static constexpr bool PERM = true; KParams p; int l;
    DV void operator()(const f32x4 (&acc)[2][2][4][2], const pg8::UnitX& u, int wr, int wc, int fr, int fq) const {
        bf16_t* O; int ldo, oc; const float* bias = nullptr;
        const int upm = opaque_s(u.pm), upn = opaque_s(u.pn);
        if (u.tag == 0) {
            const int col0 = upn * 256; bias = p->in[6] + (size_t)l * IN_WIDTH + col0;
            if (upn < 3) { O = (bf16_t*)(p->ws + WS_QKV); ldo = 768; oc = col0; }
            else if (upn < 9) { O = (bf16_t*)(p->ws + WS_HY); ldo = HY3; oc = col0 - O_HY; }
            else { O = (bf16_t*)((unsigned char*)p->out + DO_QM); ldo = 512; oc = col0 - O_MQ; }
        } else { O = (bf16_t*)(p->ws + WS_KVMEM) + (size_t)(u.tag - 1) * 768 * D; ldo = D; oc = upn * 256; }
        pg8_store_bf16_perm(acc, O + (size_t)upm * 256 * ldo + oc, ldo, bias, wr, wc, fr, fq);
    }
};
struct SchedG1 { KParams p; int l, G, c;
    DV bool next(int i, pg8::UnitX& u) const {
        int pm, pn;
        if (pg8::static_tile(T / 256, O_GATE / 256, G, c, i, pm, pn)) {
            u.A = (const char*)(p->ws + WS_XB) + (size_t)pm * 256 * 2048; u.B = (const char*)(p->ws + WS_W + l * SZ_WL + OFF_WT_IN) + (size_t)pn * 256 * 2048;
            u.lda2 = 2048; u.ldb2 = 2048; u.nt = 16; u.tag = 0; u.pm = pm; u.pn = pn; return true; }
        if (l != 0) return false;
        const int n1 = (T / 256) * (O_GATE / 256), cnt = (n1 - c + G - 1) / G, j = i - cnt, c2 = (c + G - 64) % G, idx = j * G + c2;
        if (idx >= 24) return false;
        const int ll = idx / 12, r = idx - ll * 12; pm = r >> 2; pn = r & 3;
        u.A = (const char*)(p->ws + WS_MEMB) + (size_t)pm * 256 * 2048; u.B = (const char*)(p->ws + WS_W + ll * SZ_WL + OFF_WT_MKV) + (size_t)pn * 256 * 2048;
        u.lda2 = 2048; u.ldb2 = 2048; u.nt = 16; u.tag = 1 + ll; u.pm = pm; u.pn = pn; return true;
    }
};
struct EpiOut { static constexpr bool PERM = true; KParams p;
    DV void operator()(const f32x4 (&acc)[2][2][4][2], const pg8::UnitX& u, int wr, int wc, int fr, int fq) const {
        const bf16_t* xb = (const bf16_t*)(p->ws + WS_XB); bf16_t* o = (bf16_t*)p->out;
        const int upm = opaque_s(u.pm), upn = opaque_s(u.pn);
        const size_t base = ((size_t)upm * 256 + wr * 64 + fr) * D + upn * 256 + wc * 32 + 8 * fq;
#pragma unroll
        for (int ai = 0; ai < 2; ++ai) {
            u32x4 xv[4][2];
#pragma unroll
            for (int m = 0; m < 4; ++m)
#pragma unroll
                for (int bj = 0; bj < 2; ++bj) xv[m][bj] = ldg16(xb + base + (size_t)(ai * 128 + m * 16) * D + bj * 128);
#pragma unroll
            for (int m = 0; m < 4; ++m)
#pragma unroll
                for (int bj = 0; bj < 2; ++bj) { const u32x4 x = xv[m][bj]; const f32x4 a0 = acc[ai][bj][m][0], a1 = acc[ai][bj][m][1];
                    u32x4 w; w.x = pk2(a0.x + ALPHA * bflo(x.x), a0.y + ALPHA * bfhi(x.x)); w.y = pk2(a0.z + ALPHA * bflo(x.y), a0.w + ALPHA * bfhi(x.y));
                    w.z = pk2(a1.x + ALPHA * bflo(x.z), a1.y + ALPHA * bfhi(x.z)); w.w = pk2(a1.z + ALPHA * bflo(x.w), a1.w + ALPHA * bfhi(x.w));
                    stg16(o + base + (size_t)(ai * 128 + m * 16) * D + bj * 128, w); }
            asm volatile("" ::: "memory"); }
    }
};
struct SchedOut { KParams p; int l, G, c;
    DV bool next(int i, pg8::UnitX& u) const {
        int pm, pn; if (!pg8::static_tile(T / 256, D / 256, G, c, i, pm, pn)) return false;
        u.A = (const char*)(p->ws + WS_HY) + (size_t)T * 512 * 2 + (size_t)pm * 256 * 2048; u.B = (const char*)(p->ws + WS_W + l * SZ_WL + OFF_WT_OUT) + (size_t)pn * 256 * 2048;
        u.lda2 = 2048; u.ldb2 = 2048; u.nt = 16; u.tag = 0; u.pm = pm; u.pn = pn; return true; }
};
struct EpiQ { static constexpr bool PERM = true; KParams p;
    DV void operator()(const f32x4 (&acc)[2][2][4][2], const pg8::UnitX& u, int wr, int wc, int fr, int fq) const {
        pg8_store_bf16_perm(acc, (bf16_t*)p->out + (size_t)opaque_s(u.pm) * 256 * 2048 + opaque_s(u.pn) * 256, 2048, nullptr, wr, wc, fr, fq); }
};
struct SchedQ { KParams p; int l, G, c;
    DV bool next(int i, pg8::UnitX& u) const {
        int pm, pn; if (!pg8::static_tile(T / 256, 2048 / 256, G, c, i, pm, pn)) return false;
        u.A = (const char*)(p->ws + WS_XB) + (size_t)pm * 256 * 2048; u.B = (const char*)(p->ws + WS_W + l * SZ_WL + OFF_WT_Q) + (size_t)pn * 256 * 2048;
        u.lda2 = 2048; u.ldb2 = 2048; u.nt = 16; u.tag = 0; u.pm = pm; u.pn = pn; return true; }
};
struct EpiMerge { static constexpr bool PERM = true; KParams p; int l;
    DV void operator()(const f32x4 (&acc)[2][2][4][2], const pg8::UnitX& u, int wr, int wc, int fr, int fq) const {
        const int n = u.tag >> 1, col0 = wc * 32 + 8 * fq, upm = opaque_s(u.pm), upn = opaque_s(u.pn);
        u32x4* sp = (u32x4*)((unsigned char*)p->out) + (size_t)blockIdx.x * 16 * NTH + threadIdx.x;
        if ((u.tag & 1) == 0) {
            const float* bias = p->in[6] + (size_t)l * IN_WIDTH + O_GATE + n * D + upn * 256 + col0;
            f32x4 bv[2][2];
#pragma unroll
            for (int bj = 0; bj < 2; ++bj)
#pragma unroll
                for (int nn = 0; nn < 2; ++nn) bv[bj][nn] = *(const f32x4*)(bias + bj * 128 + 4 * nn);
#pragma unroll
            for (int ai = 0; ai < 2; ++ai)
#pragma unroll
                for (int m = 0; m < 4; ++m) {
#pragma unroll
                    for (int bj = 0; bj < 2; ++bj) { const f32x4 v0 = acc[ai][bj][m][0] + bv[bj][0], v1 = acc[ai][bj][m][1] + bv[bj][1];
                        u32x4 w;
                        w.x = pk2(__builtin_amdgcn_rcpf(1.f + __expf(-v0.x)), __builtin_amdgcn_rcpf(1.f + __expf(-v0.y))); w.y = pk2(__builtin_amdgcn_rcpf(1.f + __expf(-v0.z)), __builtin_amdgcn_rcpf(1.f + __expf(-v0.w)));
                        w.z = pk2(__builtin_amdgcn_rcpf(1.f + __expf(-v1.x)), __builtin_amdgcn_rcpf(1.f + __expf(-v1.y))); w.w = pk2(__builtin_amdgcn_rcpf(1.f + __expf(-v1.z)), __builtin_amdgcn_rcpf(1.f + __expf(-v1.w)));
                        sp[bj * NTH] = w; }
                    sp += 2 * NTH; asm volatile("" : "+v"(sp)); }
        } else {
            bf16_t* rowp = (bf16_t*)(p->ws + WS_HY) + (size_t)T * 512 + ((size_t)upm * 256 + wr * 64 + fr) * D + upn * 256 + col0;
#pragma unroll
            for (int ai = 0; ai < 2; ++ai) {
                u32x4 g[4][2], o[4][2];
#pragma unroll
                for (int m = 0; m < 4; ++m)
#pragma unroll
                    for (int bj = 0; bj < 2; ++bj) { g[m][bj] = sp[(m * 2 + bj) * NTH]; if (n > 0) o[m][bj] = *(const u32x4*)(rowp + (size_t)m * 16 * D + bj * 128); }
#pragma unroll
                for (int m = 0; m < 4; ++m)
#pragma unroll
                    for (int bj = 0; bj < 2; ++bj) { const f32x4 a0 = acc[ai][bj][m][0], a1 = acc[ai][bj][m][1]; const u32x4 gg = g[m][bj];
                        float r[8] = {bflo(gg.x) * a0.x, bfhi(gg.x) * a0.y, bflo(gg.y) * a0.z, bfhi(gg.y) * a0.w, bflo(gg.z) * a1.x, bfhi(gg.z) * a1.y, bflo(gg.w) * a1.z, bfhi(gg.w) * a1.w};
                        if (n > 0) { const u32x4 oo = o[m][bj];
                            r[0] += bflo(oo.x); r[1] += bfhi(oo.x); r[2] += bflo(oo.y); r[3] += bfhi(oo.y); r[4] += bflo(oo.z); r[5] += bfhi(oo.z); r[6] += bflo(oo.w); r[7] += bfhi(oo.w); }
                        u32x4 w; w.x = pk2(r[0], r[1]); w.y = pk2(r[2], r[3]); w.z = pk2(r[4], r[5]); w.w = pk2(r[6], r[7]);
                        *(u32x4*)(rowp + (size_t)m * 16 * D + bj * 128) = w; }
                sp += 8 * NTH; rowp += 128 * D; asm volatile("" : "+v"(sp), "+v"(rowp)); }
        }
    }
};
struct SchedMerge { KParams p; int l, G, c;
    DV bool next(int i, pg8::UnitX& u) const {
        const int ti = i / 6, sub = i - ti * 6, n = sub >> 1;
        int pm, pn; if (!pg8::static_tile(T / 256, D / 256, G, c, ti, pm, pn)) return false;
        u.tag = sub; u.pm = pm; u.pn = pn;
        if ((sub & 1) == 0) {
            u.A = (const char*)(p->ws + WS_XB) + (size_t)pm * 256 * 2048; u.B = (const char*)(p->ws + WS_W + l * SZ_WL + OFF_WT_IN) + (size_t)(O_GATE + n * D + pn * 256) * 2048;
            u.lda2 = 2048; u.ldb2 = 2048; u.nt = 16;
        } else {
            if (n == 0) { u.A = (const char*)(p->ws + WS_QKV) + (size_t)pm * 256 * 1536; u.lda2 = 1536; }
            else if (n == 1) { u.A = (const char*)(p->ws + WS_HY) + (size_t)pm * 256 * 1024; u.lda2 = 1024; }
            else { u.A = (const char*)p->out + DO_QM + (size_t)pm * 256 * 1024; u.lda2 = 1024; }
            u.B = (const char*)(p->ws + WS_W + l * SZ_WL + OFF_WT_BR) + (size_t)(n * D + pn * 256) * 1024; u.ldb2 = 1024; u.nt = 8;
        }
        return true; }
};
DV void shortconv_item(KParams p, int l, int item, float* s  ) {
    const int tid = tid_();
    const int ct = item % 24, r = item / 24, tt = r % 64, seq = r / 64;
    const int t0 = tt * 256, c0 = ct * 64;
    const bf16_t* hy = (const bf16_t*)(p->ws + WS_HY);
    bf16_t* uct = (bf16_t*)((unsigned char*)p->out + DO_UCT);
    u32x4 v[5];
#pragma unroll
    for (int i = 0; i < 5; ++i) {
        const int idx = tid + i * NTH, rr = idx >> 3, ch = idx & 7, t = t0 + rr - 1;
        v[i] = (u32x4){0u, 0u, 0u, 0u};
        if (idx < 258 * 8 && t >= 0 && t < SEQL) v[i] = ldg16(hy + ((size_t)seq * SEQL + t) * HY3 + c0 + ch * 8);
    }
    __syncthreads();
#pragma unroll
    for (int i = 0; i < 5; ++i) {
        const int idx = tid + i * NTH, rr = idx >> 3, ch = idx & 7;
        if (idx < 258 * 8) { float* d = s + rr * 65 + ch * 8;
            d[0] = bflo(v[i].x); d[1] = bfhi(v[i].x); d[2] = bflo(v[i].y); d[3] = bfhi(v[i].y); d[4] = bflo(v[i].z); d[5] = bfhi(v[i].z); d[6] = bflo(v[i].w); d[7] = bfhi(v[i].w); }
    }
    __syncthreads();
    const int ch = tid >> 3, tq = tid & 7, cg = c0 + ch;
    const float* cw = p->in[7] + (size_t)l * 3 * HY3; const float cb = p->in[8][(size_t)l * HY3 + cg];
    const float w0 = cw[cg], w1 = cw[HY3 + cg], w2 = cw[2 * HY3 + cg];
#pragma unroll
    for (int grp = 0; grp < 4; ++grp) {
        float o[8];
#pragma unroll
        for (int e = 0; e < 8; ++e) { const int rr = grp * 64 + tq * 8 + e; o[e] = cb + w0 * s[rr * 65 + ch] + w1 * s[(rr + 1) * 65 + ch] + w2 * s[(rr + 2) * 65 + ch]; }
        u32x4 ov; ov.x = pk2(o[0], o[1]); ov.y = pk2(o[2], o[3]); ov.z = pk2(o[4], o[5]); ov.w = pk2(o[6], o[7]);
        stg16(uct + ((size_t)seq * HY3 + cg) * SEQL + t0 + grp * 64 + tq * 8, ov);
    }
}
DV void hyo_transpose_item(KParams p, int item, bf16_t* s  ) {
    const int tid = tid_();
    const int ct = item % 8, r = item / 8, tt = r % 64, seq = r / 64;
    const int t0 = tt * 256, c0 = ct * 64;
    const bf16_t* uct = (const bf16_t*)((unsigned char*)p->out + DO_UCT);
    bf16_t* hyo = (bf16_t*)(p->ws + WS_HY);
    u32x4 v[4];
    { const int ch = tid >> 3, tq = tid & 7;
#pragma unroll
      for (int grp = 0; grp < 4; ++grp) v[grp] = ldg16(uct + ((size_t)seq * HY3 + c0 + ch) * SEQL + t0 + grp * 64 + tq * 8);
      __syncthreads();
#pragma unroll
      for (int grp = 0; grp < 4; ++grp) *(u32x4*)(s + ch * 264 + grp * 64 + tq * 8) = v[grp]; }
    __syncthreads();
#pragma unroll
    for (int i4 = 0; i4 < 4; ++i4) { const int idx = tid + i4 * NTH, t = idx >> 3, cq = idx & 7;
      bf16_t e[8];
#pragma unroll
      for (int i = 0; i < 8; ++i) e[i] = s[(cq * 8 + i) * 264 + t];
      u32x4 o; o.x = e[0] | ((unsigned)e[1] << 16); o.y = e[2] | ((unsigned)e[3] << 16); o.z = e[4] | ((unsigned)e[5] << 16); o.w = e[6] | ((unsigned)e[7] << 16);
      stg16(hyo + ((size_t)seq * SEQL + t0 + t) * 512 + c0 + cq * 8, o); }
}

template <bool WIN> struct AttnCfg {
    static constexpr int HDIM = WIN ? 64 : 128, NK = WIN ? 384 : 256, QT = WIN ? 4 : 2, KS = HDIM / 32, DT = HDIM / 16;
    static constexpr int KSTR = HDIM + 8, VSTR = NK + 8;
    static constexpr int K_BYTES = NK * KSTR * 2, V_BYTES = HDIM * VSTR * 2;
};
template <bool WIN> DV void attn_item(KParams p, int l, int item, unsigned char* smem) {
    typedef AttnCfg<WIN> C;
    const int tid = tid_(), lane = tid & 63, w = wave_(), fr = lane & 15, fq = lane >> 4;
    bf16_t* Ks = (bf16_t*)smem; bf16_t* Vt = (bf16_t*)(smem + C::K_BYTES); float* biasT = (float*)(smem + C::K_BYTES + C::V_BYTES);
    int seq, blk, hh;
    if (WIN) { hh = item & 1; blk = (item >> 1) & 127; seq = item >> 8; }
    else { hh = item & 3; blk = (item >> 2) % 64; seq = (item >> 2) / 64; }
    __syncthreads();
    if (WIN) {
        const bf16_t* qkv = (const bf16_t*)(p->ws + WS_QKV);
#pragma unroll
        for (int i = 0; i < 6; ++i) {
            const int idx = tid + i * NTH, key = idx >> 3, ch = idx & 7, pos = blk * 128 - 128 + key;
            u32x4 kv = (u32x4){0u, 0u, 0u, 0u}, vv = kv;
            if (pos >= 0 && pos < SEQL) { const bf16_t* row = qkv + ((size_t)seq * SEQL + pos) * 768; kv = ldg16(row + O_K + hh * 64 + ch * 8); vv = ldg16(row + O_V + hh * 64 + ch * 8); }
            *(u32x4*)(Ks + key * C::KSTR + ch * 8) = kv;
            bf16_t* vd = Vt + (ch * 8) * C::VSTR + key;
            vd[0] = (bf16_t)vv.x; vd[C::VSTR] = (bf16_t)(vv.x >> 16); vd[2 * C::VSTR] = (bf16_t)vv.y; vd[3 * C::VSTR] = (bf16_t)(vv.y >> 16);
            vd[4 * C::VSTR] = (bf16_t)vv.z; vd[5 * C::VSTR] = (bf16_t)(vv.z >> 16); vd[6 * C::VSTR] = (bf16_t)vv.w; vd[7 * C::VSTR] = (bf16_t)(vv.w >> 16);
        }
        for (int i = tid; i < 4 * 257; i += NTH) { const int g = i / 257, r = i - g * 257; biasT[i] = p->in[4][t5_bucket(r - 128) * 8 + hh * 4 + g] * 1.4426950408889634f; }
    } else {
        const bf16_t* kvm = (const bf16_t*)(p->ws + WS_KVMEM) + (size_t)l * 768 * D;
#pragma unroll
        for (int i = 0; i < 8; ++i) {
            const int idx = tid + i * NTH, key = idx >> 4, ch = idx & 15;
            const bf16_t* row = kvm + ((size_t)seq * N_MEM + key) * D;
            const u32x4 kv = ldg16(row + hh * 128 + ch * 8), vv = ldg16(row + 512 + hh * 128 + ch * 8);
            *(u32x4*)(Ks + key * C::KSTR + ch * 8) = kv;
            bf16_t* vd = Vt + (ch * 8) * C::VSTR + key;
            vd[0] = (bf16_t)vv.x; vd[C::VSTR] = (bf16_t)(vv.x >> 16); vd[2 * C::VSTR] = (bf16_t)vv.y; vd[3 * C::VSTR] = (bf16_t)(vv.y >> 16);
            vd[4 * C::VSTR] = (bf16_t)vv.z; vd[5 * C::VSTR] = (bf16_t)(vv.z >> 16); vd[6 * C::VSTR] = (bf16_t)vv.w; vd[7 * C::VSTR] = (bf16_t)(vv.w >> 16);
        }
    }
    bf16_t* qbase; int ldq, qcol0, wrow0; size_t tok0; float sink = 0.f; int g = 0;
    if (WIN) { g = w >> 1; qbase = (bf16_t*)(p->ws + WS_QKV); ldq = 768; qcol0 = (hh * 4 + g) * 64; wrow0 = (w & 1) * 64; tok0 = (size_t)seq * SEQL + blk * 128;
               sink = p->in[9][(size_t)l * 8 + hh * 4 + g] * 1.4426950408889634f; }
    else { qbase = (bf16_t*)((unsigned char*)p->out + DO_QM); ldq = 512; qcol0 = hh * 128; wrow0 = w * 32; tok0 = (size_t)seq * SEQL + blk * 256; }
    bf16x8 bq[C::QT][C::KS];
#pragma unroll
    for (int qt = 0; qt < C::QT; ++qt)
#pragma unroll
        for (int ks = 0; ks < C::KS; ++ks) bq[qt][ks] = *(const bf16x8*)(qbase + (tok0 + wrow0 + qt * 16 + fr) * ldq + qcol0 + ks * 32 + fq * 8);
    f32x4 o[C::QT][C::DT]; float m[C::QT], ls[C::QT];
#pragma unroll
    for (int qt = 0; qt < C::QT; ++qt) { m[qt] = WIN ? sink : -1e30f; ls[qt] = (WIN && fq == 0) ? 1.f : 0.f;
#pragma unroll
        for (int dt = 0; dt < C::DT; ++dt) o[qt][dt] = (f32x4){0.f, 0.f, 0.f, 0.f}; }
    const float scale = (WIN ? 0.125f : 0.08838834764831845f) * 1.4426950408889634f;
    __syncthreads();
#pragma unroll 1
    for (int kc = 0; kc < C::NK / 32; ++kc) {
        bf16x8 ak[2][C::KS];
#pragma unroll
        for (int kt = 0; kt < 2; ++kt)
#pragma unroll
            for (int ks = 0; ks < C::KS; ++ks) ak[kt][ks] = *(const bf16x8*)(Ks + (kc * 32 + kt * 16 + fr) * C::KSTR + ks * 32 + fq * 8);
        bf16x8 av[C::DT];
#pragma unroll
        for (int dt = 0; dt < C::DT; ++dt) {
            const u32x2 v0 = *(const u32x2*)(Vt + (dt * 16 + fr) * C::VSTR + kc * 32 + fq * 4), v1 = *(const u32x2*)(Vt + (dt * 16 + fr) * C::VSTR + kc * 32 + 16 + fq * 4);
            u32x4 vv; vv.x = v0.x; vv.y = v0.y; vv.z = v1.x; vv.w = v1.y; av[dt] = __builtin_bit_cast(bf16x8, vv);
        }
#pragma unroll
        for (int qt = 0; qt < C::QT; ++qt) {
            const int r0 = wrow0 + qt * 16;
            if (WIN && !(kc * 32 + 31 >= r0 && kc * 32 <= r0 + 271)) continue;
            f32x4 s0 = (f32x4){0.f, 0.f, 0.f, 0.f}, s1 = s0;
#pragma unroll
            for (int ks = 0; ks < C::KS; ++ks) { s0 = __builtin_amdgcn_mfma_f32_16x16x32_bf16(ak[0][ks], bq[qt][ks], s0, 0, 0, 0); s1 = __builtin_amdgcn_mfma_f32_16x16x32_bf16(ak[1][ks], bq[qt][ks], s1, 0, 0, 0); }
            float sv[8];
            const bool interior = WIN && (kc * 32 >= r0 + 15) && (kc * 32 + 31 - r0 <= 256) && (blk * 128 - 128 + kc * 32 >= 0) && (blk * 128 - 128 + kc * 32 + 31 < SEQL);
            if (interior) {
                const float* bt = biasT + g * 257 + fq * 4 - fr + (kc * 32 - r0);
#pragma unroll
                for (int e = 0; e < 8; ++e) sv[e] = __builtin_fmaf(e < 4 ? s0[e & 3] : s1[e & 3], scale, bt[(e >> 2) * 16 + (e & 3)]);
            } else
#pragma unroll
            for (int e = 0; e < 8; ++e) {
                const float raw = (e < 4 ? s0[e & 3] : s1[e & 3]) * scale;
                if (WIN) {
                    const int jk = kc * 32 + (e >> 2) * 16 + fq * 4 + (e & 3), qi = r0 + fr, rel = jk - qi, pos = blk * 128 - 128 + jk;
                    const bool ok = (rel >= 0) && (rel <= 256) && (pos >= 0) && (pos < SEQL);
                    const int ri = rel < 0 ? 0 : (rel > 256 ? 256 : rel);
                    sv[e] = ok ? raw + biasT[g * 257 + ri] : -1e30f;
                } else sv[e] = raw;
            }
            float cm = fmaxf(fmaxf(fmaxf(sv[0], sv[1]), fmaxf(sv[2], sv[3])), fmaxf(fmaxf(sv[4], sv[5]), fmaxf(sv[6], sv[7])));
            cm = fmaxf(cm, __shfl_xor(cm, 16)); cm = fmaxf(cm, __shfl_xor(cm, 32));
            const float mn = fmaxf(m[qt], cm), al = __builtin_amdgcn_exp2f(m[qt] - mn);
            m[qt] = mn;
            float ps = 0.f; float pe[8];
#pragma unroll
            for (int e = 0; e < 8; ++e) { pe[e] = __builtin_amdgcn_exp2f(sv[e] - mn); ps += pe[e]; }
            ls[qt] = ls[qt] * al + ps;
            u32x4 pw; pw.x = pk2(pe[0], pe[1]); pw.y = pk2(pe[2], pe[3]); pw.z = pk2(pe[4], pe[5]); pw.w = pk2(pe[6], pe[7]);
            const bf16x8 pf = __builtin_bit_cast(bf16x8, pw);
#pragma unroll
            for (int dt = 0; dt < C::DT; ++dt) { o[qt][dt] = o[qt][dt] * al; o[qt][dt] = __builtin_amdgcn_mfma_f32_16x16x32_bf16(av[dt], pf, o[qt][dt], 0, 0, 0); }
        }
    }
#pragma unroll
    for (int qt = 0; qt < C::QT; ++qt) {
        float lt = ls[qt]; lt += __shfl_xor(lt, 16); lt += __shfl_xor(lt, 32);
        const float inv = 1.f / lt;
#pragma unroll
        for (int dt = 0; dt < C::DT; ++dt) {
            const f32x4 v = o[qt][dt] * inv;
            u32x2 ov; ov.x = pk2(v.x, v.y); ov.y = pk2(v.z, v.w);
            *(u32x2*)(qbase + (tok0 + wrow0 + qt * 16 + fr) * ldq + qcol0 + dt * 16 + fq * 4) = ov;
        }
    }
}
constexpr int ATT_LDS_WIN = AttnCfg<true>::K_BYTES + AttnCfg<true>::V_BYTES + 4 * 257 * 4;
constexpr int ATT_LDS_MEM = AttnCfg<false>::K_BYTES + AttnCfg<false>::V_BYTES;

constexpr int FBUF_BYTES = FBUF_F2 * 8;
constexpr int HY_LDS = FBUF_BYTES + 1024 + 288 * 8;
typedef _Float16 h2_t __attribute__((ext_vector_type(2)));
DV HPair unpackH(u32x2 v) {
    const h2_t a = __builtin_bit_cast(h2_t, v.x), b = __builtin_bit_cast(h2_t, v.y);
    const float sc = 1.f / (float)FN;
    HPair h; h.hk = make_float2((float)a.x * sc, (float)a.y * sc); h.hl = make_float2((float)b.x * sc, (float)b.y * sc); return h;
}
DV int opaque(int v) { asm volatile("" : "+v"(v)); return v; }
typedef HYV hyv_t;
template <class V> DV void fft_fwd_123(V* buf, int tid, const float2* tw) {
#pragma unroll 1
    for (int ps = 1; ps < 4; ++ps) { fft_pass<false, V>(buf, ps, opaque(tid), tw); __syncthreads(); }
}
template <class V> DV void fft_inv_012(V* buf, int tid, const float2* tw) {
#pragma unroll 1
    for (int ps = 0; ps < 3; ++ps) { fft_pass<true, V>(buf, ps, opaque(tid), tw); __syncthreads(); }
}
DV void fft_fwd_all(v2f* buf, int tid, const float2* tw) {
#pragma unroll 1
    for (int ps = 0; ps < 4; ++ps) { fft_pass<false, v2f>(buf, ps, opaque(tid), tw); __syncthreads(); }
}
DV void hyena_item(KParams p, int l, int c, unsigned char* smem) {
    const int tid = tid_(), lane = tid & 63, w = wave_();
    v2f* buf = (v2f*)smem; float* fbuf = (float*)smem;
    hyv_t* dbuf = (hyv_t*)smem;
    float* wo = (float*)(smem + FBUF_BYTES); float* red = wo + 128;
    const bf16_t* filt = (const bf16_t*)(p->ws + WS_FILT);
    const float2* tw = (const float2*)(p->ws + WS_TW);
    float2* t12 = (float2*)(smem + FBUF_BYTES + 1024);
    if (tid < 256) t12[tid] = tw[tid]; else if (tid < 288) t12[tid] = tw[(tid - 256) * 256];
    const float min_decay = -3.0701134573253945f, max_decay = -15.350567286626972f;
    const float delta = fabsf(min_decay + (float)c * ((max_decay - min_decay) / 511.f));
#ifdef PROBE_PHASE
#define HSTAMP(i) { __syncthreads(); if (blockIdx.x == 0 && threadIdx.x == 0) __hip_atomic_store((unsigned long long*)(p->ws + WS_TS) + (i), (unsigned long long)__builtin_amdgcn_s_memrealtime(), __ATOMIC_RELAXED, __HIP_MEMORY_SCOPE_AGENT); }
#else
#define HSTAMP(i)
#endif
    HSTAMP(24)
    f32x4* Hs = (f32x4*)(p->ws + WS_HSCR) + (size_t)blockIdx.x * 2 * 8192;
    __syncthreads();
#pragma unroll 1
    for (int o = 0; o < 2; ++o) {
        const bf16_t* ff = filt + (size_t)(o * 1024 + c) * SEQL; const bf16_t* fb = ff + (size_t)512 * SEQL;
        float asum = 0.f;
        u32x4 fva[4], bva[4];
#pragma unroll
        for (int i = 0; i < 4; ++i) { const int pos0 = 8 * (tid + NTH * i); fva[i] = ldg16(ff + pos0); bva[i] = ldg16(fb + pos0); }
#pragma unroll
        for (int i = 0; i < 4; ++i) {
            const int pos0 = 8 * (opaque(tid) + NTH * i);
            const u32x4 fv = fva[i], bv = bva[i];
            const float fw[8] = {bflo(fv.x), bfhi(fv.x), bflo(fv.y), bfhi(fv.y), bflo(fv.z), bfhi(fv.z), bflo(fv.w), bfhi(fv.w)};
            const float bw[8] = {bflo(bv.x), bfhi(bv.x), bflo(bv.y), bfhi(bv.y), bflo(bv.z), bfhi(bv.z), bflo(bv.w), bfhi(bv.w)};
#pragma unroll
            for (int e = 0; e < 8; ++e) {
                const int pos = pos0 + e;
                const float dec = __expf(-((float)pos * (1.f / (float)(SEQL - 1))) * delta);
                const float f = fw[e] * dec, b = bw[e] * dec;
                if (pos == 0) { const float v = f + b; fbuf[fidx(0)] = v; asum += fabsf(v); }
                else { fbuf[fidx(pos)] = f; fbuf[fidx(2 * SEQL - pos)] = b; asum += fabsf(f) + fabsf(b); }
            }
        }
        if (tid == 0) fbuf[fidx(SEQL)] = 0.f;
        asum = wave_sum(asum);
        if (lane == 0) red[w] = asum;
        __syncthreads();
        float norm = 0.f;
#pragma unroll
        for (int i = 0; i < 8; ++i) norm += red[i];
        fft_fwd_all(buf, tid, tw);
        const float sc = HY_YS / (norm * (float)FN);
#pragma unroll 2
        for (int i = 0; i < 16; ++i) { const HPair hp = pair_filter(buf, opaque(tid) + NTH * i, sc, t12);
            Hs[o * 8192 + tid + NTH * i] = (f32x4){hp.hk.x, hp.hk.y, hp.hl.x, hp.hl.y}; }
        __syncthreads();
    }
    const float bias0 = p->in[15][(size_t)l * 2 * HYW + c], bias1 = p->in[15][(size_t)l * 2 * HYW + HYW + c];
    bf16_t* uct = (bf16_t*)((unsigned char*)p->out + DO_UCT);
    unsigned pa[2][8];
#pragma unroll
    for (int i = 0; i < 2; ++i) hy_load8(uct + (size_t)c * SEQL, (unsigned)(tid + NTH * i), pa[i]);
#pragma unroll 1
    for (int s = 0; s < NSEQ; ++s) {
        bf16_t* p0 = uct + ((size_t)s * HY3 + c) * SEQL; const bf16_t* p1 = p0 + (size_t)HYW * SEQL; const bf16_t* p2 = p0 + (size_t)2 * HYW * SEQL;
        v2f z1[2][8];
#pragma unroll
        for (int i = 0; i < 2; ++i) hy_step_a(dbuf, (unsigned)(opaque(tid) + NTH * i), pa[i], tw);
        __syncthreads();
        { unsigned pb[2][8];
          fft_fwd_123(dbuf, tid, tw);
#pragma unroll 4
          for (int i = 0; i < 16; ++i) { const f32x4 hv = Hs[0 * 8192 + tid + NTH * i]; HPair hp; hp.hk = make_float2(hv.x, hv.y); hp.hl = make_float2(hv.z, hv.w);
              pair_apply(dbuf, opaque(tid) + NTH * i, hp, t12); }
          __syncthreads();
#pragma unroll
          for (int i = 0; i < 2; ++i) hy_load8(p1, (unsigned)(tid + NTH * i), pb[i]);
          fft_inv_012(dbuf, tid, tw);
#pragma unroll
          for (int i = 0; i < 2; ++i) hy_step_b(dbuf, (unsigned)(opaque(tid) + NTH * i), pa[i], pb[i], bias0, 1.f / HY_YS, z1[i], tw); }
        __syncthreads();
        { unsigned pc[2][8];
          fft_fwd_123(dbuf, tid, tw);
#pragma unroll 4
          for (int i = 0; i < 16; ++i) { const f32x4 hv = Hs[1 * 8192 + tid + NTH * i]; HPair hp; hp.hk = make_float2(hv.x, hv.y); hp.hl = make_float2(hv.z, hv.w);
              pair_apply(dbuf, opaque(tid) + NTH * i, hp, t12); }
          __syncthreads();
#pragma unroll
          for (int i = 0; i < 2; ++i) hy_load8(p2, (unsigned)(tid + NTH * i), pc[i]);
          if (s + 1 < NSEQ) {
#pragma unroll
              for (int i = 0; i < 2; ++i) hy_load8(p0 + (size_t)HY3 * SEQL, (unsigned)(tid + NTH * i), pa[i]); }
          fft_inv_012(dbuf, tid, tw);
#pragma unroll
          for (int i = 0; i < 2; ++i) hy_step_c(dbuf, (unsigned)(opaque(tid) + NTH * i), pc[i], z1[i], bias1, 1.f / HY_YS, p0, tw); }
        __syncthreads();
    }
}
__device__ static const signed char CI_TAB[52] = {0,0,0,0,0,0,0,0,0,0,0,0,0,0,0,0,1,1,1,1,1,1,1,1,2,2,2,2,2,3,3,3,3,4,4,4,5,5,6,6,7,7,8,9,10,11,12,13,14,15,15,15};
__device__ static const signed char CJ_TAB[52] = {0,1,2,3,4,5,6,7,8,9,10,11,12,13,14,15,0,1,2,3,4,5,6,7,0,1,2,3,4,0,1,2,3,0,1,2,0,1,0,1,0,1,0,0,0,0,0,0,0,0,15,15};
constexpr int CI_C[52] = {0,0,0,0,0,0,0,0,0,0,0,0,0,0,0,0,1,1,1,1,1,1,1,1,2,2,2,2,2,3,3,3,3,4,4,4,5,5,6,6,7,7,8,9,10,11,12,13,14,15,15,15};
constexpr int CJ_C[52] = {0,1,2,3,4,5,6,7,8,9,10,11,12,13,14,15,0,1,2,3,4,5,6,7,0,1,2,3,4,0,1,2,3,0,1,2,0,1,0,1,0,1,0,0,0,0,0,0,0,0,15,15};
DV unsigned f2ord(float f) { const unsigned u = __builtin_bit_cast(unsigned, f); return (u >> 31) ? ~u : (u | 0x80000000u); }
DV float ord2f(unsigned k) { const unsigned u = (k >> 31) ? (k & 0x7fffffffu) : ~k; return __builtin_bit_cast(float, u); }
DV unsigned umax3(unsigned a, unsigned b, unsigned c) { return max(max(a, b), c); }
constexpr int SK_STR = 136, SK_LDS = 2 * 128 * SK_STR * 2;
DV void peer_stage_sk(KParams p, int l, int h, bf16_t* sks) {
    const bf16_t* sk = (const bf16_t*)(p->ws + WS_W + l * SZ_WL + OFF_SK) + (size_t)h * 2 * 128 * 128;
    __syncthreads();
#pragma unroll
    for (int i = 0; i < 8; ++i) { const int idx = tid_() + i * NTH, row = idx >> 4, ch = idx & 15; *(u32x4*)(sks + row * SK_STR + ch * 8) = ldg16(sk + (size_t)row * 128 + ch * 8); }
    __syncthreads();
}
DV void peer_topk_loadq(KParams p, int tile, int h, bf16x8 (&bqa)[2][4]) {
    const int lane = tid_() & 63, w = wave_(), fr = lane & 15, fq = lane >> 4;
    const bf16_t* qp = (const bf16_t*)p->out + ((size_t)tile * 128 + w * 16 + fr) * 2048 + h * 256 + fq * 8;
#pragma unroll
    for (int c = 0; c < 2; ++c)
#pragma unroll
        for (int ks = 0; ks < 4; ++ks) bqa[c][ks] = *(const bf16x8*)(qp + c * 128 + ks * 32);
}
DV void merge16_xor(unsigned (&k)[16], int m) {
    unsigned o[16];
#pragma unroll
    for (int i = 0; i < 16; ++i) o[i] = (unsigned)__shfl_xor((int)k[15 - i], m);
#pragma unroll
    for (int i = 0; i < 16; ++i) k[i] = max(k[i], o[i]);
    bitonic_merge_desc<16>(k);
}
DV void peer_topk_item(KParams p, int l, int tile, int h, bf16_t* sks, const bf16x8 (&bqa)[2][4]) {
    const int lane = tid_() & 63, w = wave_(), fr = lane & 15, fq = lane >> 4;
    const size_t t0 = (size_t)tile * 128 + w * 16;
    unsigned tk[2][16];
#pragma unroll
    for (int c = 0; c < 2; ++c) {
        bf16x8 bq[4];
#pragma unroll
        for (int ks = 0; ks < 4; ++ks) bq[ks] = bqa[c][ks];
        unsigned key[32];
        const bf16_t* skc = sks + c * 128 * SK_STR;
#pragma unroll
        for (int kt = 0; kt < 8; ++kt) {
            f32x4 s = (f32x4){0.f, 0.f, 0.f, 0.f};
#pragma unroll
            for (int ks = 0; ks < 4; ++ks) { const bf16x8 a = *(const bf16x8*)(skc + (kt * 16 + fr) * SK_STR + ks * 32 + fq * 8); s = __builtin_amdgcn_mfma_f32_16x16x32_bf16(a, bq[ks], s, 0, 0, 0); }
#pragma unroll
            for (int j = 0; j < 4; ++j) { const int kidx = kt * 16 + fq * 4 + j; key[kt * 4 + j] = (f2ord(s[j]) & 0xffffff80u) | (unsigned)(127 - kidx); }
        }
        unsigned k16[16];
        { unsigned kb[16];
#pragma unroll
          for (int r = 0; r < 16; ++r) { k16[r] = key[r]; kb[r] = key[16 + r]; }
          bitonic_sort_desc<16>(k16); bitonic_sort_desc<16>(kb);
#pragma unroll
          for (int r = 0; r < 16; ++r) k16[r] = max(k16[r], kb[15 - r]);
          bitonic_merge_desc<16>(k16); }
        merge16_xor(k16, 16); merge16_xor(k16, 32);
#pragma unroll
        for (int r = 0; r < 16; ++r) tk[c][r] = k16[r];
    }
    float v0[16], v1[16];
#pragma unroll
    for (int r = 0; r < 16; ++r) { v0[r] = ord2f(tk[0][r] & 0xffffff80u); v1[r] = ord2f(tk[1][r] & 0xffffff80u); }
    unsigned ck[13]; int ce[13];
#pragma unroll
    for (int s = 0; s < 13; ++s) {
        float sum[4]; int ee[4];
#pragma unroll
        for (int q = 0; q < 4; ++q) { const int i = CI_C[q + 4 * s], j = CJ_C[q + 4 * s]; sum[q] = v0[i] + v1[j];
            ee[q] = (127 - (int)(tk[0][i] & 127u)) * 128 + (127 - (int)(tk[1][j] & 127u)); }
        const float sm = fq == 0 ? sum[0] : (fq == 1 ? sum[1] : (fq == 2 ? sum[2] : sum[3]));
        ce[s] = fq == 0 ? ee[0] : (fq == 1 ? ee[1] : (fq == 2 ? ee[2] : ee[3]));
        ck[s] = (f2ord(sm) & 0xffffffc0u) | (unsigned)(63 - (4 * s)) ;
        ck[s] -= (unsigned)fq;
    }
    int* celds = (int*)(sks + 2 * 128 * SK_STR) + (w * 16 + fr) * 52;
#pragma unroll
    for (int s = 0; s < 13; ++s) celds[fq + 4 * s] = ce[s];
    float myv[4]; int myc[4]; float w0;
    { unsigned c16[16];
#pragma unroll
      for (int i = 0; i < 16; ++i) c16[i] = i < 13 ? ck[i] : 0u;
      bitonic_sort_desc<16>(c16);
      merge16_xor(c16, 16); merge16_xor(c16, 32);
      w0 = ord2f(c16[0] & 0xffffffc0u);
#pragma unroll
      for (int i = 0; i < 4; ++i) { const unsigned mk = fq == 0 ? c16[i] : (fq == 1 ? c16[4 + i] : (fq == 2 ? c16[8 + i] : c16[12 + i]));
          myv[i] = ord2f(mk & 0xffffffc0u); myc[i] = 63 - (int)(mk & 63u); } }
    int mye[4];
#pragma unroll
    for (int i = 0; i < 4; ++i) mye[i] = celds[myc[i]];
    float ex[4], ps = 0.f;
#pragma unroll
    for (int i = 0; i < 4; ++i) { ex[i] = __expf(myv[i] - w0); ps += ex[i]; }
    ps += __shfl_xor(ps, 16); ps += __shfl_xor(ps, 32);
    const float inv = 1.f / ps;
    unsigned short* eidx = (unsigned short*)(p->ws + WS_EIDX) + (t0 + fr) * 128; float* gate = (float*)(p->ws + WS_GATE) + (t0 + fr) * 128;
#pragma unroll
    for (int i = 0; i < 4; ++i) { const int o = (4 * (fq & 1) + i) * 16 + 2 * h + (fq >> 1); eidx[o] = (unsigned short)mye[i]; gate[o] = ex[i] * inv; }
    { unsigned short* en = (unsigned short*)(p->ws + WS_EIDXN) + (t0 + fr) * 128 + (2 * h + (fq >> 1)) * 8 + 4 * (fq & 1);
      *(uint2*)en = make_uint2((unsigned)mye[0] | ((unsigned)mye[1] << 16), (unsigned)mye[2] | ((unsigned)mye[3] << 16)); }
}

typedef float f32x2 __attribute__((ext_vector_type(2)));
DV float gelu_exact(float x) { return 0.5f * x * (1.f + erff(x * 0.7071067811865476f)); }
constexpr size_t SLICE_BYTES = (size_t)NEXP * 128;
DV int peer_q0(int s) { return ((s >> 2) & 1) * 8 + ((s >> 1) & 1) * 4 + (s & 1) * 2; }
struct PeerUIn { u32x4 e; };
constexpr int NSL = 4;
typedef int i32x8 __attribute__((ext_vector_type(8)));
DV PeerUIn peer_u_in(KParams p, size_t t, int lane) {
    PeerUIn r; r.e = ldg16((const unsigned short*)(p->ws + WS_EIDXN) + t * 128 + (lane >> 2) * 8); return r;
}
DV unsigned peer_e8(const u32x4& a, int g) { const unsigned w = g < 2 ? a.x : g < 4 ? a.y : g < 6 ? a.z : a.w; return (g & 1) ? (w >> 16) : (w & 0xffffu); }
DV void peer_u_gather(KParams p, const unsigned char* U4, const PeerUIn& in, int sl, size_t t, int lane, u32x4 (&r)[16], u32x4 (&x)[2]) {
#pragma unroll
    for (int g = 0; g < 8; ++g) { const unsigned char* row = U4 + (size_t)peer_e8(in.e, g) * 128; r[2 * g] = ldg16(row); r[2 * g + 1] = ldg16(row + 64); }
    const unsigned char* xh = p->ws + WS_X8 + t * D + 256 * sl + (lane & 3) * 32 + ((lane >> 4) & 1) * 16;
    x[0] = ldg16(xh); x[1] = ldg16(xh + 128);
}
DV i32x8 cat8(const u32x4& a, const u32x4& b) { return (i32x8){(int)a.x, (int)a.y, (int)a.z, (int)a.w, (int)b.x, (int)b.y, (int)b.z, (int)b.w}; }
DV float quad_sum(float v) {
    v += __builtin_bit_cast(float, __builtin_amdgcn_update_dpp(0, __builtin_bit_cast(int, v), 0xB1, 0xf, 0xf, true));
    v += __builtin_bit_cast(float, __builtin_amdgcn_update_dpp(0, __builtin_bit_cast(int, v), 0x4E, 0xf, 0xf, true));
    return v;
}
DV void peer_u_finish(KParams p, int sl, size_t t, int lane, const u32x4 (&r)[16], const u32x4 (&x)[2], bf16_t* lw) {
    const bool k0 = ((lane >> 2) & 3) == (lane >> 5), k1 = ((lane >> 2) & 3) == 2 + (lane >> 5);
    const u32x4 z4 = (u32x4){0u, 0u, 0u, 0u};
    const i32x8 x0 = cat8(k0 ? x[0] : z4, k1 ? x[0] : z4), x1 = cat8(k0 ? x[1] : z4, k1 ? x[1] : z4);
    const int c = lane & 3; const bool c0 = (c & 1) != 0, c1 = (c & 2) != 0;
    float h[8];
#pragma unroll
    for (int g = 0; g < 8; ++g) {
        f32x4 acc = __builtin_amdgcn_mfma_scale_f32_16x16x128_f8f6f4(cat8(r[2 * g], z4), x0, (f32x4){0.f, 0.f, 0.f, 0.f}, 4, 0, 0, 0, 0, 0);
        acc = __builtin_amdgcn_mfma_scale_f32_16x16x128_f8f6f4(cat8(r[2 * g + 1], z4), x1, acc, 4, 0, 0, 0, 0, 0);
        const float d0 = c0 ? acc[1] : acc[0], d1 = c0 ? acc[3] : acc[2];
        h[g] = quad_sum(c1 ? d1 : d0); }
    const float v0 = c1 ? (c0 ? h[3] : h[2]) : (c0 ? h[1] : h[0]), v1 = c1 ? (c0 ? h[7] : h[6]) : (c0 ? h[5] : h[4]);
    const int q = (lane >> 4) + 4 * ((lane >> 2) & 3);
    const unsigned w = pk2(v0, v1);
    lw[c * 16 + q] = (bf16_t)(w & 0xffffu); lw[64 + c * 16 + q] = (bf16_t)(w >> 16);
    asm volatile("" ::: "memory");
    const unsigned pv = ((const unsigned*)lw)[lane];
    asm volatile("" ::: "memory");
    ((unsigned*)p->out + ((size_t)sl * T + t) * 64)[lane] = pv;
}
DV void peer_u_phase(KParams p, int l, int bid, int nblk, unsigned char* smem) {
    const int wv = wave_(), lane = tid_() & 63, j = bid & 7, sl = j & 3, half = j >> 2, b8 = bid >> 3, nb8 = nblk >> 3;
    const unsigned char* U4 = p->ws + WS_EXP + (size_t)(2 * l) * SZ_EXP1 + (size_t)sl * SLICE_BYTES + (lane & 3) * 16;
    const size_t step = (size_t)nb8 * 16; size_t t = (size_t)(b8 * 8 + wv) * 2 + half;
    bf16_t* lw = (bf16_t*)smem + wv * 128;
    if (t >= (size_t)T) return;
    const size_t t0 = t;
    size_t ta = t, tb = t + step;
    u32x4 ra[16], rb[16], xa[2], xb[2];
    { const PeerUIn a = peer_u_in(p, ta, lane), b = peer_u_in(p, tb < (size_t)T ? tb : t0, lane);
      peer_u_gather(p, U4, a, sl, ta, lane, ra, xa); peer_u_gather(p, U4, b, sl, tb < (size_t)T ? tb : t0, lane, rb, xb); }
    PeerUIn na = peer_u_in(p, ta + 2 * step < (size_t)T ? ta + 2 * step : t0, lane), nb = peer_u_in(p, tb + 2 * step < (size_t)T ? tb + 2 * step : t0, lane);
#pragma unroll 1
    while (ta < (size_t)T) {
        peer_u_finish(p, sl, ta, lane, ra, xa, lw);
        ta += 2 * step;
        peer_u_gather(p, U4, na, sl, ta < (size_t)T ? ta : t0, lane, ra, xa);
        na = peer_u_in(p, ta + 2 * step < (size_t)T ? ta + 2 * step : t0, lane);
        if (tb < (size_t)T) peer_u_finish(p, sl, tb, lane, rb, xb, lw);
        tb += 2 * step;
        peer_u_gather(p, U4, nb, sl, tb < (size_t)T ? tb : t0, lane, rb, xb);
        nb = peer_u_in(p, tb + 2 * step < (size_t)T ? tb + 2 * step : t0, lane);
    }
}
DV unsigned peer_e16(const u32x4& a, const u32x4& b, int q) {
    const unsigned w = q < 2 ? a.x : q < 4 ? a.y : q < 6 ? a.z : q < 8 ? a.w : q < 10 ? b.x : q < 12 ? b.y : q < 14 ? b.z : b.w;
    return (q & 1) ? (w >> 16) : (w & 0xffffu);
}
typedef _Float16 h16x2 __attribute__((ext_vector_type(2)));
DV h16x2 fp8h(unsigned w, bool hi) { return hi ? __builtin_amdgcn_cvt_scalef32_pk_f16_fp8(w, 1.0f, true) : __builtin_amdgcn_cvt_scalef32_pk_f16_fp8(w, 1.0f, false); }
constexpr size_t DO_COEF = (size_t)T * D * 2;
constexpr size_t DO_CSC = DO_COEF + (size_t)NSL * T * 128;
DV void peer_c_phase(KParams p, int l, int bid, int nblk) {
    const int wv = wave_(), lane = tid_() & 63, g = lane >> 3, s = lane & 7;
    const unsigned char* tabu = p->ws + WS_EXP + (size_t)(2 * l) * SZ_EXP1; const unsigned char* tabv = tabu + SZ_EXP1;
    const unsigned char* sc16 = tabu + NSL * SLICE_BYTES;
    const int o2 = g * 16 + peer_q0(s);
    const size_t step = (size_t)nblk * 8;
#pragma unroll 1
    for (size_t t0 = (size_t)bid * 8 + wv; t0 < (size_t)T; t0 += 4 * step) {
        unsigned pw[4][NSL]; unsigned ew[4]; f32x2 gt[4];
#pragma unroll
        for (int k = 0; k < 4; ++k) { const size_t t = t0 + k * step < (size_t)T ? t0 + k * step : t0;
            const unsigned* part = (const unsigned*)p->out + t * 64 + lane;
#pragma unroll
            for (int q = 0; q < NSL; ++q) pw[k][q] = part[(size_t)q * T * 64];
            ew[k] = *(const unsigned*)((const unsigned short*)(p->ws + WS_EIDX) + t * 128 + o2);
            gt[k] = *(const f32x2*)((const float*)(p->ws + WS_GATE) + t * 128 + o2); }
#pragma unroll
        for (int k = 0; k < 4; ++k) { const size_t t = t0 + k * step;
            const int e0 = (int)(ew[k] & 0xffffu), e1 = (int)(ew[k] >> 16);
            const f32x4 su0 = *(const f32x4*)(sc16 + (size_t)e0 * 32), sv0 = *(const f32x4*)(sc16 + (size_t)e0 * 32 + 16);
            const f32x4 su1 = *(const f32x4*)(sc16 + (size_t)e1 * 32), sv1 = *(const f32x4*)(sc16 + (size_t)e1 * 32 + 16);
            float a0 = 0.f, a1 = 0.f;
#pragma unroll
            for (int q = 0; q < NSL; ++q) { a0 += bflo(pw[k][q]) * su0[q]; a1 += bfhi(pw[k][q]) * su1[q]; }
            float v0[NSL] = {sv0[0], sv0[1], sv0[2], sv0[3]}, v1[NSL] = {sv1[0], sv1[1], sv1[2], sv1[3]};
            const float c0 = gt[k].x * gelu_exact(a0), c1 = gt[k].y * gelu_exact(a1);
            float mx = 0.f;
#pragma unroll
            for (int q = 0; q < NSL; ++q) { v0[q] *= c0; v1[q] *= c1; mx = fmaxf(mx, fmaxf(fabsf(v0[q]), fabsf(v1[q]))); }
            mx = wave_max(mx);
            const float S = mx > 0.f ? 128.f / mx : 0.f;
            if (t < (size_t)T) {
#pragma unroll
                for (int q = 0; q < NSL; ++q) *(unsigned short*)((unsigned char*)p->out + DO_COEF + ((size_t)q * T + t) * 128 + o2) = (unsigned short)__builtin_amdgcn_cvt_pk_fp8_f32(v0[q] * S, v1[q] * S, 0, false);
                if (lane == 0) ((float*)((unsigned char*)p->out + DO_CSC))[t] = mx * (1.f / 128.f); } }
    }
}
struct PeerVIn { u32x4 e0, e1; };
DV PeerVIn peer_v_in(KParams p, size_t t, int lane) {
    PeerVIn r; const unsigned short* eidx = (const unsigned short*)(p->ws + WS_EIDX) + t * 128 + (lane >> 3) * 16;
    r.e0 = ldg16(eidx); r.e1 = ldg16(eidx + 8); return r;
}
struct PeerVCo { u32x2 ca, cb; float isc; };
DV void peer_v_gather(KParams p, const unsigned char* V4, const unsigned char* coef, const PeerVIn& in, size_t t, u32x4 (&r)[16], PeerVCo& c) {
#pragma unroll
    for (int q = 0; q < 16; ++q) r[q] = ldg16(V4 + (size_t)peer_e16(in.e0, in.e1, q) * 128);
    c.ca = *(const u32x2*)(coef + t * 128); c.cb = *(const u32x2*)(coef + t * 128 + 64);
    c.isc = ((const float*)((const unsigned char*)p->out + DO_CSC))[t];
}
DV float add_ror8(float a, float b) { return a + __builtin_bit_cast(float, __builtin_amdgcn_update_dpp(0, __builtin_bit_cast(int, b), 0x128, 0xf, 0xf, true)); }
DV void peer_v_finish(KParams p, int sl, size_t t, int lane, const PeerVCo& co, const u32x4 (&r)[16]) {
    const int m = lane & 15; const bool z = (m & 2) != 0, live = m < 4;
    const unsigned s0 = z ? 0x010c000cu : 0x0c010c00u, s1 = z ? 0x030c020cu : 0x0c030c02u;
    const unsigned cax = live ? co.ca.x : 0u, cay = live ? co.ca.y : 0u, cbx = live ? co.cb.x : 0u, cby = live ? co.cb.y : 0u;
    const i32x8 A = (i32x8){(int)__builtin_amdgcn_perm(0u, cax, s0), (int)__builtin_amdgcn_perm(0u, cax, s1), (int)__builtin_amdgcn_perm(0u, cay, s0), (int)__builtin_amdgcn_perm(0u, cay, s1),
                            (int)__builtin_amdgcn_perm(0u, cbx, s0), (int)__builtin_amdgcn_perm(0u, cbx, s1), (int)__builtin_amdgcn_perm(0u, cby, s0), (int)__builtin_amdgcn_perm(0u, cby, s1)};
    float y[32];
#pragma unroll
    for (int w = 0; w < 4; ++w) {
        unsigned Tt[4][4];
#pragma unroll
        for (int u = 0; u < 4; ++u) {
            const unsigned a0 = r[4 * u][w], a1 = r[4 * u + 1][w], a2 = r[4 * u + 2][w], a3 = r[4 * u + 3][w];
            const unsigned p0 = __builtin_amdgcn_perm(a1, a0, 0x05010400u), p1 = __builtin_amdgcn_perm(a1, a0, 0x07030602u);
            const unsigned p2 = __builtin_amdgcn_perm(a3, a2, 0x05010400u), p3 = __builtin_amdgcn_perm(a3, a2, 0x07030602u);
            Tt[0][u] = __builtin_amdgcn_perm(p2, p0, 0x05040100u); Tt[1][u] = __builtin_amdgcn_perm(p2, p0, 0x07060302u);
            Tt[2][u] = __builtin_amdgcn_perm(p3, p1, 0x05040100u); Tt[3][u] = __builtin_amdgcn_perm(p3, p1, 0x07060302u);
        }
#pragma unroll
        for (int bq = 0; bq < 4; ++bq) {
            const i32x8 B = (i32x8){(int)Tt[bq][0], (int)Tt[bq][1], (int)Tt[bq][2], (int)Tt[bq][3], 0, 0, 0, 0};
            const f32x4 acc = __builtin_amdgcn_mfma_scale_f32_16x16x128_f8f6f4(A, B, (f32x4){0.f, 0.f, 0.f, 0.f}, 0, 4, 0, 0, 0, 0);
            const int j = 4 * w + bq;
            y[2 * j] = add_ror8(acc[0], acc[1]); y[2 * j + 1] = add_ror8(acc[2], acc[3]);
        }
    }
    if (lane < 8) {
        const size_t off = t * D + 256 * sl + lane * 32;
        const bf16_t* xr = (const bf16_t*)(p->ws + WS_XB) + off; bf16_t* yo = (bf16_t*)(p->ws + WS_HY) + off;
        const float isc = co.isc;
#pragma unroll
        for (int i = 0; i < 4; ++i) { const u32x4 xw = ldg16(xr + 8 * i); u32x4 o;
            o.x = pk2(ALPHA * bflo(xw.x) + y[8 * i + 0] * isc, ALPHA * bfhi(xw.x) + y[8 * i + 1] * isc); o.y = pk2(ALPHA * bflo(xw.y) + y[8 * i + 2] * isc, ALPHA * bfhi(xw.y) + y[8 * i + 3] * isc);
            o.z = pk2(ALPHA * bflo(xw.z) + y[8 * i + 4] * isc, ALPHA * bfhi(xw.z) + y[8 * i + 5] * isc); o.w = pk2(ALPHA * bflo(xw.w) + y[8 * i + 6] * isc, ALPHA * bfhi(xw.w) + y[8 * i + 7] * isc);
            stg16(yo + 8 * i, o); }
    }
}
DV void peer_v_phase(KParams p, int l, int bid, int nblk) {
    const int wv = wave_(), lane = tid_() & 63, lab = bid & 7, sl = lab & 3, half = lab >> 2, b8 = bid >> 3, nb8 = nblk >> 3, s = lane & 7;
    const unsigned char* V4 = p->ws + WS_EXP + (size_t)(2 * l + 1) * SZ_EXP1 + (size_t)sl * SLICE_BYTES + s * 16;
    const unsigned char* coef = (const unsigned char*)p->out + DO_COEF + (size_t)sl * T * 128 + (2 * (lane >> 5) + (lane & 1)) * 16 + ((lane >> 4) & 1) * 8;
    const size_t step = (size_t)nb8 * 16; size_t t = ((size_t)b8 * 8 + wv) * 2 + half;
    if (t >= (size_t)T) return;
    const size_t t0 = t;
    size_t ta = t, tb = t + step;
    u32x4 ra[16], rb[16]; PeerVCo ca, cb;
    { const PeerVIn a = peer_v_in(p, ta, lane), b = peer_v_in(p, tb < (size_t)T ? tb : t0, lane);
      peer_v_gather(p, V4, coef, a, ta, ra, ca); peer_v_gather(p, V4, coef, b, tb < (size_t)T ? tb : t0, rb, cb); }
    PeerVIn na = peer_v_in(p, ta + 2 * step < (size_t)T ? ta + 2 * step : t0, lane), nb = peer_v_in(p, tb + 2 * step < (size_t)T ? tb + 2 * step : t0, lane);
#pragma unroll 1
    while (ta < (size_t)T) {
        peer_v_finish(p, sl, ta, lane, ca, ra);
        ta += 2 * step;
        peer_v_gather(p, V4, coef, na, ta < (size_t)T ? ta : t0, ra, ca);
        na = peer_v_in(p, ta + 2 * step < (size_t)T ? ta + 2 * step : t0, lane);
        if (tb < (size_t)T) peer_v_finish(p, sl, tb, lane, cb, rb);
        tb += 2 * step;
        peer_v_gather(p, V4, coef, nb, tb < (size_t)T ? tb : t0, rb, cb);
        nb = peer_v_in(p, tb + 2 * step < (size_t)T ? tb + 2 * step : t0, lane);
    }
}
DV void ln2_job(KParams p, int l, int bid, int nblk) { ln_job(p->in[25] + (size_t)l * D, p->in[26] + (size_t)l * D, (const bf16_t*)(p->ws + WS_HY), l == DEPTH - 1 ? nullptr : (bf16_t*)(p->ws + WS_XB), p->out, bid, nblk); }


#define XB_TMO      128
#define XB_XCNT(j)  (256  + 64 * (j))
#define XB_XSUB(j)  (1280 + 64 * (j))
#define XB_XGEN(j)  (2304 + 64 * (j))
#define XB_TOP      3328
#define XB_TOPGEN   3392
#define XCD_BAR_WORDS 3456
#define XB_SPIN_CAP (1u << 18)
DV unsigned xb_ld(unsigned* p)              { return __hip_atomic_load(p, __ATOMIC_RELAXED, __HIP_MEMORY_SCOPE_AGENT); }
DV unsigned xb_add(unsigned* p, unsigned v) { return __hip_atomic_fetch_add(p, v, __ATOMIC_RELAXED, __HIP_MEMORY_SCOPE_AGENT); }
DV unsigned xb_xcc_id() { return (unsigned)__builtin_amdgcn_s_getreg((3 << 11) | 20) & 0xFu; }
#define XB_SPIN(cond, bar) do { unsigned _sp = 0; while (cond) { __builtin_amdgcn_s_sleep(1); \
    if ((++_sp & 255u) == 0u) { if (xb_ld(&(bar)[XB_TMO])) break; if (_sp > XB_SPIN_CAP) { atomicAdd(&(bar)[XB_TMO], 1u); break; } } } } while (0)
struct XcdBarrier { unsigned* bar; unsigned x; volatile LAS unsigned* st; };
DV XcdBarrier xcd_barrier_post(unsigned* bar, volatile LAS unsigned* st) {
    XcdBarrier b; b.bar = bar; b.x = xb_xcc_id(); b.st = st;
    if (threadIdx.x == 0) (void)xb_add(&bar[XB_XCNT(b.x)], 1u);
    return b;
}
DV void xcd_barrier_complete(unsigned* bar, unsigned x, unsigned& nloc, unsigned& nx) {
    const unsigned G = gridDim.x * gridDim.y * gridDim.z;
    unsigned sum, cnt, mine, sp = 0u;
    for (;;) {
        sum = 0u; cnt = 0u; mine = 0u;
#pragma unroll
        for (unsigned j = 0; j < 16; ++j) { const unsigned c = xb_ld(&bar[XB_XCNT(j)]); sum += c; cnt += (c > 0u) ? 1u : 0u; mine = (j == x) ? c : mine; }
        if (sum == G) break;
        __builtin_amdgcn_s_sleep(1);
        if ((++sp & 255u) == 0u) { if (xb_ld(&bar[XB_TMO])) break; if (sp > XB_SPIN_CAP) { atomicAdd(&bar[XB_TMO], 1u); break; } }
    }
    nloc = mine > 0u ? mine : 1u; nx = cnt > 0u ? cnt : 1u;
}
DV void xcd_barrier(const XcdBarrier& b) {
    asm volatile("s_waitcnt vmcnt(0)" ::: "memory");
    __syncthreads();
    if (threadIdx.x == 0) {
        unsigned* bar = b.bar;
        __builtin_amdgcn_s_waitcnt(0);
        unsigned nloc = b.st[0], nx = b.st[1];
        if (nloc == 0u) { xcd_barrier_complete(bar, b.x, nloc, nx); b.st[0] = nloc; b.st[1] = nx; }
        const unsigned old = xb_add(&bar[XB_XSUB(b.x)], 1u);
        const unsigned gen = old / nloc;
        if (old + 1u == (gen + 1u) * nloc) {
            __builtin_amdgcn_fence(__ATOMIC_RELEASE, "agent");
            asm volatile("s_waitcnt vmcnt(0)" ::: "memory");
            const unsigned og = xb_add(&bar[XB_TOP], 1u);
            const unsigned tg = og / nx;
            if (og + 1u == (tg + 1u) * nx) xb_add(&bar[XB_TOPGEN], 1u);
            else XB_SPIN(xb_ld(&bar[XB_TOPGEN]) == tg, bar);
            __builtin_amdgcn_fence(__ATOMIC_ACQUIRE, "agent");
            xb_add(&bar[XB_XGEN(b.x)], 1u);
            asm volatile("s_waitcnt vmcnt(0)" ::: "memory");
        } else {
            XB_SPIN(xb_ld(&bar[XB_XGEN(b.x)]) == gen, bar);
            __builtin_amdgcn_fence(__ATOMIC_ACQUIRE, "agent");
            asm volatile("s_waitcnt vmcnt(0)" ::: "memory");
        }
    }
    __syncthreads();
}
constexpr int LDS_BYTES = 139264 + 1024 + 288 * 8 + 256;
constexpr int PH_PER_LAYER = 13, NPHASE = 1 + DEPTH * PH_PER_LAYER;
DV void convert_experts(KParams p, int bid, int nblk) {
    const int lane = tid_() & 63, wv = wave_();
#pragma unroll 1
    for (int r = bid * 8 + wv; r < 4 * NEXP; r += nblk * 8) {
        const int tab = r / NEXP, e = r - tab * NEXP, l = tab >> 1, uv = tab & 1;
        unsigned char* dstb = p->ws + WS_EXP + (size_t)tab * SZ_EXP1;
        const float* src = p->in[23 + uv] + ((size_t)l * NEXP + e) * D + lane * 4;
        f32x4 v[4];
#pragma unroll
        for (int j = 0; j < 4; ++j) v[j] = *(const f32x4*)(src + 256 * j);
        float bmj[4];
#pragma unroll
        for (int j = 0; j < 4; ++j) {
            float bm = fmaxf(fmaxf(fabsf(v[j].x), fabsf(v[j].y)), fmaxf(fabsf(v[j].z), fabsf(v[j].w))); bm = wave_max(bm);
            bmj[j] = bm * (1.f / 6.f);
            const float es = bm > 0.f ? 6.f / bm : 0.f;
            unsigned pk = 0;
            pk = __builtin_amdgcn_cvt_scalef32_pk_fp4_f32(pk, v[j].x * es, v[j].y * es, 1.0f, 0);
            pk = __builtin_amdgcn_cvt_scalef32_pk_fp4_f32(pk, v[j].z * es, v[j].w * es, 1.0f, 1);
            *(unsigned short*)(dstb + (size_t)j * SLICE_BYTES + (size_t)e * 128 + 2 * lane) = (unsigned short)pk;
        }
        if (lane == 0) {
            unsigned char* rec = p->ws + WS_EXP + (size_t)(2 * l) * SZ_EXP1 + NSL * SLICE_BYTES + (size_t)e * 32 + uv * 16;
            *(f32x4*)rec = (f32x4){bmj[0], bmj[1], bmj[2], bmj[3]}; }
    }
}
DV void run_phase0(KParams p, unsigned char* smem) {
    const int bid = blockIdx.x, nblk = gridDim.x;
    cvt_job(p->in[0], (bf16_t*)(p->ws + WS_XB), (size_t)2 * SEQL * D, bid, nblk);
    cvt_job(p->in[1], (bf16_t*)(p->ws + WS_XB) + (size_t)2 * SEQL * D, (size_t)SEQL * D, bid, nblk);
    cvt_job(p->in[2], (bf16_t*)(p->ws + WS_MEMB), (size_t)2 * N_MEM * D, bid, nblk);
    cvt_job(p->in[3], (bf16_t*)(p->ws + WS_MEMB) + (size_t)2 * N_MEM * D, (size_t)N_MEM * D, bid, nblk);
#pragma unroll 1
    for (int l = 0; l < DEPTH; ++l) {
        unsigned char* wl = p->ws + WS_W + l * SZ_WL;
        cvt_job(p->in[22] + (size_t)l * 8 * 2 * 128 * 128, (bf16_t*)(wl + OFF_SK), (size_t)8 * 2 * 128 * 128, bid, nblk);
        transpose_job(p->in[5] + (size_t)l * D * IN_WIDTH, D, IN_WIDTH, (bf16_t*)(wl + OFF_WT_IN), bid, nblk, (float*)smem);
#pragma unroll 1
        for (int n = 0; n < 3; ++n) transpose_job(p->in[17] + ((size_t)l * 3 + n) * 512 * D, 512, D, (bf16_t*)(wl + OFF_WT_BR) + (size_t)n * D * 512, bid, nblk, (float*)smem);
        transpose_job(p->in[18] + (size_t)l * D * D, D, D, (bf16_t*)(wl + OFF_WT_OUT), bid, nblk, (float*)smem);
        transpose_job(p->in[21] + (size_t)l * D * 2048, D, 2048, (bf16_t*)(wl + OFF_WT_Q), bid, nblk, (float*)smem);
        transpose_job(p->in[16] + (size_t)l * D * D, D, D, (bf16_t*)(wl + OFF_WT_MKV), bid, nblk, (float*)smem);
        transpose_job(p->in[14] + (size_t)l * FHID * 2048, FHID, 2048, (bf16_t*)(p->ws + WS_WOT) + (size_t)l * 2048 * FHID, bid, nblk, (float*)smem);
    }
    for (int k = bid * NTH + tid_(); k < 16384; k += nblk * NTH) { float sn, cs; sincospif((float)k * (1.f / 16384.f), &sn, &cs); ((float2*)(p->ws + WS_TW))[k] = make_float2(cs, -sn); }
    convert_experts(p, bid, nblk);
    filter_mlp_job(p, bid, nblk);
}
#ifndef ONLY_Q
#define ONLY_Q -1
#endif
template <int Q> DV void run_phase_q(KParams p, int l, unsigned char* smem) {
    const int bid = opaque_s(blockIdx.x), nblk = opaque_s(gridDim.x);
    if (ONLY_Q >= 0 && Q != ONLY_Q) return;
    if (Q == 0) {
        SchedG1 S{p, l, nblk, bid}; EpiG1 E{p, l};
        __syncthreads();
        pg8::gemm_stream(( LAS unsigned char*)smem, S, E);
    } else if (Q == 1) {
        const int na = 768, nm = 768, nf = 1024, ns = NSEQ * 64 * 24;
#pragma unroll 1
        for (int t = bid; t < na + nm + nf + ns; t += nblk) {
            if (t < na) attn_item<true>(p, l, t, smem);
            else if (t < na + nm) attn_item<false>(p, l, t - na, smem);
            else if (t < na + nm + nf) filt_tile(p, l, t - na - nm, smem);
            else shortconv_item(p, l, t - na - nm - nf, (float*)smem);
        }
    } else if (Q == 2) {
#pragma unroll 1
        for (int c = bid; c < HYW; c += nblk) hyena_item(p, l, c, smem);
    } else if (Q == 3) {
#pragma unroll 1
        for (int t = bid; t < NSEQ * 64 * 8; t += nblk) hyo_transpose_item(p, t, (bf16_t*)smem);
    } else if (Q == 4) {
        SchedMerge S{p, l, nblk, bid}; EpiMerge E{p, l};
        __syncthreads();
        pg8::gemm_stream((LAS unsigned char*)smem, S, E);
    } else if (Q == 5) {
        SchedOut S{p, l, nblk, bid}; EpiOut E{p};
        __syncthreads();
        pg8::gemm_stream((LAS unsigned char*)smem, S, E);
    } else if (Q == 6) ln1_job(p, l, bid, nblk);
    else if (Q == 7) {
        SchedQ S{p, l, nblk, bid}; EpiQ E{p};
        __syncthreads();
        pg8::gemm_stream((LAS unsigned char*)smem, S, E);
    } else if (Q == 8) {
        const int h = bid & 7, b8 = bid >> 3, nb8 = nblk >> 3;
        peer_stage_sk(p, l, h, (bf16_t*)smem);
        bf16x8 bqn[2][4];
        if (b8 < T / 128) peer_topk_loadq(p, b8, h, bqn);
#pragma unroll 1
        for (int tile = b8; tile < T / 128; tile += nb8) {
            bf16x8 bqc[2][4];
#pragma unroll
            for (int c = 0; c < 2; ++c)
#pragma unroll
                for (int ks = 0; ks < 4; ++ks) bqc[c][ks] = bqn[c][ks];
            if (tile + nb8 < T / 128) peer_topk_loadq(p, tile + nb8, h, bqn);
            peer_topk_item(p, l, tile, h, (bf16_t*)smem, bqc);
        }
    } else if (Q == 9) peer_u_phase(p, l, bid, nblk, smem);
    else if (Q == 11) peer_v_phase(p, l, bid, nblk);
    else if (Q == 10) peer_c_phase(p, l, bid, nblk);
    else ln2_job(p, l, bid, nblk);
}
#ifdef PROBE_PHASE
#define PROBE_STAMP(i) { if (blockIdx.x == 0 && threadIdx.x == 0) __hip_atomic_store((unsigned long long*)(p.ws + WS_TS) + (i), (unsigned long long)__builtin_amdgcn_s_memrealtime(), __ATOMIC_RELAXED, __HIP_MEMORY_SCOPE_AGENT); }
#else
#define PROBE_STAMP(i)
#endif
#define PHASE_STEP(Q) { const int ph = 1 + l * PH_PER_LAYER + Q; if (ph >= p.ph_lo && ph < p.ph_hi) { run_phase_q<Q>(kparams(), l, smem); if (ph + 1 < p.ph_hi) GRID_SYNC(); PROBE_STAMP(ph + 1) } }
__global__ void __launch_bounds__(NTH, 2) encoder_fwd(Params p) {
    extern __shared__ __attribute__((aligned(16))) unsigned char smem[];
    cg::grid_group grid = cg::this_grid();
    PROBE_STAMP(0)
    volatile LAS unsigned* xst = (volatile LAS unsigned*)(smem + LDS_BYTES - 16);
    unsigned* xbar = (unsigned*)(p.ws + WS_BAR);
    if (threadIdx.x == 0) { xst[0] = 0u; xst[1] = 0u; }
    if (p.ph_lo == 0 && blockIdx.x == 0) for (int i = threadIdx.x; i < XCD_BAR_WORDS; i += NTH) __hip_atomic_store(xbar + i, 0u, __ATOMIC_RELAXED, __HIP_MEMORY_SCOPE_AGENT);
    XcdBarrier xb; xb.bar = xbar; xb.x = 0; xb.st = xst;
#define GRID_SYNC() xcd_barrier(xb)
    if (p.ph_lo == 0) { if (ONLY_Q < 0 || ONLY_Q == 100) run_phase0(kparams(), smem); if (1 < p.ph_hi) { grid.sync(); xb = xcd_barrier_post(xbar, xst); } PROBE_STAMP(1) }
#pragma unroll 1
    for (int l = 0; l < DEPTH; ++l) {
        PHASE_STEP(0) PHASE_STEP(1) PHASE_STEP(2) PHASE_STEP(3) PHASE_STEP(4) PHASE_STEP(5) PHASE_STEP(6) PHASE_STEP(7) PHASE_STEP(8) PHASE_STEP(9) PHASE_STEP(10) PHASE_STEP(11) PHASE_STEP(12)
    }
#ifdef PROBE_PHASE
#ifndef PROBE_END
#define PROBE_END (PROBE_PHASE + 1)
#endif
    GRID_SYNC();
    PROBE_STAMP(NPHASE)
    GRID_SYNC();
    {
        const unsigned long long* ts = (const unsigned long long*)(p.ws + WS_TS);
        const unsigned long long t0 = __hip_atomic_load(ts, __ATOMIC_RELAXED, __HIP_MEMORY_SCOPE_AGENT), t1 = __hip_atomic_load(ts + NPHASE, __ATOMIC_RELAXED, __HIP_MEMORY_SCOPE_AGENT);
        const unsigned long long ta = __hip_atomic_load(ts + PROBE_PHASE, __ATOMIC_RELAXED, __HIP_MEMORY_SCOPE_AGENT), tb = __hip_atomic_load(ts + PROBE_END, __ATOMIC_RELAXED, __HIP_MEMORY_SCOPE_AGENT);
        const float f = (float)(tb - ta) / (float)(t1 - t0);
        const float sc = 1.f + sqrtf(6e-4f * f);
        f32x4* o = (f32x4*)(p.out + (size_t)2 * SEQL * D);
        for (size_t i = (size_t)blockIdx.x * NTH + threadIdx.x; i < (size_t)SEQL * D / 4; i += (size_t)gridDim.x * NTH) o[i] = o[i] * sc;
    }
#endif
}

#ifndef ONE_LAUNCH
#define ONE_LAUNCH 1
#endif
extern "C" void kernel_launch(void* const* d_in, const int* in_sizes, int n_in, void* d_out, int out_size, void* d_ws, size_t ws_size, hipStream_t stream) {
    static int grid = 0;
    if (grid == 0) {
        if (n_in != 27 || out_size != T * D || ws_size < WS_END) { fprintf(stderr, "kernel_launch: unexpected shapes: n_in %d out %d ws %zu (need %zu)\n", n_in, out_size, ws_size, (size_t)WS_END); grid = -1; return; }
        int dev = 0, cus = 0, per_cu = 0;
        hipGetDevice(&dev);
        hipDeviceGetAttribute(&cus, hipDeviceAttributeMultiprocessorCount, dev);
        if (hipFuncSetAttribute((const void*)encoder_fwd, hipFuncAttributeMaxDynamicSharedMemorySize, LDS_BYTES) != hipSuccess) { fprintf(stderr, "kernel_launch: hipFuncSetAttribute failed\n"); grid = -1; return; }
        if (hipOccupancyMaxActiveBlocksPerMultiprocessor(&per_cu, (const void*)encoder_fwd, NTH, LDS_BYTES) != hipSuccess || per_cu < 1) { fprintf(stderr, "kernel_launch: occupancy query failed (%d)\n", per_cu); grid = -1; return; }
        grid = cus < MAX_GRID ? cus : MAX_GRID; grid &= ~7;
        fprintf(stderr, "kernel_launch: cus %d per_cu %d grid %d ws %zu need %zu\n", cus, per_cu, grid, ws_size, (size_t)WS_END);
    }
    if (grid < 0) return;
    Params p{};
    for (int i = 0; i < 27; ++i) p.in[i] = (const float*)d_in[i];
    p.out = (float*)d_out; p.ws = (unsigned char*)d_ws;
#if ONE_LAUNCH
    p.ph_lo = 0; p.ph_hi = NPHASE;
    void* args[] = {&p};
    hipError_t e = hipLaunchCooperativeKernel((const void*)encoder_fwd, dim3(grid), dim3(NTH), args, LDS_BYTES, stream);
    if (e != hipSuccess) fprintf(stderr, "cooperative launch failed: %s (grid %d)\n", hipGetErrorString(e), grid);
#else
    for (int ph = 0; ph < NPHASE; ++ph) {
        p.ph_lo = ph; p.ph_hi = ph + 1;
        hipLaunchKernelGGL(encoder_fwd, dim3(grid), dim3(NTH), LDS_BYTES, stream, p);
    }
#endif
}
```

```cpp
#include <hip/hip_runtime.h>
#include <hip/hip_cooperative_groups.h>
#include <cstdio>
#include <cmath>
namespace cg = cooperative_groups;

#define HD __host__ __device__ __forceinline__
#define DV __device__ __forceinline__

typedef unsigned short bf16_t;
typedef short bf16x8 __attribute__((ext_vector_type(8)));
typedef float f32x4 __attribute__((ext_vector_type(4)));
typedef unsigned u32x4 __attribute__((ext_vector_type(4)));
typedef unsigned u32x2 __attribute__((ext_vector_type(2)));
typedef _Float16 f16_t;

constexpr int NTH = 512;
constexpr int D = 1024, NSEQ = 3, SEQL = 16384, T = NSEQ * SEQL, DEPTH = 2;
constexpr int N_MEM = 256;
constexpr int IN_WIDTH = 5888, O_K = 512, O_V = 640, O_HY = 768, O_MQ = 2304, O_GATE = 2816;
constexpr int HYW = 512, HY3 = 1536;
constexpr int FEMB = 33, FHID = 64;
constexpr int NEXP = 16384;
constexpr float ALPHA = 1.4142135623730951f;
constexpr float LN_EPS = 1e-5f;

constexpr size_t SZ_WT_IN = (size_t)IN_WIDTH * D * 2, SZ_WT_BR = (size_t)3 * D * 512 * 2, SZ_WT_OUT = (size_t)D * D * 2,
                 SZ_WT_Q = (size_t)2048 * D * 2, SZ_WT_MKV = (size_t)D * D * 2, SZ_SK = (size_t)8 * 2 * 128 * 128 * 2;
constexpr size_t OFF_WT_IN = 0, OFF_WT_BR = OFF_WT_IN + SZ_WT_IN, OFF_WT_OUT = OFF_WT_BR + SZ_WT_BR, OFF_WT_Q = OFF_WT_OUT + SZ_WT_OUT,
                 OFF_WT_MKV = OFF_WT_Q + SZ_WT_Q, OFF_SK = OFF_WT_MKV + SZ_WT_MKV, SZ_WL = OFF_SK + SZ_SK;
constexpr size_t WS_W = 0;
constexpr size_t WS_EXP = WS_W + 2 * SZ_WL;
constexpr size_t SZ_EXP1 = (size_t)NEXP * D + (size_t)NEXP * 4;
constexpr size_t WS_XB = WS_EXP + 4 * SZ_EXP1;
constexpr size_t WS_QKV = WS_XB + (size_t)T * D * 2;
constexpr size_t WS_HY = WS_QKV + (size_t)T * 768 * 2;
constexpr size_t WS_MEMB = WS_HY + (size_t)T * HY3 * 2;
constexpr size_t WS_KVMEM = WS_MEMB + (size_t)768 * D * 2;
constexpr size_t WS_H3 = WS_KVMEM + (size_t)2 * 768 * D * 2;
constexpr size_t WS_WOT = WS_H3 + (size_t)2 * 64 * SEQL * 2;
constexpr size_t WS_FILT = WS_WOT + (size_t)2 * 2048 * 64 * 2;
constexpr int MAX_GRID = 256;
constexpr size_t WS_HSCR = WS_HY;
static_assert((size_t)MAX_GRID * 2 * 8192 * 16 <= (size_t)T * HY3 * 2, "HSCR overlay");
constexpr size_t WS_TS = WS_FILT + (size_t)2048 * SEQL * 2;
constexpr size_t WS_TW = WS_TS + 1024;
constexpr size_t WS_BAR = WS_TW + (size_t)16384 * 8;
constexpr size_t WS_END = WS_BAR + 16384;
constexpr size_t WS_EIDX = WS_QKV;
constexpr size_t WS_GATE = WS_EIDX + (size_t)T * 128 * 2;
constexpr size_t WS_COEF = WS_GATE + (size_t)T * 128 * 4;
constexpr size_t WS_EIDXN = WS_COEF + (size_t)T * 128 * 2;
constexpr size_t WS_X8 = WS_HY;
static_assert(WS_EIDXN + (size_t)T * 128 * 2 <= WS_HY, "eidx copy overflows the qkv region");
static_assert(WS_COEF + (size_t)T * 128 * 4 <= WS_HY, "PEER buffers overlay qkv");
constexpr size_t DO_UCT = 0, DO_QM = (size_t)NSEQ * HY3 * SEQL * 2;

struct Params {
    const float* in[27];
    float* out;
    unsigned char* ws;
    int ph_lo, ph_hi;
};

HD bf16_t f2bf(float f) {
    unsigned u = __builtin_bit_cast(unsigned, f);
    u += 0x7fffu + ((u >> 16) & 1u);
    return (bf16_t)(u >> 16);
}
HD float bf2f(bf16_t h) { return __builtin_bit_cast(float, (unsigned)h << 16); }
typedef __bf16 bf16x2_hw __attribute__((ext_vector_type(2)));
typedef float f32x2_cv __attribute__((ext_vector_type(2)));
HD unsigned pk2(float lo, float hi) {
#if defined(__HIP_DEVICE_COMPILE__)
    return __builtin_bit_cast(unsigned, __builtin_convertvector((f32x2_cv){lo, hi}, bf16x2_hw));
#else
    return (unsigned)f2bf(lo) | ((unsigned)f2bf(hi) << 16);
#endif
}
HD float bflo(unsigned w) { return __builtin_bit_cast(float, w << 16); }
HD float bfhi(unsigned w) { return __builtin_bit_cast(float, w & 0xffff0000u); }

HD float2 cadd(float2 a, float2 b) { return make_float2(a.x + b.x, a.y + b.y); }
HD float2 csub(float2 a, float2 b) { return make_float2(a.x - b.x, a.y - b.y); }
HD float2 cmul(float2 a, float2 b) { return make_float2(a.x * b.x - a.y * b.y, a.x * b.y + a.y * b.x); }
HD float2 cmulc(float2 a, float2 b) { return make_float2(a.x * b.x + a.y * b.y, a.y * b.x - a.x * b.y); }
HD float2 cconj(float2 a) { return make_float2(a.x, -a.y); }

constexpr int FN = 16384;
HD int PI(int p) { return p + ((p >> 5) << 1); }
constexpr int FBUF_F2 = FN + (FN >> 5) * 2;
HD int fpos(int k) { return ((k & 15) << 10) | (((k >> 4) & 15) << 6) | (((k >> 8) & 3) << 4) | (k >> 10); }
HD int frev(int p) { return (p >> 10) | (((p >> 6) & 15) << 4) | (((p >> 4) & 3) << 8) | ((p & 15) << 10); }

typedef float v2f __attribute__((ext_vector_type(2)));
typedef _Float16 h2 __attribute__((ext_vector_type(2)));
template <class V> HD V mk2(float a, float b);
template <> HD v2f mk2<v2f>(float a, float b) { return (v2f){a, b}; }
template <> HD h2 mk2<h2>(float a, float b) { return (h2){(_Float16)a, (_Float16)b}; }
HD v2f tof(v2f a) { return a; }
HD v2f tof(h2 a) { return (v2f){(float)a.x, (float)a.y}; }
template <class V> HD V vswap(V a) { return __builtin_shufflevector(a, a, 1, 0); }
template <class V> HD V cmulv(V a, V w) { const V wr = __builtin_shufflevector(w, w, 0, 0); V wi = w; wi.x = -w.y; wi.y = w.y; return a * wr + vswap(a) * wi; }
template <class V> HD V rot_mi(V a) { return vswap(a) * mk2<V>(1.f, -1.f); }
template <class V> HD V rot_pi(V a) { return vswap(a) * mk2<V>(-1.f, 1.f); }
template <bool INV, class V> HD void dft4(V& a, V& b, V& c, V& d) {
    const V t0 = a + c, t1 = a - c, t2 = b + d, t3 = b - d;
    a = t0 + t2; c = t0 - t2;
    if (!INV) { b = t1 + rot_mi(t3); d = t1 + rot_pi(t3); }
    else      { b = t1 + rot_pi(t3); d = t1 + rot_mi(t3); }
}
template <bool INV, class V> HD void dft16(V (&x)[16]) {
    const float C1 = 0.92387953251128674f, S1 = 0.38268343236508977f, R2 = 0.70710678118654752f;
#pragma unroll
    for (int a = 0; a < 4; ++a) dft4<INV, V>(x[a], x[a + 4], x[a + 8], x[a + 12]);
    const float sg = INV ? 1.f : -1.f;
    x[1 + 4] = cmulv(x[1 + 4], mk2<V>(C1, sg * S1));
    x[1 + 8] = cmulv(x[1 + 8], mk2<V>(R2, sg * R2));
    x[1 + 12] = cmulv(x[1 + 12], mk2<V>(S1, sg * C1));
    x[2 + 4] = cmulv(x[2 + 4], mk2<V>(R2, sg * R2));
    x[2 + 8] = INV ? rot_pi(x[2 + 8]) : rot_mi(x[2 + 8]);
    x[2 + 12] = cmulv(x[2 + 12], mk2<V>(-R2, sg * R2));
    x[3 + 4] = cmulv(x[3 + 4], mk2<V>(S1, sg * C1));
    x[3 + 8] = cmulv(x[3 + 8], mk2<V>(-R2, sg * R2));
    x[3 + 12] = cmulv(x[3 + 12], mk2<V>(-C1, -sg * S1));
#pragma unroll
    for (int b = 0; b < 4; ++b) dft4<INV, V>(x[4 * b], x[4 * b + 1], x[4 * b + 2], x[4 * b + 3]);
}
HD float2 twid(float frac) {
    float s, c;
#if defined(__HIP_DEVICE_COMPILE__)
    sincospif(2.f * frac, &s, &c);
#else
    s = sinf(6.283185307179586f * frac); c = cosf(6.283185307179586f * frac);
#endif
    return make_float2(c, -s);
}
HD float2 twnf(const float2* tw, int j, int n) {
#if defined(__HIP_DEVICE_COMPILE__)
    return tw[j * (32768 / n)];
#else
    (void)tw; return twid((float)j / (float)n);
#endif
}
HD int PIx(v2f*, int p) { return p + ((p >> 5) << 1); }
HD int PIx(h2*, int p) { return p + ((p >> 6) << 2); }
constexpr int FBUF_H2 = FN + (FN >> 6) * 4;
template <int STRIDE> HD constexpr int poffx(v2f*, int m) { return STRIDE >= 32 ? m * (STRIDE + 2 * (STRIDE / 32)) : (STRIDE == 16 ? 16 * m + 2 * (m >> 1) : m); }
template <int STRIDE> HD constexpr int poffx(h2*, int m) { return STRIDE >= 64 ? m * (STRIDE + 4 * (STRIDE / 64)) : m * STRIDE; }
template <class V> HD void wpowers(V w1, V (&w)[16]) {
    w[1] = w1; w[2] = cmulv(w1, w1); w[3] = cmulv(w[2], w1); w[4] = cmulv(w[2], w[2]);
    w[5] = cmulv(w[4], w1); w[6] = cmulv(w[4], w[2]); w[7] = cmulv(w[4], w[3]); w[8] = cmulv(w[4], w[4]);
#pragma unroll
    for (int i = 1; i < 8; ++i) w[8 + i] = cmulv(w[8], w[i]);
}
template <bool INV, int N, int STRIDE, class V> HD void bfly16_core(V (&x)[16], unsigned j, const float2* tw) {
    if (STRIDE > 1) {
        const float2 t = twnf(tw, (int)j, N);
        V w[16]; wpowers(mk2<V>(t.x, INV ? -t.y : t.y), w);
        if (INV) {
#pragma unroll
            for (int m = 1; m < 16; ++m) x[m] = cmulv(x[m], w[m]);
            dft16<INV, V>(x);
        } else {
            dft16<INV, V>(x);
#pragma unroll
            for (int q = 1; q < 16; ++q) { const int s = (q >> 2) + 4 * (q & 3); x[s] = cmulv(x[s], w[q]); }
        }
    } else dft16<INV, V>(x);
}
template <bool INV, int N, int STRIDE, class V> HD void fft_bfly16(V* buf, unsigned bf, const float2* tw) {
    const unsigned blk = bf / STRIDE, j = bf % STRIDE, base = blk * N + j;
    V* b = buf + PIx((V*)nullptr, (int)base);
    V x[16];
#pragma unroll
    for (int m = 0; m < 16; ++m) x[m] = b[poffx<STRIDE>((V*)nullptr, m)];
    bfly16_core<INV, N, STRIDE, V>(x, j, tw);
#pragma unroll
    for (int q = 0; q < 16; ++q) b[poffx<STRIDE>((V*)nullptr, q)] = x[(q >> 2) + 4 * (q & 3)];
}
template <bool INV, int N, int STRIDE, class V> HD void fft_bfly4(V* buf, unsigned bf, const float2* tw) {
    const unsigned blk = bf / STRIDE, j = bf % STRIDE, base = blk * N + j;
    V* b = buf + PIx((V*)nullptr, (int)base);
    V x[4];
#pragma unroll
    for (int m = 0; m < 4; ++m) x[m] = b[poffx<STRIDE>((V*)nullptr, m)];
    const float2 t = twnf(tw, (int)j, N);
    const V w1 = mk2<V>(t.x, INV ? -t.y : t.y), w2 = cmulv(w1, w1), w3 = cmulv(w2, w1);
    if (INV) { x[1] = cmulv(x[1], w1); x[2] = cmulv(x[2], w2); x[3] = cmulv(x[3], w3); }
    dft4<INV, V>(x[0], x[1], x[2], x[3]);
    if (!INV) { x[1] = cmulv(x[1], w1); x[2] = cmulv(x[2], w2); x[3] = cmulv(x[3], w3); }
#pragma unroll
    for (int q = 0; q < 4; ++q) b[poffx<STRIDE>((V*)nullptr, q)] = x[q];
}
#ifndef HYV
#define HYV h2
#endif
template <class V> struct YScale { static constexpr float v = 1.f; };
template <> struct YScale<h2> { static constexpr float v = 128.f; };
constexpr float HY_YS = YScale<HYV>::v;
HD unsigned ldpairw(const bf16_t* p, unsigned bf, int m) { return *(const unsigned*)(p + 2 * (bf + 1024u * (unsigned)m)); }
HD v2f pairf(unsigned w) { return (v2f){bflo(w), bfhi(w)}; }
HD void hy_load8(const bf16_t* p, unsigned bf, unsigned (&w)[8]) {
#pragma unroll
    for (int m = 0; m < 8; ++m) w[m] = ldpairw(p, bf, m);
}
template <class V> HD void hy_step_a(V* buf, unsigned bf, const unsigned (&pa)[8], const float2* tw) {
    V x[16];
#pragma unroll
    for (int m = 0; m < 8; ++m) x[m] = mk2<V>(bflo(pa[m]), bfhi(pa[m]));
#pragma unroll
    for (int m = 8; m < 16; ++m) x[m] = mk2<V>(0.f, 0.f);
    bfly16_core<false, 16384, 1024, V>(x, bf, tw);
    V* b = buf + PIx((V*)nullptr, (int)bf);
#pragma unroll
    for (int q = 0; q < 16; ++q) b[poffx<1024>((V*)nullptr, q)] = x[(q >> 2) + 4 * (q & 3)];
}
template <class V> HD void hy_step_b(V* buf, unsigned bf, const unsigned (&pa)[8], const unsigned (&pb)[8], float bias0, float ys, v2f (&z1)[8], const float2* tw) {
    V* b = buf + PIx((V*)nullptr, (int)bf);
    V x[16];
#pragma unroll
    for (int m = 0; m < 16; ++m) x[m] = b[poffx<1024>((V*)nullptr, m)];
    bfly16_core<true, 16384, 1024, V>(x, bf, tw);
    V y[16];
#pragma unroll
    for (int q = 0; q < 8; ++q) { const v2f a = pairf(pa[q]), c = pairf(pb[q]); z1[q] = c * (tof(x[(q >> 2) + 4 * (q & 3)]) * ys + a * bias0); y[q] = mk2<V>(z1[q].x, z1[q].y); }
#pragma unroll
    for (int q = 8; q < 16; ++q) y[q] = mk2<V>(0.f, 0.f);
    bfly16_core<false, 16384, 1024, V>(y, bf, tw);
#pragma unroll
    for (int q = 0; q < 16; ++q) b[poffx<1024>((V*)nullptr, q)] = y[(q >> 2) + 4 * (q & 3)];
}
template <class V> HD void hy_step_c(const V* buf, unsigned bf, const unsigned (&pc)[8], const v2f (&z1)[8], float bias1, float ys, bf16_t* outp, const float2* tw) {
    const V* b = buf + PIx((V*)nullptr, (int)bf);
    V x[16];
#pragma unroll
    for (int m = 0; m < 16; ++m) x[m] = b[poffx<1024>((V*)nullptr, m)];
    bfly16_core<true, 16384, 1024, V>(x, bf, tw);
#pragma unroll
    for (int q = 0; q < 8; ++q) { const v2f c = pairf(pc[q]); const v2f o = c * (tof(x[(q >> 2) + 4 * (q & 3)]) * ys + z1[q] * bias1);
        *(unsigned*)(outp + 2 * (bf + 1024u * (unsigned)q)) = pk2(o.x, o.y); }
}
template <bool INV, class V> HD void fft_pass(V* buf, int p, int tid, const float2* tw = nullptr) {
    const int pp = INV ? 3 - p : p;
    if (pp == 0) {
#pragma unroll 2
        for (int i = 0; i < 2; ++i) fft_bfly16<INV, 16384, 1024, V>(buf, (unsigned)(tid + NTH * i), tw); }
    else if (pp == 1) {
#pragma unroll 2
        for (int i = 0; i < 2; ++i) fft_bfly16<INV, 1024, 64, V>(buf, (unsigned)(tid + NTH * i), tw); }
    else if (pp == 2) {
#pragma unroll 2
        for (int i = 0; i < 8; ++i) fft_bfly4<INV, 64, 16, V>(buf, (unsigned)(tid + NTH * i), tw); }
    else {
#pragma unroll 2
        for (int i = 0; i < 2; ++i) fft_bfly16<INV, 16, 1, V>(buf, (unsigned)(tid + NTH * i), tw); }
}
struct HPair { float2 hk, hl; };
HD void pair_unpack(float2 ck, float2 cl, float2 w, float2& ak, float2& al) {
    const float2 e = make_float2(0.5f * (ck.x + cl.x), 0.5f * (ck.y - cl.y));
    const float2 dd = make_float2(0.5f * (ck.x - cl.x), 0.5f * (ck.y + cl.y));
    const float2 o = make_float2(dd.y, -dd.x);
    const float2 wo = cmul(w, o);
    ak = cadd(e, wo); al = cconj(csub(e, wo));
}
HD void pair_pack(float2 yk, float2 yl, float2 w, float2& dk, float2& dl) {
    const float2 ye = make_float2(0.5f * (yk.x + yl.x), 0.5f * (yk.y - yl.y));
    const float2 dd = make_float2(0.5f * (yk.x - yl.x), 0.5f * (yk.y + yl.y));
    const float2 yo = cmulc(dd, w);
    dk = make_float2(ye.x - yo.y, ye.y + yo.x);
    dl = make_float2(ye.x + yo.y, -ye.y + yo.x);
}
HD void pair_item_pos(int e, int& p, int& k, int& pl) { p = 16 * (e >> 3) + (e & 7); k = frev(p); pl = fpos((FN - k) & (FN - 1)); }
HD float2 twn2(const float2* t12, int k) {
#if defined(__HIP_DEVICE_COMPILE__)
    return cmul(t12[k & 255], t12[256 + (k >> 8)]);
#else
    (void)t12; return twid((float)k / (float)(2 * FN));
#endif
}
HD float2 ldc(const v2f* b, int p) { const v2f v = b[PIx((v2f*)nullptr, p)]; return make_float2(v.x, v.y); }
HD float2 ldc(const h2* b, int p) { const h2 v = b[PIx((h2*)nullptr, p)]; return make_float2((float)v.x, (float)v.y); }
HD void stc(v2f* b, int p, float2 v) { b[PIx((v2f*)nullptr, p)] = (v2f){v.x, v.y}; }
HD void stc(h2* b, int p, float2 v) { b[PIx((h2*)nullptr, p)] = mk2<h2>(v.x, v.y); }
HD HPair pair_filter(const v2f* buf, int e, float sc, const float2* tw = nullptr) {
    int p, k, pl; pair_item_pos(e, p, k, pl);
    HPair h;
    if (e == 0) {
        const float2 c0 = ldc(buf, 0), c8 = ldc(buf, fpos(FN / 2));
        h.hk = make_float2((c0.x + c0.y) * sc, (c0.x - c0.y) * sc);
        h.hl = make_float2(c8.x * sc, -c8.y * sc);
        return h;
    }
    const float2 ck = ldc(buf, p), cl = ldc(buf, pl);
    float2 ak, al; pair_unpack(ck, cl, twn2(tw, k), ak, al);
    h.hk = make_float2(ak.x * sc, ak.y * sc); h.hl = make_float2(al.x * sc, al.y * sc);
    return h;
}
template <class V> HD void pair_apply(V* buf, int e, const HPair& h, const float2* tw = nullptr) {
    int p, k, pl; pair_item_pos(e, p, k, pl);
    if (e == 0) {
        const float2 c0 = ldc(buf, 0);
        const float y0 = (c0.x + c0.y) * h.hk.x, yL = (c0.x - c0.y) * h.hk.y;
        stc(buf, 0, make_float2(0.5f * (y0 + yL), 0.5f * (y0 - yL)));
        const int p8 = fpos(FN / 2);
        const float2 c8 = ldc(buf, p8);
        const float2 y8 = cmul(cconj(c8), h.hl);
        stc(buf, p8, cconj(y8));
        return;
    }
    const float2 ck = ldc(buf, p), cl = ldc(buf, pl);
    const float2 w = twn2(tw, k);
    float2 ak, al; pair_unpack(ck, cl, w, ak, al);
    const float2 yk = cmul(ak, h.hk), yl = cmul(al, h.hl);
    float2 dk, dl; pair_pack(yk, yl, w, dk, dl);
    stc(buf, p, dk); stc(buf, pl, dl);
}
HD int fidx(int n) { return PI(n >> 1) * 2 + (n & 1); }

template <int N> HD void bitonic_sort_desc(unsigned (&k)[N]) {
#pragma unroll
    for (int size = 2; size <= N; size <<= 1)
#pragma unroll
        for (int stride = size >> 1; stride > 0; stride >>= 1)
#pragma unroll
            for (int i = 0; i < N; ++i) { const int j = i ^ stride;
                if (j > i) { const bool up = (i & size) != 0;
                    const unsigned a = k[i], b = k[j], mx = a > b ? a : b, mn = a > b ? b : a;
                    k[i] = up ? mn : mx; k[j] = up ? mx : mn; } }
}
template <int N> HD void bitonic_merge_desc(unsigned (&k)[N]) {
#pragma unroll
    for (int stride = N >> 1; stride > 0; stride >>= 1)
#pragma unroll
        for (int i = 0; i < N; ++i) { const int j = i ^ stride;
            if (j > i) { const unsigned a = k[i], b = k[j]; k[i] = a > b ? a : b; k[j] = a > b ? b : a; } }
}
HD int t5_bucket(int rel) {
    const int n = rel < 0 ? -rel : rel;
    int b = rel > 0 ? 16 : 0;
    if (n < 8) return b + n;
    int nn = n * n, lg = 0;
    while ((nn >> (lg + 1)) != 0) ++lg;
    int large = lg + 2;
    if (large > 15) large = 15;
    return b + large;
}

#define LAS __attribute__((address_space(3)))
#define GAS __attribute__((address_space(1)))
typedef const Params __attribute__((address_space(4)))* KParams;
DV KParams kparams() { KParams kp = (KParams)__builtin_amdgcn_kernarg_segment_ptr(); asm volatile("" : "+s"(kp)); return kp; }
DV int opaque_s(int v) { asm volatile("" : "+s"(v)); return v; }
DV int tid_() { int v = threadIdx.x; asm volatile("" : "+v"(v)); return v; }
DV int wave_() { return __builtin_amdgcn_readfirstlane(tid_() >> 6); }
DV float wave_sum(float v) {
#pragma unroll
    for (int o = 1; o < 64; o <<= 1) v += __shfl_xor(v, o);
    return v;
}
DV float wave_max(float v) {
#pragma unroll
    for (int o = 1; o < 64; o <<= 1) v = fmaxf(v, __shfl_xor(v, o));
    return v;
}
DV void glds16(const void* g, void* l) {
    __builtin_amdgcn_global_load_lds((const GAS unsigned*)g, (LAS unsigned*)l, 16, 0, 0);
}
DV u32x4 ldg16(const void* p) { return *(const u32x4*)p; }
DV void stg16(void* p, u32x4 v) { *(u32x4*)p = v; }

DV void cvt_job(const float* src, bf16_t* dst, size_t n, int bid, int nblk) {
    const size_t n8 = n / 8;
    for (size_t i = (size_t)bid * NTH + tid_(); i < n8; i += (size_t)nblk * NTH) {
        const f32x4 a = *(const f32x4*)(src + i * 8), b = *(const f32x4*)(src + i * 8 + 4);
        u32x4 o; o.x = pk2(a.x, a.y); o.y = pk2(a.z, a.w); o.z = pk2(b.x, b.y); o.w = pk2(b.z, b.w);
        stg16(dst + i * 8, o);
    }
}
DV void transpose_item(const float* W, int K, int N, bf16_t* WT, int item, float* s  ) {
    const int ntn = N / 64, kb = item / ntn, nb = item - kb * ntn, k0 = kb * 64, n0 = nb * 64, tid = tid_();
    __syncthreads();
#pragma unroll
    for (int i = 0; i < 8; ++i) { const int idx = tid + i * NTH, r = idx >> 6, c = idx & 63; s[r * 65 + c] = W[(size_t)(k0 + r) * N + n0 + c]; }
    __syncthreads();
#pragma unroll
    for (int i = 0; i < 4; ++i) { const int idx = tid + i * NTH, n = idx >> 5, kp = idx & 31;
        *(unsigned*)(WT + (size_t)(n0 + n) * K + k0 + 2 * kp) = pk2(s[(2 * kp) * 65 + n], s[(2 * kp + 1) * 65 + n]); }
}
DV void transpose_job(const float* W, int K, int N, bf16_t* WT, int bid, int nblk, float* s) {
    const int items = (K / 64) * (N / 64);
    for (int it = bid; it < items; it += nblk) transpose_item(W, K, N, WT, it, s);
}
DV void filter_mlp_job(KParams p, int bid, int nblk) {
    const int lane = tid_() & 63, wv = wave_();
    bf16_t* h3 = (bf16_t*)(p->ws + WS_H3);
    const int gw = bid * 8 + wv, nw = nblk * 8, l = gw & 1;
    const float* w_in = p->in[10] + (size_t)l * FEMB * FHID;
    const float* w_mid = p->in[11] + (size_t)l * 2 * FHID * FHID;
    const float* fb = p->in[12] + (size_t)l * 3 * FHID;
    const float* ff = p->in[13] + (size_t)l * 3 * FHID;
    unsigned wi[17], wm[2][FHID / 2];
#pragma unroll
    for (int i = 0; i < 16; ++i) wi[i] = pk2(w_in[(2 * i) * FHID + lane], w_in[(2 * i + 1) * FHID + lane]);
    wi[16] = pk2(w_in[32 * FHID + lane], 0.f);
#pragma unroll
    for (int q = 0; q < 2; ++q)
#pragma unroll
        for (int i = 0; i < FHID / 2; ++i) wm[q][i] = pk2(w_mid[(q * FHID + 2 * i) * FHID + lane], w_mid[(q * FHID + 2 * i + 1) * FHID + lane]);
    const float b0 = fb[lane], b1 = fb[FHID + lane], b2 = fb[2 * FHID + lane], f0 = ff[lane], f1 = ff[FHID + lane], f2 = ff[2 * FHID + lane];
#pragma unroll 1
    for (int pos = gw >> 1; pos < SEQL; pos += nw >> 1) {
        const float tt = (float)pos / (float)(SEQL - 1);
        const float wang = 6.283185307179586f * (float)pos / (float)SEQL;
        float zf = 0.f;
        if (lane == 0) zf = tt;
        else if (lane < 33) { const int bi = (lane - 1) & 15; const float band = 1e-4f + (float)bi * ((15.f - 1e-4f) / 15.f); const float ang = wang * band;
            zf = lane <= 16 ? __cosf(ang) : -__sinf(ang); }
        float acc = 0.f;
#pragma unroll
        for (int i = 0; i < 16; ++i) { acc += __shfl(zf, 2 * i) * bflo(wi[i]); acc += __shfl(zf, 2 * i + 1) * bfhi(wi[i]); }
        acc += __shfl(zf, 32) * bflo(wi[16]);
        float h = __sinf(f0 * (acc + b0));
        float a2 = 0.f;
#pragma unroll
        for (int i = 0; i < FHID / 2; ++i) { a2 += __shfl(h, 2 * i) * bflo(wm[0][i]); a2 += __shfl(h, 2 * i + 1) * bfhi(wm[0][i]); }
        h = __sinf(f1 * (a2 + b1));
        a2 = 0.f;
#pragma unroll
        for (int i = 0; i < FHID / 2; ++i) { a2 += __shfl(h, 2 * i) * bflo(wm[1][i]); a2 += __shfl(h, 2 * i + 1) * bfhi(wm[1][i]); }
        h = __sinf(f2 * (a2 + b2));
        h3[((size_t)l * SEQL + pos) * FHID + lane] = f2bf(h);
    }
}

constexpr int G_BM = 256, G_BN = 128, G_BK = 32;
constexpr int G_ABYTES = G_BM * G_BK * 2, G_BBYTES = G_BN * G_BK * 2, G_STAGE = G_ABYTES + G_BBYTES;
constexpr int G_LDS = 2 * G_STAGE;
DV void gemm_stage(const bf16_t* A, int lda, const bf16_t* Bt, int ldb, int kt, unsigned char* sbuf) {
    const int tid = tid_();
#pragma unroll
    for (int i = 0; i < 2; ++i) { const int b = tid * 16 + i * 8192, r = b >> 6, c = (b & 63) >> 1;
        glds16(A + (size_t)r * lda + kt * G_BK + c, sbuf + b); }
    { const int b = tid * 16, r = b >> 6, c = (b & 63) >> 1;
        glds16(Bt + (size_t)r * ldb + kt * G_BK + c, sbuf + G_ABYTES + b); }
}
DV void gemm_kloop(f32x4 (&acc)[4][4], const bf16_t* A, int lda, const bf16_t* Bt, int ldb, int nk, unsigned char* smem) {
    const int lane = tid_() & 63, wid = wave_(), wr = wid >> 1, wc = wid & 1, fr = lane & 15, fq = lane >> 4;
    __syncthreads();
    gemm_stage(A, lda, Bt, ldb, 0, smem);
#pragma unroll 1
    for (int t = 0; t < nk; ++t) {
        unsigned char* cur = smem + (t & 1) * G_STAGE;
        asm volatile("s_waitcnt vmcnt(0)" ::: "memory");
        __syncthreads();
        if (t + 1 < nk) gemm_stage(A, lda, Bt, ldb, t + 1, smem + ((t + 1) & 1) * G_STAGE);
        bf16x8 a[4], b[4];
#pragma unroll
        for (int m = 0; m < 4; ++m) a[m] = *(const bf16x8*)(cur + (wr * 64 + m * 16 + fr) * 64 + fq * 16);
#pragma unroll
        for (int n = 0; n < 4; ++n) b[n] = *(const bf16x8*)(cur + G_ABYTES + (wc * 64 + n * 16 + fr) * 64 + fq * 16);
#pragma unroll
        for (int m = 0; m < 4; ++m)
#pragma unroll
            for (int n = 0; n < 4; ++n) acc[m][n] = __builtin_amdgcn_mfma_f32_16x16x32_bf16(b[n], a[m], acc[m][n], 0, 0, 0);
    }
}
DV void acc_zero(f32x4 (&acc)[4][4]) {
#pragma unroll
    for (int m = 0; m < 4; ++m)
#pragma unroll
        for (int n = 0; n < 4; ++n) acc[m][n] = (f32x4){0.f, 0.f, 0.f, 0.f};
}
struct TileCoord { int row0, col0, wr, wc, fr, fq; };
DV TileCoord tile_coord(int pm, int pn) {
    const int lane = tid_() & 63, wid = wave_();
    TileCoord c; c.row0 = pm * G_BM; c.col0 = pn * G_BN; c.wr = wid >> 1; c.wc = wid & 1; c.fr = lane & 15; c.fq = lane >> 4; return c;
}
DV void epi_store_bf16(const f32x4 (&acc)[4][4], const TileCoord& c, bf16_t* O, int ldo, int ocol0, const float* bias  ) {
#pragma unroll
    for (int n = 0; n < 4; ++n) {
        const int cl = c.wc * 64 + n * 16 + c.fq * 4;
        f32x4 bv = (f32x4){0.f, 0.f, 0.f, 0.f};
        if (bias) bv = *(const f32x4*)(bias + cl);
#pragma unroll
        for (int m = 0; m < 4; ++m) {
            const int row = c.row0 + c.wr * 64 + m * 16 + c.fr;
            const f32x4 v = acc[m][n] + bv;
            u32x2 o; o.x = pk2(v.x, v.y); o.y = pk2(v.z, v.w);
            *(u32x2*)(O + (size_t)row * ldo + ocol0 + cl) = o;
        }
    }
}

DV void filt_tile(KParams p, int l, int tile, unsigned char* smem) {
    const int pm = tile >> 7, pn = tile & 127;
    const TileCoord c = tile_coord(pm, pn);
    const bf16_t* A = (const bf16_t*)(p->ws + WS_WOT) + (size_t)l * 2048 * FHID;
    const bf16_t* Bt = (const bf16_t*)(p->ws + WS_H3) + (size_t)l * SEQL * FHID;
    f32x4 acc[4][4]; acc_zero(acc);
    gemm_kloop(acc, A + (size_t)c.row0 * FHID, FHID, Bt + (size_t)c.col0 * FHID, FHID, FHID / G_BK, smem);
    epi_store_bf16(acc, c, (bf16_t*)(p->ws + WS_FILT), SEQL, c.col0, nullptr);
}
DV void ln_job(const float* gq, const float* bq, const bf16_t* src, bf16_t* dstb, float* dstf, int bid, int nblk, unsigned char* dst8 = nullptr) {
    const int lane = tid_() & 63, wv = wave_();
    const size_t step = (size_t)nblk * 8;
    f32x4 gg[4], bb[4];
#pragma unroll
    for (int i = 0; i < 4; ++i) { gg[i] = *(const f32x4*)(gq + lane * 16 + 4 * i); bb[i] = *(const f32x4*)(bq + lane * 16 + 4 * i); }
#pragma unroll 1
    for (size_t row0 = (size_t)bid * 8 + wv; row0 < (size_t)T; row0 += 2 * step) {
        const bool two = row0 + step < (size_t)T; const size_t row1 = two ? row0 + step : row0;
        u32x4 raw[2][2];
        raw[0][0] = ldg16(src + row0 * D + lane * 16); raw[0][1] = ldg16(src + row0 * D + lane * 16 + 8);
        raw[1][0] = ldg16(src + row1 * D + lane * 16); raw[1][1] = ldg16(src + row1 * D + lane * 16 + 8);
#pragma unroll
        for (int k = 0; k < 2; ++k) {
            if (k == 1 && !two) break;
            const size_t row = k ? row1 : row0;
            float v[16];
#pragma unroll
            for (int h = 0; h < 2; ++h) { const u32x4 w = raw[k][h];
                v[8 * h + 0] = bflo(w.x); v[8 * h + 1] = bfhi(w.x); v[8 * h + 2] = bflo(w.y); v[8 * h + 3] = bfhi(w.y); v[8 * h + 4] = bflo(w.z); v[8 * h + 5] = bfhi(w.z); v[8 * h + 6] = bflo(w.w); v[8 * h + 7] = bfhi(w.w); }
            float sm = 0.f;
#pragma unroll
            for (int i = 0; i < 16; ++i) sm += v[i];
            const float mean = wave_sum(sm) * (1.f / D); float s2 = 0.f;
#pragma unroll
            for (int i = 0; i < 16; ++i) { v[i] -= mean; s2 += v[i] * v[i]; }
            const float rstd = rsqrtf(wave_sum(s2) * (1.f / D) + LN_EPS);
#pragma unroll
            for (int i = 0; i < 16; ++i) v[i] = v[i] * rstd * gg[i >> 2][i & 3] + bb[i >> 2][i & 3];
            if (dstb) { u32x4 o0, o1; o0.x = pk2(v[0], v[1]); o0.y = pk2(v[2], v[3]); o0.z = pk2(v[4], v[5]); o0.w = pk2(v[6], v[7]);
                o1.x = pk2(v[8], v[9]); o1.y = pk2(v[10], v[11]); o1.z = pk2(v[12], v[13]); o1.w = pk2(v[14], v[15]);
                stg16(dstb + row * D + lane * 16, o0); stg16(dstb + row * D + lane * 16 + 8, o1);
                if (dst8) {
                    int hw[4];
#pragma unroll
                    for (int i = 0; i < 4; ++i) { int h = 0; h = __builtin_amdgcn_cvt_pk_fp8_f32(v[4 * i], v[4 * i + 1], h, false); h = __builtin_amdgcn_cvt_pk_fp8_f32(v[4 * i + 2], v[4 * i + 3], h, true); hw[i] = h; }
                    stg16(dst8 + row * D + lane * 16, (u32x4){(unsigned)hw[0], (unsigned)hw[1], (unsigned)hw[2], (unsigned)hw[3]}); } }
            else {
#pragma unroll
                for (int i = 0; i < 4; ++i) *(f32x4*)(dstf + row * D + lane * 16 + 4 * i) = (f32x4){v[4 * i], v[4 * i + 1], v[4 * i + 2], v[4 * i + 3]}; }
        }
    }
}
DV void ln1_job(KParams p, int l, int bid, int nblk) { ln_job(p->in[19] + (size_t)l * D, p->in[20] + (size_t)l * D, (const bf16_t*)p->out, (bf16_t*)(p->ws + WS_XB), nullptr, bid, nblk, p->ws + WS_X8); }
namespace pg8 {
constexpr int BM = 256, BK = 64, HALF = 128, HTB = HALF * BK * 2  , STAGE_BYTES = 8 * HTB, NXCD = 8, WGM = 8;
DV int lds_byte(int r, int c) { const int st = (r >> 4) * 2 + (c >> 5), rr = r & 15, cc = c & 31, ob = rr * 64 + cc * 2; return st * 1024 + (ob ^ (((ob >> 9) & 1) << 5)); }
DV void stage_rc(int b, int& R, int& C) { const int st = b / 1024, sb = b % 1024, swz = sb ^ (((sb >> 9) & 1) << 5); R = (st >> 1) * 16 + swz / 64; C = (st & 1) * 32 + (swz % 64) / 2; }
DV int perm32(int rho) { const int n = rho >> 4, i = rho & 15; return 8 * (i >> 2) + 4 * n + (i & 3); }
struct UnitX { const char* A; const char* B; unsigned lda2, ldb2; int nt, tag, pm, pn; };
DV bool static_tile(int nM, int nN, int G, int c, int i, int& pm, int& pn) {
    const int nwg = nM * nN; const long L = (long)i * G + c; if (L >= nwg) return false;
    int wgid = (int)L; { const int q = nwg / NXCD, r = nwg % NXCD, xcd = wgid % NXCD, off = wgid / NXCD; wgid = (xcd < r ? xcd * (q + 1) : r * (q + 1) + (xcd - r) * q) + off; }
    const int nig = WGM * nN, gid = wgid / nig, fm = gid * WGM, gsz = (nM - fm) < WGM ? (nM - fm) : WGM;
    pm = fm + ((wgid % nig) % gsz); pn = (wgid % nig) / gsz; return true;
}
template <class Epi, class Sched>
DV void gemm_stream(LAS unsigned char* lds, const Sched& S, Epi& E) {
    const int tid = tid_(), wid = __builtin_amdgcn_readfirstlane(tid >> 6), lane = tid & 63, wr = wid >> 2, wc = wid & 3, fr = lane & 15, fq = lane >> 4;
    unsigned rA[2], rB[2], c2[2];
#pragma unroll
    for (int i = 0; i < 2; ++i) { int R, C; stage_rc(tid * 16 + i * 8192, R, C); rA[i] = (unsigned)R; rB[i] = (unsigned)(Epi::PERM ? ((R & ~31) + perm32(R & 31)) : R); c2[i] = (unsigned)C * 2u; }
    const size_t kstep = (size_t)(BK * 2);
    const unsigned ldsw = (unsigned)wid * 1024u;
    const int aoff = lds_byte(wr * 64 + fr, fq * 8), boff = lds_byte(wc * 32 + fr, fq * 8);
#define PG8_SA(b, h) (((b) * 2 + (h)) * HTB)
#define PG8_SB(b, h) ((4 + (b) * 2 + (h)) * HTB)
#define PG8_STAGE(bufoff, gbase, voff) do { _Pragma("unroll") for (int _i = 0; _i < 2; ++_i) \
        __builtin_amdgcn_global_load_lds((const GAS unsigned*)((const char*)(gbase) + (voff)[_i]), (LAS unsigned*)(lds + (bufoff) + ldsw + _i * 8192), 16, 0, 0); } while (0)
#define PG8_LDA(dst, b, h) do { _Pragma("unroll") for (int m = 0; m < 4; ++m) _Pragma("unroll") for (int k = 0; k < 2; ++k) dst[m][k] = *(const LAS bf16x8*)(lds + PG8_SA(b, h) + aoff + m * 2048 + k * 1024); } while (0)
#define PG8_LDB(dst, b, h) do { _Pragma("unroll") for (int n = 0; n < 2; ++n) _Pragma("unroll") for (int k = 0; k < 2; ++k) dst[n][k] = *(const LAS bf16x8*)(lds + PG8_SB(b, h) + boff + n * 2048 + k * 1024); } while (0)
#define PG8_MMA(ai, bj, At, Bt) do { __builtin_amdgcn_s_setprio(1); _Pragma("unroll") for (int m = 0; m < 4; ++m) _Pragma("unroll") for (int n = 0; n < 2; ++n) _Pragma("unroll") for (int k = 0; k < 2; ++k) \
        acc[ai][bj][m][n] = __builtin_amdgcn_mfma_f32_16x16x32_bf16(Bt[n][k], At[m][k], acc[ai][bj][m][n], 0, 0, 0); __builtin_amdgcn_s_setprio(0); } while (0)
#define PG8_WAIT_V(n) asm volatile("s_waitcnt vmcnt(" #n ")" ::: "memory")
#define PG8_WAIT_L(n) asm volatile("s_waitcnt lgkmcnt(" #n ")" ::: "memory")
#define PG8_BAR __builtin_amdgcn_s_barrier()
#define PG8_SCHED __builtin_amdgcn_sched_barrier(0)
    UnitX cur, nxt; int ui = 0;
    if (!S.next(0, cur)) return;
    f32x4 acc[2][2][4][2];
#pragma unroll
    for (int a = 0; a < 2; ++a)
#pragma unroll
        for (int b = 0; b < 2; ++b)
#pragma unroll
            for (int m = 0; m < 4; ++m)
#pragma unroll
                for (int n = 0; n < 2; ++n) acc[a][b][m][n] = (f32x4){0.f, 0.f, 0.f, 0.f};
    bf16x8 At[4][2], B0[2][2], B1[2][2];
    const char* cA = cur.A; const char* cB = cur.B;
    unsigned clda = cur.lda2, cldb = cur.ldb2;
    {
        unsigned vA[2], vB[2];
#pragma unroll
        for (int i = 0; i < 2; ++i) { vA[i] = rA[i] * clda + c2[i]; vB[i] = rB[i] * cldb + c2[i]; }
        const size_t hA = (size_t)HALF * clda, hB = (size_t)HALF * cldb;
        PG8_STAGE(PG8_SB(0, 0), cB, vB); PG8_STAGE(PG8_SA(0, 0), cA, vA); PG8_STAGE(PG8_SB(0, 1), cB + hB, vB); PG8_STAGE(PG8_SA(0, 1), cA + hA, vA);
        if (wr == 1) PG8_BAR;
        PG8_WAIT_V(4); PG8_BAR;
        PG8_STAGE(PG8_SB(1, 0), cB + kstep, vB); PG8_STAGE(PG8_SA(1, 0), cA + kstep, vA); PG8_STAGE(PG8_SB(1, 1), cB + hB + kstep, vB);
        PG8_WAIT_V(6); PG8_BAR;
    }
    for (;;) {
        const bool has_next = S.next(ui + 1, nxt);
        const char* nA = has_next ? nxt.A : cA; const char* nB = has_next ? nxt.B : cB;
        const unsigned nlda = has_next ? nxt.lda2 : clda, nldb = has_next ? nxt.ldb2 : cldb;
        const int nt = cur.nt;
#pragma unroll 1
        for (int t = 0; t < nt; t += 2) {
            const bool last = (t == nt - 2);
            const char* a1 = cA + (size_t)(t + 1) * kstep;
            const char* a2 = last ? nA : cA + (size_t)(t + 2) * kstep; const char* b2 = last ? nB : cB + (size_t)(t + 2) * kstep;
            const char* a3 = a2 + kstep; const char* b3 = b2 + kstep;
            const unsigned xlda = last ? nlda : clda, xldb = last ? nldb : cldb;
            unsigned vA[2], xA[2], xB[2];
#pragma unroll
            for (int i = 0; i < 2; ++i) { vA[i] = rA[i] * clda + c2[i]; xA[i] = rA[i] * xlda + c2[i]; xB[i] = rB[i] * xldb + c2[i]; }
            const size_t hA = (size_t)HALF * clda, xhA = (size_t)HALF * xlda, xhB = (size_t)HALF * xldb;
            PG8_LDB(B0, 0, 0); PG8_SCHED; PG8_LDA(At, 0, 0); PG8_STAGE(PG8_SA(1, 1), a1 + hA, vA);
            PG8_WAIT_L(8); PG8_BAR; PG8_WAIT_L(0); PG8_MMA(0, 0, At, B0); PG8_BAR; PG8_SCHED;
            PG8_LDB(B1, 0, 1); PG8_STAGE(PG8_SB(0, 0), b2, xB);
            PG8_BAR; PG8_WAIT_L(0); PG8_MMA(0, 1, At, B1); PG8_BAR;
            PG8_LDA(At, 0, 1); PG8_STAGE(PG8_SA(0, 0), a2, xA);
            PG8_BAR; PG8_WAIT_L(0); PG8_MMA(1, 0, At, B0); PG8_BAR; PG8_SCHED;
            PG8_STAGE(PG8_SB(0, 1), b2 + xhB, xB);
            PG8_WAIT_V(6); PG8_BAR; PG8_MMA(1, 1, At, B1); PG8_BAR;
            PG8_LDB(B0, 1, 0); PG8_SCHED; PG8_LDA(At, 1, 0); PG8_STAGE(PG8_SA(0, 1), a2 + xhA, xA);
            PG8_WAIT_L(8); PG8_BAR; PG8_WAIT_L(0); PG8_MMA(0, 0, At, B0); PG8_BAR; PG8_SCHED;
            PG8_LDB(B1, 1, 1); PG8_STAGE(PG8_SB(1, 0), b3, xB);
            PG8_BAR; PG8_WAIT_L(0); PG8_MMA(0, 1, At, B1); PG8_BAR;
            PG8_LDA(At, 1, 1); PG8_STAGE(PG8_SA(1, 0), a3, xA);
            PG8_BAR; PG8_WAIT_L(0); PG8_MMA(1, 0, At, B0); PG8_BAR; PG8_SCHED;
            PG8_STAGE(PG8_SB(1, 1), b3 + xhB, xB);
            PG8_WAIT_V(6); PG8_BAR; PG8_MMA(1, 1, At, B1); PG8_BAR;
        }
        E(acc, cur, wr, wc, fr, fq);
        if (!has_next) break;
#pragma unroll
        for (int a = 0; a < 2; ++a)
#pragma unroll
            for (int b = 0; b < 2; ++b)
#pragma unroll
                for (int m = 0; m < 4; ++m)
#pragma unroll
                    for (int n = 0; n < 2; ++n) acc[a][b][m][n] = (f32x4){0.f, 0.f, 0.f, 0.f};
        cur = nxt; cA = nA; cB = nB; clda = nlda; cldb = nldb; ++ui;
    }
    PG8_WAIT_V(0);
    if (wr == 0) PG8_BAR;
    PG8_BAR;
#undef PG8_SA
#undef PG8_SB
#undef PG8_STAGE
#undef PG8_LDA
#undef PG8_LDB
#undef PG8_MMA
#undef PG8_WAIT_V
#undef PG8_WAIT_L
#undef PG8_BAR
#undef PG8_SCHED
}
}
DV void pg8_store_bf16_perm(const f32x4 (&acc)[2][2][4][2], bf16_t* O  , int ldo, const float* bias  , int wr, int wc, int fr, int fq) {
    const int col0 = wc * 32 + 8 * fq;
    f32x4 bv[2][2];
#pragma unroll
    for (int bj = 0; bj < 2; ++bj)
#pragma unroll
        for (int n = 0; n < 2; ++n) bv[bj][n] = bias ? *(const f32x4*)(bias + col0 + bj * 128 + 4 * n) : (f32x4){0.f, 0.f, 0.f, 0.f};
#pragma unroll
    for (int ai = 0; ai < 2; ++ai)
#pragma unroll
        for (int m = 0; m < 4; ++m) { bf16_t* rowp = O + (size_t)(ai * 128 + wr * 64 + m * 16 + fr) * ldo + col0;
#pragma unroll
            for (int bj = 0; bj < 2; ++bj) { const f32x4 v0 = acc[ai][bj][m][0] + bv[bj][0], v1 = acc[ai][bj][m][1] + bv[bj][1];
                u32x4 w; w.x = pk2(v0.x, v0.y); w.y = pk2(v0.z, v0.w); w.z = pk2(v1.x, v1.y); w.w = pk2(v1.z, v1.w);
                *(u32x4*)(rowp + bj * 128) = w; } }
}
struct EpiG1 { static constexpr bool PERM = true; KParams p; int l;
    DV void operator()(const f32x4 (&acc)[2][2][4][2], const pg8::UnitX& u, int wr, int wc, int fr, int fq) const {
        bf16_t* O; int ldo, oc; const float* bias = nullptr;
        const int upm = opaque_s(u.pm), upn = opaque_s(u.pn);
        if (u.tag == 0) {
            const int col0 = upn * 256; bias = p->in[6] + (size_t)l * IN_WIDTH + col0;
            if (upn < 3) { O = (bf16_t*)(p->ws + WS_QKV); ldo = 768; oc = col0; }
            else if (upn < 9) { O = (bf16_t*)(p->ws + WS_HY); ldo = HY3; oc = col0 - O_HY; }
            else { O = (bf16_t*)((unsigned char*)p->out + DO_QM); ldo = 512; oc = col0 - O_MQ; }
        } else { O = (bf16_t*)(p->ws + WS_KVMEM) + (size_t)(u.tag - 1) * 768 * D; ldo = D; oc = upn * 256; }
        pg8_store_bf16_perm(acc, O + (size_t)upm * 256 * ldo + oc, ldo, bias, wr, wc, fr, fq);
    }
};
struct SchedG1 { KParams p; int l, G, c;
    DV bool next(int i, pg8::UnitX& u) const {
        int pm, pn;
        if (pg8::static_tile(T / 256, O_GATE / 256, G, c, i, pm, pn)) {
            u.A = (const char*)(p->ws + WS_XB) + (size_t)pm * 256 * 2048; u.B = (const char*)(p->ws + WS_W + l * SZ_WL + OFF_WT_IN) + (size_t)pn * 256 * 2048;
            u.lda2 = 2048; u.ldb2 = 2048; u.nt = 16; u.tag = 0; u.pm = pm; u.pn = pn; return true; }
        if (l != 0) return false;
        const int n1 = (T / 256) * (O_GATE / 256), cnt = (n1 - c + G - 1) / G, j = i - cnt, c2 = (c + G - 64) % G, idx = j * G + c2;
        if (idx >= 24) return false;
        const int ll = idx / 12, r = idx - ll * 12; pm = r >> 2; pn = r & 3;
        u.A = (const char*)(p->ws + WS_MEMB) + (size_t)pm * 256 * 2048; u.B = (const char*)(p->ws + WS_W + ll * SZ_WL + OFF_WT_MKV) + (size_t)pn * 256 * 2048;
        u.lda2 = 2048; u.ldb2 = 2048; u.nt = 16; u.tag = 1 + ll; u.pm = pm; u.pn = pn; return true;
    }
};
struct EpiOut { static constexpr bool PERM = true; KParams p;
    DV void operator()(const f32x4 (&acc)[2][2][4][2], const pg8::UnitX& u, int wr, int wc, int fr, int fq) const {
        const bf16_t* xb = (const bf16_t*)(p->ws + WS_XB); bf16_t* o = (bf16_t*)p->out;
        const int upm = opaque_s(u.pm), upn = opaque_s(u.pn);
        const size_t base = ((size_t)upm * 256 + wr * 64 + fr) * D + upn * 256 + wc * 32 + 8 * fq;
#pragma unroll
        for (int ai = 0; ai < 2; ++ai) {
            u32x4 xv[4][2];
#pragma unroll
            for (int m = 0; m < 4; ++m)
#pragma unroll
                for (int bj = 0; bj < 2; ++bj) xv[m][bj] = ldg16(xb + base + (size_t)(ai * 128 + m * 16) * D + bj * 128);
#pragma unroll
            for (int m = 0; m < 4; ++m)
#pragma unroll
                for (int bj = 0; bj < 2; ++bj) { const u32x4 x = xv[m][bj]; const f32x4 a0 = acc[ai][bj][m][0], a1 = acc[ai][bj][m][1];
                    u32x4 w; w.x = pk2(a0.x + ALPHA * bflo(x.x), a0.y + ALPHA * bfhi(x.x)); w.y = pk2(a0.z + ALPHA * bflo(x.y), a0.w + ALPHA * bfhi(x.y));
                    w.z = pk2(a1.x + ALPHA * bflo(x.z), a1.y + ALPHA * bfhi(x.z)); w.w = pk2(a1.z + ALPHA * bflo(x.w), a1.w + ALPHA * bfhi(x.w));
                    stg16(o + base + (size_t)(ai * 128 + m * 16) * D + bj * 128, w); }
            asm volatile("" ::: "memory"); }
    }
};
struct SchedOut { KParams p; int l, G, c;
    DV bool next(int i, pg8::UnitX& u) const {
        int pm, pn; if (!pg8::static_tile(T / 256, D / 256, G, c, i, pm, pn)) return false;
        u.A = (const char*)(p->ws + WS_HY) + (size_t)T * 512 * 2 + (size_t)pm * 256 * 2048; u.B = (const char*)(p->ws + WS_W + l * SZ_WL + OFF_WT_OUT) + (size_t)pn * 256 * 2048;
        u.lda2 = 2048; u.ldb2 = 2048; u.nt = 16; u.tag = 0; u.pm = pm; u.pn = pn; return true; }
};
struct EpiQ { static constexpr bool PERM = true; KParams p;
    DV void operator()(const f32x4 (&acc)[2][2][4][2], const pg8::UnitX& u, int wr, int wc, int fr, int fq) const {
        pg8_store_bf16_perm(acc, (bf16_t*)p->out + (size_t)opaque_s(u.pm) * 256 * 2048 + opaque_s(u.pn) * 256, 2048, nullptr, wr, wc, fr, fq); }
};
struct SchedQ { KParams p; int l, G, c;
    DV bool next(int i, pg8::UnitX& u) const {
        int pm, pn; if (!pg8::static_tile(T / 256, 2048 / 256, G, c, i, pm, pn)) return false;
        u.A = (const char*)(p->ws + WS_XB) + (size_t)pm * 256 * 2048; u.B = (const char*)(p->ws + WS_W + l * SZ_WL + OFF_WT_Q) + (size_t)pn * 256 * 2048;
        u.lda2 = 2048; u.ldb2 = 2048; u.nt = 16; u.tag = 0; u.pm = pm; u.pn = pn; return true; }
};
struct EpiMerge { static constexpr bool PERM = true; KParams p; int l;
    DV void operator()(const f32x4 (&acc)[2][2][4][2], const pg8::UnitX& u, int wr, int wc, int fr, int fq) const {
        const int n = u.tag >> 1, col0 = wc * 32 + 8 * fq, upm = opaque_s(u.pm), upn = opaque_s(u.pn);
        u32x4* sp = (u32x4*)((unsigned char*)p->out) + (size_t)blockIdx.x * 16 * NTH + threadIdx.x;
        if ((u.tag & 1) == 0) {
            const float* bias = p->in[6] + (size_t)l * IN_WIDTH + O_GATE + n * D + upn * 256 + col0;
            f32x4 bv[2][2];
#pragma unroll
            for (int bj = 0; bj < 2; ++bj)
#pragma unroll
                for (int nn = 0; nn < 2; ++nn) bv[bj][nn] = *(const f32x4*)(bias + bj * 128 + 4 * nn);
#pragma unroll
            for (int ai = 0; ai < 2; ++ai)
#pragma unroll
                for (int m = 0; m < 4; ++m) {
#pragma unroll
                    for (int bj = 0; bj < 2; ++bj) { const f32x4 v0 = acc[ai][bj][m][0] + bv[bj][0], v1 = acc[ai][bj][m][1] + bv[bj][1];
                        u32x4 w;
                        w.x = pk2(__builtin_amdgcn_rcpf(1.f + __expf(-v0.x)), __builtin_amdgcn_rcpf(1.f + __expf(-v0.y))); w.y = pk2(__builtin_amdgcn_rcpf(1.f + __expf(-v0.z)), __builtin_amdgcn_rcpf(1.f + __expf(-v0.w)));
                        w.z = pk2(__builtin_amdgcn_rcpf(1.f + __expf(-v1.x)), __builtin_amdgcn_rcpf(1.f + __expf(-v1.y))); w.w = pk2(__builtin_amdgcn_rcpf(1.f + __expf(-v1.z)), __builtin_amdgcn_rcpf(1.f + __expf(-v1.w)));
                        sp[bj * NTH] = w; }
                    sp += 2 * NTH; asm volatile("" : "+v"(sp)); }
        } else {
            bf16_t* rowp = (bf16_t*)(p->ws + WS_HY) + (size_t)T * 512 + ((size_t)upm * 256 + wr * 64 + fr) * D + upn * 256 + col0;
#pragma unroll
            for (int ai = 0; ai < 2; ++ai) {
                u32x4 g[4][2], o[4][2];
#pragma unroll
                for (int m = 0; m < 4; ++m)
#pragma unroll
                    for (int bj = 0; bj < 2; ++bj) { g[m][bj] = sp[(m * 2 + bj) * NTH]; if (n > 0) o[m][bj] = *(const u32x4*)(rowp + (size_t)m * 16 * D + bj * 128); }
#pragma unroll
                for (int m = 0; m < 4; ++m)
#pragma unroll
                    for (int bj = 0; bj < 2; ++bj) { const f32x4 a0 = acc[ai][bj][m][0], a1 = acc[ai][bj][m][1]; const u32x4 gg = g[m][bj];
                        float r[8] = {bflo(gg.x) * a0.x, bfhi(gg.x) * a0.y, bflo(gg.y) * a0.z, bfhi(gg.y) * a0.w, bflo(gg.z) * a1.x, bfhi(gg.z) * a1.y, bflo(gg.w) * a1.z, bfhi(gg.w) * a1.w};
                        if (n > 0) { const u32x4 oo = o[m][bj];
                            r[0] += bflo(oo.x); r[1] += bfhi(oo.x); r[2] += bflo(oo.y); r[3] += bfhi(oo.y); r[4] += bflo(oo.z); r[5] += bfhi(oo.z); r[6] += bflo(oo.w); r[7] += bfhi(oo.w); }
                        u32x4 w; w.x = pk2(r[0], r[1]); w.y = pk2(r[2], r[3]); w.z = pk2(r[4], r[5]); w.w = pk2(r[6], r[7]);
                        *(u32x4*)(rowp + (size_t)m * 16 * D + bj * 128) = w; }
                sp += 8 * NTH; rowp += 128 * D; asm volatile("" : "+v"(sp), "+v"(rowp)); }
        }
    }
};
struct SchedMerge { KParams p; int l, G, c;
    DV bool next(int i, pg8::UnitX& u) const {
        const int ti = i / 6, sub = i - ti * 6, n = sub >> 1;
        int pm, pn; if (!pg8::static_tile(T / 256, D / 256, G, c, ti, pm, pn)) return false;
        u.tag = sub; u.pm = pm; u.pn = pn;
        if ((sub & 1) == 0) {
            u.A = (const char*)(p->ws + WS_XB) + (size_t)pm * 256 * 2048; u.B = (const char*)(p->ws + WS_W + l * SZ_WL + OFF_WT_IN) + (size_t)(O_GATE + n * D + pn * 256) * 2048;
            u.lda2 = 2048; u.ldb2 = 2048; u.nt = 16;
        } else {
            if (n == 0) { u.A = (const char*)(p->ws + WS_QKV) + (size_t)pm * 256 * 1536; u.lda2 = 1536; }
            else if (n == 1) { u.A = (const char*)(p->ws + WS_HY) + (size_t)pm * 256 * 1024; u.lda2 = 1024; }
            else { u.A = (const char*)p->out + DO_QM + (size_t)pm * 256 * 1024; u.lda2 = 1024; }
            u.B = (const char*)(p->ws + WS_W + l * SZ_WL + OFF_WT_BR) + (size_t)(n * D + pn * 256) * 1024; u.ldb2 = 1024; u.nt = 8;
        }
        return true; }
};
DV void shortconv_item(KParams p, int l, int item, float* s  ) {
    const int tid = tid_();
    const int ct = item % 24, r = item / 24, tt = r % 64, seq = r / 64;
    const int t0 = tt * 256, c0 = ct * 64;
    const bf16_t* hy = (const bf16_t*)(p->ws + WS_HY);
    bf16_t* uct = (bf16_t*)((unsigned char*)p->out + DO_UCT);
    u32x4 v[5];
#pragma unroll
    for (int i = 0; i < 5; ++i) {
        const int idx = tid + i * NTH, rr = idx >> 3, ch = idx & 7, t = t0 + rr - 1;
        v[i] = (u32x4){0u, 0u, 0u, 0u};
        if (idx < 258 * 8 && t >= 0 && t < SEQL) v[i] = ldg16(hy + ((size_t)seq * SEQL + t) * HY3 + c0 + ch * 8);
    }
    __syncthreads();
#pragma unroll
    for (int i = 0; i < 5; ++i) {
        const int idx = tid + i * NTH, rr = idx >> 3, ch = idx & 7;
        if (idx < 258 * 8) { float* d = s + rr * 65 + ch * 8;
            d[0] = bflo(v[i].x); d[1] = bfhi(v[i].x); d[2] = bflo(v[i].y); d[3] = bfhi(v[i].y); d[4] = bflo(v[i].z); d[5] = bfhi(v[i].z); d[6] = bflo(v[i].w); d[7] = bfhi(v[i].w); }
    }
    __syncthreads();
    const int ch = tid >> 3, tq = tid & 7, cg = c0 + ch;
    const float* cw = p->in[7] + (size_t)l * 3 * HY3; const float cb = p->in[8][(size_t)l * HY3 + cg];
    const float w0 = cw[cg], w1 = cw[HY3 + cg], w2 = cw[2 * HY3 + cg];
#pragma unroll
    for (int grp = 0; grp < 4; ++grp) {
        float o[8];
#pragma unroll
        for (int e = 0; e < 8; ++e) { const int rr = grp * 64 + tq * 8 + e; o[e] = cb + w0 * s[rr * 65 + ch] + w1 * s[(rr + 1) * 65 + ch] + w2 * s[(rr + 2) * 65 + ch]; }
        u32x4 ov; ov.x = pk2(o[0], o[1]); ov.y = pk2(o[2], o[3]); ov.z = pk2(o[4], o[5]); ov.w = pk2(o[6], o[7]);
        stg16(uct + ((size_t)seq * HY3 + cg) * SEQL + t0 + grp * 64 + tq * 8, ov);
    }
}
DV void hyo_transpose_item(KParams p, int item, bf16_t* s  ) {
    const int tid = tid_();
    const int ct = item % 8, r = item / 8, tt = r % 64, seq = r / 64;
    const int t0 = tt * 256, c0 = ct * 64;
    const bf16_t* uct = (const bf16_t*)((unsigned char*)p->out + DO_UCT);
    bf16_t* hyo = (bf16_t*)(p->ws + WS_HY);
    u32x4 v[4];
    { const int ch = tid >> 3, tq = tid & 7;
#pragma unroll
      for (int grp = 0; grp < 4; ++grp) v[grp] = ldg16(uct + ((size_t)seq * HY3 + c0 + ch) * SEQL + t0 + grp * 64 + tq * 8);
      __syncthreads();
#pragma unroll
      for (int grp = 0; grp < 4; ++grp) *(u32x4*)(s + ch * 264 + grp * 64 + tq * 8) = v[grp]; }
    __syncthreads();
#pragma unroll
    for (int i4 = 0; i4 < 4; ++i4) { const int idx = tid + i4 * NTH, t = idx >> 3, cq = idx & 7;
      bf16_t e[8];
#pragma unroll
      for (int i = 0; i < 8; ++i) e[i] = s[(cq * 8 + i) * 264 + t];
      u32x4 o; o.x = e[0] | ((unsigned)e[1] << 16); o.y = e[2] | ((unsigned)e[3] << 16); o.z = e[4] | ((unsigned)e[5] << 16); o.w = e[6] | ((unsigned)e[7] << 16);
      stg16(hyo + ((size_t)seq * SEQL + t0 + t) * 512 + c0 + cq * 8, o); }
}

template <bool WIN> struct AttnCfg {
    static constexpr int HDIM = WIN ? 64 : 128, NK = WIN ? 384 : 256, QT = WIN ? 4 : 2, KS = HDIM / 32, DT = HDIM / 16;
    static constexpr int KSTR = HDIM + 8, VSTR = NK + 8;
    static constexpr int K_BYTES = NK * KSTR * 2, V_BYTES = HDIM * VSTR * 2;
};
template <bool WIN> DV void attn_item(KParams p, int l, int item, unsigned char* smem) {
    typedef AttnCfg<WIN> C;
    const int tid = tid_(), lane = tid & 63, w = wave_(), fr = lane & 15, fq = lane >> 4;
    bf16_t* Ks = (bf16_t*)smem; bf16_t* Vt = (bf16_t*)(smem + C::K_BYTES); float* biasT = (float*)(smem + C::K_BYTES + C::V_BYTES);
    int seq, blk, hh;
    if (WIN) { hh = item & 1; blk = (item >> 1) & 127; seq = item >> 8; }
    else { hh = item & 3; blk = (item >> 2) % 64; seq = (item >> 2) / 64; }
    __syncthreads();
    if (WIN) {
        const bf16_t* qkv = (const bf16_t*)(p->ws + WS_QKV);
#pragma unroll
        for (int i = 0; i < 6; ++i) {
            const int idx = tid + i * NTH, key = idx >> 3, ch = idx & 7, pos = blk * 128 - 128 + key;
            u32x4 kv = (u32x4){0u, 0u, 0u, 0u}, vv = kv;
            if (pos >= 0 && pos < SEQL) { const bf16_t* row = qkv + ((size_t)seq * SEQL + pos) * 768; kv = ldg16(row + O_K + hh * 64 + ch * 8); vv = ldg16(row + O_V + hh * 64 + ch * 8); }
            *(u32x4*)(Ks + key * C::KSTR + ch * 8) = kv;
            bf16_t* vd = Vt + (ch * 8) * C::VSTR + key;
            vd[0] = (bf16_t)vv.x; vd[C::VSTR] = (bf16_t)(vv.x >> 16); vd[2 * C::VSTR] = (bf16_t)vv.y; vd[3 * C::VSTR] = (bf16_t)(vv.y >> 16);
            vd[4 * C::VSTR] = (bf16_t)vv.z; vd[5 * C::VSTR] = (bf16_t)(vv.z >> 16); vd[6 * C::VSTR] = (bf16_t)vv.w; vd[7 * C::VSTR] = (bf16_t)(vv.w >> 16);
        }
        for (int i = tid; i < 4 * 257; i += NTH) { const int g = i / 257, r = i - g * 257; biasT[i] = p->in[4][t5_bucket(r - 128) * 8 + hh * 4 + g] * 1.4426950408889634f; }
    } else {
        const bf16_t* kvm = (const bf16_t*)(p->ws + WS_KVMEM) + (size_t)l * 768 * D;
#pragma unroll
        for (int i = 0; i < 8; ++i) {
            const int idx = tid + i * NTH, key = idx >> 4, ch = idx & 15;
            const bf16_t* row = kvm + ((size_t)seq * N_MEM + key) * D;
            const u32x4 kv = ldg16(row + hh * 128 + ch * 8), vv = ldg16(row + 512 + hh * 128 + ch * 8);
            *(u32x4*)(Ks + key * C::KSTR + ch * 8) = kv;
            bf16_t* vd = Vt + (ch * 8) * C::VSTR + key;
            vd[0] = (bf16_t)vv.x; vd[C::VSTR] = (bf16_t)(vv.x >> 16); vd[2 * C::VSTR] = (bf16_t)vv.y; vd[3 * C::VSTR] = (bf16_t)(vv.y >> 16);
            vd[4 * C::VSTR] = (bf16_t)vv.z; vd[5 * C::VSTR] = (bf16_t)(vv.z >> 16); vd[6 * C::VSTR] = (bf16_t)vv.w; vd[7 * C::VSTR] = (bf16_t)(vv.w >> 16);
        }
    }
    bf16_t* qbase; int ldq, qcol0, wrow0; size_t tok0; float sink = 0.f; int g = 0;
    if (WIN) { g = w >> 1; qbase = (bf16_t*)(p->ws + WS_QKV); ldq = 768; qcol0 = (hh * 4 + g) * 64; wrow0 = (w & 1) * 64; tok0 = (size_t)seq * SEQL + blk * 128;
               sink = p->in[9][(size_t)l * 8 + hh * 4 + g] * 1.4426950408889634f; }
    else { qbase = (bf16_t*)((unsigned char*)p->out + DO_QM); ldq = 512; qcol0 = hh * 128; wrow0 = w * 32; tok0 = (size_t)seq * SEQL + blk * 256; }
    bf16x8 bq[C::QT][C::KS];
#pragma unroll
    for (int qt = 0; qt < C::QT; ++qt)
#pragma unroll
        for (int ks = 0; ks < C::KS; ++ks) bq[qt][ks] = *(const bf16x8*)(qbase + (tok0 + wrow0 + qt * 16 + fr) * ldq + qcol0 + ks * 32 + fq * 8);
    f32x4 o[C::QT][C::DT]; float m[C::QT], ls[C::QT];
#pragma unroll
    for (int qt = 0; qt < C::QT; ++qt) { m[qt] = WIN ? sink : -1e30f; ls[qt] = (WIN && fq == 0) ? 1.f : 0.f;
#pragma unroll
        for (int dt = 0; dt < C::DT; ++dt) o[qt][dt] = (f32x4){0.f, 0.f, 0.f, 0.f}; }
    const float scale = (WIN ? 0.125f : 0.08838834764831845f) * 1.4426950408889634f;
    __syncthreads();
#pragma unroll 1
    for (int kc = 0; kc < C::NK / 32; ++kc) {
        bf16x8 ak[2][C::KS];
#pragma unroll
        for (int kt = 0; kt < 2; ++kt)
#pragma unroll
            for (int ks = 0; ks < C::KS; ++ks) ak[kt][ks] = *(const bf16x8*)(Ks + (kc * 32 + kt * 16 + fr) * C::KSTR + ks * 32 + fq * 8);
        bf16x8 av[C::DT];
#pragma unroll
        for (int dt = 0; dt < C::DT; ++dt) {
            const u32x2 v0 = *(const u32x2*)(Vt + (dt * 16 + fr) * C::VSTR + kc * 32 + fq * 4), v1 = *(const u32x2*)(Vt + (dt * 16 + fr) * C::VSTR + kc * 32 + 16 + fq * 4);
            u32x4 vv; vv.x = v0.x; vv.y = v0.y; vv.z = v1.x; vv.w = v1.y; av[dt] = __builtin_bit_cast(bf16x8, vv);
        }
#pragma unroll
        for (int qt = 0; qt < C::QT; ++qt) {
            const int r0 = wrow0 + qt * 16;
            if (WIN && !(kc * 32 + 31 >= r0 && kc * 32 <= r0 + 271)) continue;
            f32x4 s0 = (f32x4){0.f, 0.f, 0.f, 0.f}, s1 = s0;
#pragma unroll
            for (int ks = 0; ks < C::KS; ++ks) { s0 = __builtin_amdgcn_mfma_f32_16x16x32_bf16(ak[0][ks], bq[qt][ks], s0, 0, 0, 0); s1 = __builtin_amdgcn_mfma_f32_16x16x32_bf16(ak[1][ks], bq[qt][ks], s1, 0, 0, 0); }
            float sv[8];
            const bool interior = WIN && (kc * 32 >= r0 + 15) && (kc * 32 + 31 - r0 <= 256) && (blk * 128 - 128 + kc * 32 >= 0) && (blk * 128 - 128 + kc * 32 + 31 < SEQL);
            if (interior) {
                const float* bt = biasT + g * 257 + fq * 4 - fr + (kc * 32 - r0);
#pragma unroll
                for (int e = 0; e < 8; ++e) sv[e] = __builtin_fmaf(e < 4 ? s0[e & 3] : s1[e & 3], scale, bt[(e >> 2) * 16 + (e & 3)]);
            } else
#pragma unroll
            for (int e = 0; e < 8; ++e) {
                const float raw = (e < 4 ? s0[e & 3] : s1[e & 3]) * scale;
                if (WIN) {
                    const int jk = kc * 32 + (e >> 2) * 16 + fq * 4 + (e & 3), qi = r0 + fr, rel = jk - qi, pos = blk * 128 - 128 + jk;
                    const bool ok = (rel >= 0) && (rel <= 256) && (pos >= 0) && (pos < SEQL);
                    const int ri = rel < 0 ? 0 : (rel > 256 ? 256 : rel);
                    sv[e] = ok ? raw + biasT[g * 257 + ri] : -1e30f;
                } else sv[e] = raw;
            }
            float cm = fmaxf(fmaxf(fmaxf(sv[0], sv[1]), fmaxf(sv[2], sv[3])), fmaxf(fmaxf(sv[4], sv[5]), fmaxf(sv[6], sv[7])));
            cm = fmaxf(cm, __shfl_xor(cm, 16)); cm = fmaxf(cm, __shfl_xor(cm, 32));
            const float mn = fmaxf(m[qt], cm), al = __builtin_amdgcn_exp2f(m[qt] - mn);
            m[qt] = mn;
            float ps = 0.f; float pe[8];
#pragma unroll
            for (int e = 0; e < 8; ++e) { pe[e] = __builtin_amdgcn_exp2f(sv[e] - mn); ps += pe[e]; }
            ls[qt] = ls[qt] * al + ps;
            u32x4 pw; pw.x = pk2(pe[0], pe[1]); pw.y = pk2(pe[2], pe[3]); pw.z = pk2(pe[4], pe[5]); pw.w = pk2(pe[6], pe[7]);
            const bf16x8 pf = __builtin_bit_cast(bf16x8, pw);
#pragma unroll
            for (int dt = 0; dt < C::DT; ++dt) { o[qt][dt] = o[qt][dt] * al; o[qt][dt] = __builtin_amdgcn_mfma_f32_16x16x32_bf16(av[dt], pf, o[qt][dt], 0, 0, 0); }
        }
    }
#pragma unroll
    for (int qt = 0; qt < C::QT; ++qt) {
        float lt = ls[qt]; lt += __shfl_xor(lt, 16); lt += __shfl_xor(lt, 32);
        const float inv = 1.f / lt;
#pragma unroll
        for (int dt = 0; dt < C::DT; ++dt) {
            const f32x4 v = o[qt][dt] * inv;
            u32x2 ov; ov.x = pk2(v.x, v.y); ov.y = pk2(v.z, v.w);
            *(u32x2*)(qbase + (tok0 + wrow0 + qt * 16 + fr) * ldq + qcol0 + dt * 16 + fq * 4) = ov;
        }
    }
}
constexpr int ATT_LDS_WIN = AttnCfg<true>::K_BYTES + AttnCfg<true>::V_BYTES + 4 * 257 * 4;
constexpr int ATT_LDS_MEM = AttnCfg<false>::K_BYTES + AttnCfg<false>::V_BYTES;

constexpr int FBUF_BYTES = FBUF_F2 * 8;
constexpr int HY_LDS = FBUF_BYTES + 1024 + 288 * 8;
typedef _Float16 h2_t __attribute__((ext_vector_type(2)));
DV HPair unpackH(u32x2 v) {
    const h2_t a = __builtin_bit_cast(h2_t, v.x), b = __builtin_bit_cast(h2_t, v.y);
    const float sc = 1.f / (float)FN;
    HPair h; h.hk = make_float2((float)a.x * sc, (float)a.y * sc); h.hl = make_float2((float)b.x * sc, (float)b.y * sc); return h;
}
DV int opaque(int v) { asm volatile("" : "+v"(v)); return v; }
typedef HYV hyv_t;
template <class V> DV void fft_fwd_123(V* buf, int tid, const float2* tw) {
#pragma unroll 1
    for (int ps = 1; ps < 4; ++ps) { fft_pass<false, V>(buf, ps, opaque(tid), tw); __syncthreads(); }
}
template <class V> DV void fft_inv_012(V* buf, int tid, const float2* tw) {
#pragma unroll 1
    for (int ps = 0; ps < 3; ++ps) { fft_pass<true, V>(buf, ps, opaque(tid), tw); __syncthreads(); }
}
DV void fft_fwd_all(v2f* buf, int tid, const float2* tw) {
#pragma unroll 1
    for (int ps = 0; ps < 4; ++ps) { fft_pass<false, v2f>(buf, ps, opaque(tid), tw); __syncthreads(); }
}
DV void hyena_item(KParams p, int l, int c, unsigned char* smem) {
    const int tid = tid_(), lane = tid & 63, w = wave_();
    v2f* buf = (v2f*)smem; float* fbuf = (float*)smem;
    hyv_t* dbuf = (hyv_t*)smem;
    float* wo = (float*)(smem + FBUF_BYTES); float* red = wo + 128;
    const bf16_t* filt = (const bf16_t*)(p->ws + WS_FILT);
    const float2* tw = (const float2*)(p->ws + WS_TW);
    float2* t12 = (float2*)(smem + FBUF_BYTES + 1024);
    if (tid < 256) t12[tid] = tw[tid]; else if (tid < 288) t12[tid] = tw[(tid - 256) * 256];
    const float min_decay = -3.0701134573253945f, max_decay = -15.350567286626972f;
    const float delta = fabsf(min_decay + (float)c * ((max_decay - min_decay) / 511.f));
#ifdef PROBE_PHASE
#define HSTAMP(i) { __syncthreads(); if (blockIdx.x == 0 && threadIdx.x == 0) __hip_atomic_store((unsigned long long*)(p->ws + WS_TS) + (i), (unsigned long long)__builtin_amdgcn_s_memrealtime(), __ATOMIC_RELAXED, __HIP_MEMORY_SCOPE_AGENT); }
#else
#define HSTAMP(i)
#endif
    HSTAMP(24)
    f32x4* Hs = (f32x4*)(p->ws + WS_HSCR) + (size_t)blockIdx.x * 2 * 8192;
    __syncthreads();
#pragma unroll 1
    for (int o = 0; o < 2; ++o) {
        const bf16_t* ff = filt + (size_t)(o * 1024 + c) * SEQL; const bf16_t* fb = ff + (size_t)512 * SEQL;
        float asum = 0.f;
        u32x4 fva[4], bva[4];
#pragma unroll
        for (int i = 0; i < 4; ++i) { const int pos0 = 8 * (tid + NTH * i); fva[i] = ldg16(ff + pos0); bva[i] = ldg16(fb + pos0); }
#pragma unroll
        for (int i = 0; i < 4; ++i) {
            const int pos0 = 8 * (opaque(tid) + NTH * i);
            const u32x4 fv = fva[i], bv = bva[i];
            const float fw[8] = {bflo(fv.x), bfhi(fv.x), bflo(fv.y), bfhi(fv.y), bflo(fv.z), bfhi(fv.z), bflo(fv.w), bfhi(fv.w)};
            const float bw[8] = {bflo(bv.x), bfhi(bv.x), bflo(bv.y), bfhi(bv.y), bflo(bv.z), bfhi(bv.z), bflo(bv.w), bfhi(bv.w)};
#pragma unroll
            for (int e = 0; e < 8; ++e) {
                const int pos = pos0 + e;
                const float dec = __expf(-((float)pos * (1.f / (float)(SEQL - 1))) * delta);
                const float f = fw[e] * dec, b = bw[e] * dec;
                if (pos == 0) { const float v = f + b; fbuf[fidx(0)] = v; asum += fabsf(v); }
                else { fbuf[fidx(pos)] = f; fbuf[fidx(2 * SEQL - pos)] = b; asum += fabsf(f) + fabsf(b); }
            }
        }
        if (tid == 0) fbuf[fidx(SEQL)] = 0.f;
        asum = wave_sum(asum);
        if (lane == 0) red[w] = asum;
        __syncthreads();
        float norm = 0.f;
#pragma unroll
        for (int i = 0; i < 8; ++i) norm += red[i];
        fft_fwd_all(buf, tid, tw);
        const float sc = HY_YS / (norm * (float)FN);
#pragma unroll 2
        for (int i = 0; i < 16; ++i) { const HPair hp = pair_filter(buf, opaque(tid) + NTH * i, sc, t12);
            Hs[o * 8192 + tid + NTH * i] = (f32x4){hp.hk.x, hp.hk.y, hp.hl.x, hp.hl.y}; }
        __syncthreads();
    }
    const float bias0 = p->in[15][(size_t)l * 2 * HYW + c], bias1 = p->in[15][(size_t)l * 2 * HYW + HYW + c];
    bf16_t* uct = (bf16_t*)((unsigned char*)p->out + DO_UCT);
    unsigned pa[2][8];
#pragma unroll
    for (int i = 0; i < 2; ++i) hy_load8(uct + (size_t)c * SEQL, (unsigned)(tid + NTH * i), pa[i]);
#pragma unroll 1
    for (int s = 0; s < NSEQ; ++s) {
        bf16_t* p0 = uct + ((size_t)s * HY3 + c) * SEQL; const bf16_t* p1 = p0 + (size_t)HYW * SEQL; const bf16_t* p2 = p0 + (size_t)2 * HYW * SEQL;
        v2f z1[2][8];
#pragma unroll
        for (int i = 0; i < 2; ++i) hy_step_a(dbuf, (unsigned)(opaque(tid) + NTH * i), pa[i], tw);
        __syncthreads();
        { unsigned pb[2][8];
          fft_fwd_123(dbuf, tid, tw);
#pragma unroll 4
          for (int i = 0; i < 16; ++i) { const f32x4 hv = Hs[0 * 8192 + tid + NTH * i]; HPair hp; hp.hk = make_float2(hv.x, hv.y); hp.hl = make_float2(hv.z, hv.w);
              pair_apply(dbuf, opaque(tid) + NTH * i, hp, t12); }
          __syncthreads();
#pragma unroll
          for (int i = 0; i < 2; ++i) hy_load8(p1, (unsigned)(tid + NTH * i), pb[i]);
          fft_inv_012(dbuf, tid, tw);
#pragma unroll
          for (int i = 0; i < 2; ++i) hy_step_b(dbuf, (unsigned)(opaque(tid) + NTH * i), pa[i], pb[i], bias0, 1.f / HY_YS, z1[i], tw); }
        __syncthreads();
        { unsigned pc[2][8];
          fft_fwd_123(dbuf, tid, tw);
#pragma unroll 4
          for (int i = 0; i < 16; ++i) { const f32x4 hv = Hs[1 * 8192 + tid + NTH * i]; HPair hp; hp.hk = make_float2(hv.x, hv.y); hp.hl = make_float2(hv.z, hv.w);
              pair_apply(dbuf, opaque(tid) + NTH * i, hp, t12); }
          __syncthreads();
#pragma unroll
          for (int i = 0; i < 2; ++i) hy_load8(p2, (unsigned)(tid + NTH * i), pc[i]);
          if (s + 1 < NSEQ) {
#pragma unroll
              for (int i = 0; i < 2; ++i) hy_load8(p0 + (size_t)HY3 * SEQL, (unsigned)(tid + NTH * i), pa[i]); }
          fft_inv_012(dbuf, tid, tw);
#pragma unroll
          for (int i = 0; i < 2; ++i) hy_step_c(dbuf, (unsigned)(opaque(tid) + NTH * i), pc[i], z1[i], bias1, 1.f / HY_YS, p0, tw); }
        __syncthreads();
    }
}
__device__ static const signed char CI_TAB[52] = {0,0,0,0,0,0,0,0,0,0,0,0,0,0,0,0,1,1,1,1,1,1,1,1,2,2,2,2,2,3,3,3,3,4,4,4,5,5,6,6,7,7,8,9,10,11,12,13,14,15,15,15};
__device__ static const signed char CJ_TAB[52] = {0,1,2,3,4,5,6,7,8,9,10,11,12,13,14,15,0,1,2,3,4,5,6,7,0,1,2,3,4,0,1,2,3,0,1,2,0,1,0,1,0,1,0,0,0,0,0,0,0,0,15,15};
constexpr int CI_C[52] = {0,0,0,0,0,0,0,0,0,0,0,0,0,0,0,0,1,1,1,1,1,1,1,1,2,2,2,2,2,3,3,3,3,4,4,4,5,5,6,6,7,7,8,9,10,11,12,13,14,15,15,15};
constexpr int CJ_C[52] = {0,1,2,3,4,5,6,7,8,9,10,11,12,13,14,15,0,1,2,3,4,5,6,7,0,1,2,3,4,0,1,2,3,0,1,2,0,1,0,1,0,1,0,0,0,0,0,0,0,0,15,15};
DV unsigned f2ord(float f) { const unsigned u = __builtin_bit_cast(unsigned, f); return (u >> 31) ? ~u : (u | 0x80000000u); }
DV float ord2f(unsigned k) { const unsigned u = (k >> 31) ? (k & 0x7fffffffu) : ~k; return __builtin_bit_cast(float, u); }
DV unsigned umax3(unsigned a, unsigned b, unsigned c) { return max(max(a, b), c); }
constexpr int SK_STR = 136, SK_LDS = 2 * 128 * SK_STR * 2;
DV void peer_stage_sk(KParams p, int l, int h, bf16_t* sks) {
    const bf16_t* sk = (const bf16_t*)(p->ws + WS_W + l * SZ_WL + OFF_SK) + (size_t)h * 2 * 128 * 128;
    __syncthreads();
#pragma unroll
    for (int i = 0; i < 8; ++i) { const int idx = tid_() + i * NTH, row = idx >> 4, ch = idx & 15; *(u32x4*)(sks + row * SK_STR + ch * 8) = ldg16(sk + (size_t)row * 128 + ch * 8); }
    __syncthreads();
}
DV void peer_topk_loadq(KParams p, int tile, int h, bf16x8 (&bqa)[2][4]) {
    const int lane = tid_() & 63, w = wave_(), fr = lane & 15, fq = lane >> 4;
    const bf16_t* qp = (const bf16_t*)p->out + ((size_t)tile * 128 + w * 16 + fr) * 2048 + h * 256 + fq * 8;
#pragma unroll
    for (int c = 0; c < 2; ++c)
#pragma unroll
        for (int ks = 0; ks < 4; ++ks) bqa[c][ks] = *(const bf16x8*)(qp + c * 128 + ks * 32);
}
DV void merge16_xor(unsigned (&k)[16], int m) {
    unsigned o[16];
#pragma unroll
    for (int i = 0; i < 16; ++i) o[i] = (unsigned)__shfl_xor((int)k[15 - i], m);
#pragma unroll
    for (int i = 0; i < 16; ++i) k[i] = max(k[i], o[i]);
    bitonic_merge_desc<16>(k);
}
DV void peer_topk_item(KParams p, int l, int tile, int h, bf16_t* sks, const bf16x8 (&bqa)[2][4]) {
    const int lane = tid_() & 63, w = wave_(), fr = lane & 15, fq = lane >> 4;
    const size_t t0 = (size_t)tile * 128 + w * 16;
    unsigned tk[2][16];
#pragma unroll
    for (int c = 0; c < 2; ++c) {
        bf16x8 bq[4];
#pragma unroll
        for (int ks = 0; ks < 4; ++ks) bq[ks] = bqa[c][ks];
        unsigned key[32];
        const bf16_t* skc = sks + c * 128 * SK_STR;
#pragma unroll
        for (int kt = 0; kt < 8; ++kt) {
            f32x4 s = (f32x4){0.f, 0.f, 0.f, 0.f};
#pragma unroll
            for (int ks = 0; ks < 4; ++ks) { const bf16x8 a = *(const bf16x8*)(skc + (kt * 16 + fr) * SK_STR + ks * 32 + fq * 8); s = __builtin_amdgcn_mfma_f32_16x16x32_bf16(a, bq[ks], s, 0, 0, 0); }
#pragma unroll
            for (int j = 0; j < 4; ++j) { const int kidx = kt * 16 + fq * 4 + j; key[kt * 4 + j] = (f2ord(s[j]) & 0xffffff80u) | (unsigned)(127 - kidx); }
        }
        unsigned k16[16];
        { unsigned kb[16];
#pragma unroll
          for (int r = 0; r < 16; ++r) { k16[r] = key[r]; kb[r] = key[16 + r]; }
          bitonic_sort_desc<16>(k16); bitonic_sort_desc<16>(kb);
#pragma unroll
          for (int r = 0; r < 16; ++r) k16[r] = max(k16[r], kb[15 - r]);
          bitonic_merge_desc<16>(k16); }
        merge16_xor(k16, 16); merge16_xor(k16, 32);
#pragma unroll
        for (int r = 0; r < 16; ++r) tk[c][r] = k16[r];
    }
    float v0[16], v1[16];
#pragma unroll
    for (int r = 0; r < 16; ++r) { v0[r] = ord2f(tk[0][r] & 0xffffff80u); v1[r] = ord2f(tk[1][r] & 0xffffff80u); }
    unsigned ck[13]; int ce[13];
#pragma unroll
    for (int s = 0; s < 13; ++s) {
        float sum[4]; int ee[4];
#pragma unroll
        for (int q = 0; q < 4; ++q) { const int i = CI_C[q + 4 * s], j = CJ_C[q + 4 * s]; sum[q] = v0[i] + v1[j];
            ee[q] = (127 - (int)(tk[0][i] & 127u)) * 128 + (127 - (int)(tk[1][j] & 127u)); }
        const float sm = fq == 0 ? sum[0] : (fq == 1 ? sum[1] : (fq == 2 ? sum[2] : sum[3]));
        ce[s] = fq == 0 ? ee[0] : (fq == 1 ? ee[1] : (fq == 2 ? ee[2] : ee[3]));
        ck[s] = (f2ord(sm) & 0xffffffc0u) | (unsigned)(63 - (4 * s)) ;
        ck[s] -= (unsigned)fq;
    }
    int* celds = (int*)(sks + 2 * 128 * SK_STR) + (w * 16 + fr) * 52;
#pragma unroll
    for (int s = 0; s < 13; ++s) celds[fq + 4 * s] = ce[s];
    float myv[4]; int myc[4]; float w0;
    { unsigned c16[16];
#pragma unroll
      for (int i = 0; i < 16; ++i) c16[i] = i < 13 ? ck[i] : 0u;
      bitonic_sort_desc<16>(c16);
      merge16_xor(c16, 16); merge16_xor(c16, 32);
      w0 = ord2f(c16[0] & 0xffffffc0u);
#pragma unroll
      for (int i = 0; i < 4; ++i) { const unsigned mk = fq == 0 ? c16[i] : (fq == 1 ? c16[4 + i] : (fq == 2 ? c16[8 + i] : c16[12 + i]));
          myv[i] = ord2f(mk & 0xffffffc0u); myc[i] = 63 - (int)(mk & 63u); } }
    int mye[4];
#pragma unroll
    for (int i = 0; i < 4; ++i) mye[i] = celds[myc[i]];
    float ex[4], ps = 0.f;
#pragma unroll
    for (int i = 0; i < 4; ++i) { ex[i] = __expf(myv[i] - w0); ps += ex[i]; }
    ps += __shfl_xor(ps, 16); ps += __shfl_xor(ps, 32);
    const float inv = 1.f / ps;
    unsigned short* eidx = (unsigned short*)(p->ws + WS_EIDX) + (t0 + fr) * 128 + 16 * h + 4 * fq; float* gate = (float*)(p->ws + WS_GATE) + (t0 + fr) * 128 + 16 * h + 4 * fq;
    *(uint2*)eidx = make_uint2((unsigned)mye[0] | ((unsigned)mye[1] << 16), (unsigned)mye[2] | ((unsigned)mye[3] << 16));
    *(f32x4*)gate = (f32x4){ex[0] * inv, ex[1] * inv, ex[2] * inv, ex[3] * inv};
}

typedef float f32x2 __attribute__((ext_vector_type(2)));
DV float gelu_exact(float x) { return 0.5f * x * (1.f + erff(x * 0.7071067811865476f)); }
constexpr size_t SLICE_BYTES = (size_t)NEXP * 128;
DV int peer_q0(int s) { return ((s >> 2) & 1) * 8 + ((s >> 1) & 1) * 4 + (s & 1) * 2; }
struct PeerUIn { u32x4 e; };
constexpr int NSL = 4;
typedef int i32x8 __attribute__((ext_vector_type(8)));
DV PeerUIn peer_u_in(KParams p, size_t t, int lane) {
    PeerUIn r; r.e = ldg16((const unsigned short*)(p->ws + WS_EIDX) + t * 128 + (lane >> 2) * 8); return r;
}
DV unsigned peer_e8(const u32x4& a, int g) { const unsigned w = g < 2 ? a.x : g < 4 ? a.y : g < 6 ? a.z : a.w; return (g & 1) ? (w >> 16) : (w & 0xffffu); }
DV void peer_u_gather(KParams p, const unsigned char* U4, const PeerUIn& in, int sl, size_t t, int lane, u32x4 (&r)[16], u32x4 (&x)[2]) {
#pragma unroll
    for (int g = 0; g < 8; ++g) { const unsigned char* row = U4 + (size_t)peer_e8(in.e, g) * 128; r[2 * g] = ldg16(row); r[2 * g + 1] = ldg16(row + 64); }
    const unsigned char* xh = p->ws + WS_X8 + t * D + 256 * sl + (lane & 3) * 32 + ((lane >> 4) & 1) * 16;
    x[0] = ldg16(xh); x[1] = ldg16(xh + 128);
}
DV i32x8 cat8(const u32x4& a, const u32x4& b) { return (i32x8){(int)a.x, (int)a.y, (int)a.z, (int)a.w, (int)b.x, (int)b.y, (int)b.z, (int)b.w}; }
DV float quad_sum(float v) {
    v += __builtin_bit_cast(float, __builtin_amdgcn_update_dpp(0, __builtin_bit_cast(int, v), 0xB1, 0xf, 0xf, true));
    v += __builtin_bit_cast(float, __builtin_amdgcn_update_dpp(0, __builtin_bit_cast(int, v), 0x4E, 0xf, 0xf, true));
    return v;
}
DV void peer_u_finish(KParams p, int sl, size_t t, int lane, const u32x4 (&r)[16], const u32x4 (&x)[2]) {
    const bool k0 = ((lane >> 2) & 3) == (lane >> 5), k1 = ((lane >> 2) & 3) == 2 + (lane >> 5);
    const u32x4 z4 = (u32x4){0u, 0u, 0u, 0u};
    const i32x8 x0 = cat8(k0 ? x[0] : z4, k1 ? x[0] : z4), x1 = cat8(k0 ? x[1] : z4, k1 ? x[1] : z4);
    const int c = lane & 3; const bool c0 = (c & 1) != 0, c1 = (c & 2) != 0;
    float h[8];
#pragma unroll
    for (int g = 0; g < 8; ++g) {
        f32x4 acc = __builtin_amdgcn_mfma_scale_f32_16x16x128_f8f6f4(cat8(r[2 * g], z4), x0, (f32x4){0.f, 0.f, 0.f, 0.f}, 4, 0, 0, 0, 0, 0);
        acc = __builtin_amdgcn_mfma_scale_f32_16x16x128_f8f6f4(cat8(r[2 * g + 1], z4), x1, acc, 4, 0, 0, 0, 0, 0);
        const float d0 = c0 ? acc[1] : acc[0], d1 = c0 ? acc[3] : acc[2];
        h[g] = quad_sum(c1 ? d1 : d0); }
    const int e = (lane >> 4) + 4 * ((lane >> 2) & 3);
    if (c == 0) {
        bf16_t* part = (bf16_t*)((unsigned*)p->out + ((size_t)sl * T + t) * 64) + e * 8;
        stg16(part, (u32x4){pk2(h[0], h[1]), pk2(h[2], h[3]), pk2(h[4], h[5]), pk2(h[6], h[7])}); }
}
DV void peer_u_phase(KParams p, int l, int bid, int nblk) {
    const int wv = wave_(), lane = tid_() & 63, j = bid & 7, sl = j & 3, half = j >> 2, b8 = bid >> 3, nb8 = nblk >> 3;
    const unsigned char* U4 = p->ws + WS_EXP + (size_t)(2 * l) * SZ_EXP1 + (size_t)sl * SLICE_BYTES + (lane & 3) * 16;
    const size_t step = (size_t)nb8 * 16; size_t t = (size_t)(b8 * 8 + wv) * 2 + half;
    if (t >= (size_t)T) return;
    const size_t t0 = t;
    size_t ta = t, tb = t + step;
    u32x4 ra[16], rb[16], xa[2], xb[2];
    { const PeerUIn a = peer_u_in(p, ta, lane), b = peer_u_in(p, tb < (size_t)T ? tb : t0, lane);
      peer_u_gather(p, U4, a, sl, ta, lane, ra, xa); peer_u_gather(p, U4, b, sl, tb < (size_t)T ? tb : t0, lane, rb, xb); }
    PeerUIn na = peer_u_in(p, ta + 2 * step < (size_t)T ? ta + 2 * step : t0, lane), nb = peer_u_in(p, tb + 2 * step < (size_t)T ? tb + 2 * step : t0, lane);
#pragma unroll 1
    while (ta < (size_t)T) {
        peer_u_finish(p, sl, ta, lane, ra, xa);
        ta += 2 * step;
        peer_u_gather(p, U4, na, sl, ta < (size_t)T ? ta : t0, lane, ra, xa);
        na = peer_u_in(p, ta + 2 * step < (size_t)T ? ta + 2 * step : t0, lane);
        if (tb < (size_t)T) peer_u_finish(p, sl, tb, lane, rb, xb);
        tb += 2 * step;
        peer_u_gather(p, U4, nb, sl, tb < (size_t)T ? tb : t0, lane, rb, xb);
        nb = peer_u_in(p, tb + 2 * step < (size_t)T ? tb + 2 * step : t0, lane);
    }
}
DV unsigned peer_e16(const u32x4& a, const u32x4& b, int q) {
    const unsigned w = q < 2 ? a.x : q < 4 ? a.y : q < 6 ? a.z : q < 8 ? a.w : q < 10 ? b.x : q < 12 ? b.y : q < 14 ? b.z : b.w;
    return (q & 1) ? (w >> 16) : (w & 0xffffu);
}
typedef _Float16 h16x2 __attribute__((ext_vector_type(2)));
DV h16x2 fp8h(unsigned w, bool hi) { return hi ? __builtin_amdgcn_cvt_scalef32_pk_f16_fp8(w, 1.0f, true) : __builtin_amdgcn_cvt_scalef32_pk_f16_fp8(w, 1.0f, false); }
constexpr size_t DO_COEF = (size_t)T * D * 2;
constexpr size_t DO_CSC = DO_COEF + (size_t)NSL * T * 128;
DV void peer_c_phase(KParams p, int l, int bid, int nblk) {
    const int wv = wave_(), lane = tid_() & 63, g = lane >> 3, s = lane & 7;
    const unsigned char* tabu = p->ws + WS_EXP + (size_t)(2 * l) * SZ_EXP1; const unsigned char* tabv = tabu + SZ_EXP1;
    const unsigned char* sc16 = tabu + NSL * SLICE_BYTES;
    const int o2 = g * 16 + peer_q0(s);
    const size_t step = (size_t)nblk * 8;
#pragma unroll 1
    for (size_t t0 = (size_t)bid * 8 + wv; t0 < (size_t)T; t0 += 4 * step) {
        unsigned pw[4][NSL]; unsigned ew[4]; f32x2 gt[4];
#pragma unroll
        for (int k = 0; k < 4; ++k) { const size_t t = t0 + k * step < (size_t)T ? t0 + k * step : t0;
            const unsigned* part = (const unsigned*)p->out + t * 64 + lane;
#pragma unroll
            for (int q = 0; q < NSL; ++q) pw[k][q] = part[(size_t)q * T * 64];
            ew[k] = *(const unsigned*)((const unsigned short*)(p->ws + WS_EIDX) + t * 128 + o2);
            gt[k] = *(const f32x2*)((const float*)(p->ws + WS_GATE) + t * 128 + o2); }
#pragma unroll
        for (int k = 0; k < 4; ++k) { const size_t t = t0 + k * step;
            const int e0 = (int)(ew[k] & 0xffffu), e1 = (int)(ew[k] >> 16);
            const f32x4 su0 = *(const f32x4*)(sc16 + (size_t)e0 * 32), sv0 = *(const f32x4*)(sc16 + (size_t)e0 * 32 + 16);
            const f32x4 su1 = *(const f32x4*)(sc16 + (size_t)e1 * 32), sv1 = *(const f32x4*)(sc16 + (size_t)e1 * 32 + 16);
            float a0 = 0.f, a1 = 0.f;
#pragma unroll
            for (int q = 0; q < NSL; ++q) { a0 += bflo(pw[k][q]) * su0[q]; a1 += bfhi(pw[k][q]) * su1[q]; }
            float v0[NSL] = {sv0[0], sv0[1], sv0[2], sv0[3]}, v1[NSL] = {sv1[0], sv1[1], sv1[2], sv1[3]};
            const float c0 = gt[k].x * gelu_exact(a0), c1 = gt[k].y * gelu_exact(a1);
            float mx = 0.f;
#pragma unroll
            for (int q = 0; q < NSL; ++q) { v0[q] *= c0; v1[q] *= c1; mx = fmaxf(mx, fmaxf(fabsf(v0[q]), fabsf(v1[q]))); }
            mx = wave_max(mx);
            const float S = mx > 0.f ? 128.f / mx : 0.f;
            if (t < (size_t)T) {
#pragma unroll
                for (int q = 0; q < NSL; ++q) *(unsigned short*)((unsigned char*)p->out + DO_COEF + ((size_t)q * T + t) * 128 + o2) = (unsigned short)__builtin_amdgcn_cvt_pk_fp8_f32(v0[q] * S, v1[q] * S, 0, false);
                if (lane == 0) ((float*)((unsigned char*)p->out + DO_CSC))[t] = mx * (1.f / 128.f); } }
    }
}
struct PeerVIn { u32x4 e0, e1; };
DV PeerVIn peer_v_in(KParams p, size_t t, int lane) {
    PeerVIn r; const unsigned short* eidx = (const unsigned short*)(p->ws + WS_EIDX) + t * 128 + (lane >> 3) * 16;
    r.e0 = ldg16(eidx); r.e1 = ldg16(eidx + 8); return r;
}
struct PeerVCo { u32x2 ca, cb; float isc; };
DV void peer_v_gather(KParams p, const unsigned char* V4, const unsigned char* coef, const PeerVIn& in, size_t t, u32x4 (&r)[16], PeerVCo& c) {
#pragma unroll
    for (int q = 0; q < 16; ++q) r[q] = ldg16(V4 + (size_t)peer_e16(in.e0, in.e1, q) * 128);
    c.ca = *(const u32x2*)(coef + t * 128); c.cb = *(const u32x2*)(coef + t * 128 + 64);
    c.isc = ((const float*)((const unsigned char*)p->out + DO_CSC))[t];
}
DV float add_ror8(float a, float b) { return a + __builtin_bit_cast(float, __builtin_amdgcn_update_dpp(0, __builtin_bit_cast(int, b), 0x128, 0xf, 0xf, true)); }
DV void peer_v_finish(KParams p, int sl, size_t t, int lane, const PeerVCo& co, const u32x4 (&r)[16]) {
    const int m = lane & 15; const bool z = (m & 2) != 0, live = m < 4;
    const unsigned s0 = z ? 0x010c000cu : 0x0c010c00u, s1 = z ? 0x030c020cu : 0x0c030c02u;
    const unsigned cax = live ? co.ca.x : 0u, cay = live ? co.ca.y : 0u, cbx = live ? co.cb.x : 0u, cby = live ? co.cb.y : 0u;
    const i32x8 A = (i32x8){(int)__builtin_amdgcn_perm(0u, cax, s0), (int)__builtin_amdgcn_perm(0u, cax, s1), (int)__builtin_amdgcn_perm(0u, cay, s0), (int)__builtin_amdgcn_perm(0u, cay, s1),
                            (int)__builtin_amdgcn_perm(0u, cbx, s0), (int)__builtin_amdgcn_perm(0u, cbx, s1), (int)__builtin_amdgcn_perm(0u, cby, s0), (int)__builtin_amdgcn_perm(0u, cby, s1)};
    float y[32];
#pragma unroll
    for (int w = 0; w < 4; ++w) {
        unsigned Tt[4][4];
#pragma unroll
        for (int u = 0; u < 4; ++u) {
            const unsigned a0 = r[4 * u][w], a1 = r[4 * u + 1][w], a2 = r[4 * u + 2][w], a3 = r[4 * u + 3][w];
            const unsigned p0 = __builtin_amdgcn_perm(a1, a0, 0x05010400u), p1 = __builtin_amdgcn_perm(a1, a0, 0x07030602u);
            const unsigned p2 = __builtin_amdgcn_perm(a3, a2, 0x05010400u), p3 = __builtin_amdgcn_perm(a3, a2, 0x07030602u);
            Tt[0][u] = __builtin_amdgcn_perm(p2, p0, 0x05040100u); Tt[1][u] = __builtin_amdgcn_perm(p2, p0, 0x07060302u);
            Tt[2][u] = __builtin_amdgcn_perm(p3, p1, 0x05040100u); Tt[3][u] = __builtin_amdgcn_perm(p3, p1, 0x07060302u);
        }
#pragma unroll
        for (int bq = 0; bq < 4; ++bq) {
            const i32x8 B = (i32x8){(int)Tt[bq][0], (int)Tt[bq][1], (int)Tt[bq][2], (int)Tt[bq][3], 0, 0, 0, 0};
            const f32x4 acc = __builtin_amdgcn_mfma_scale_f32_16x16x128_f8f6f4(A, B, (f32x4){0.f, 0.f, 0.f, 0.f}, 0, 4, 0, 0, 0, 0);
            const int j = 4 * w + bq;
            y[2 * j] = add_ror8(acc[0], acc[1]); y[2 * j + 1] = add_ror8(acc[2], acc[3]);
        }
    }
    if (lane < 8) {
        const size_t off = t * D + 256 * sl + lane * 32;
        const bf16_t* xr = (const bf16_t*)(p->ws + WS_XB) + off; bf16_t* yo = (bf16_t*)(p->ws + WS_HY) + off;
        const float isc = co.isc;
#pragma unroll
        for (int i = 0; i < 4; ++i) { const u32x4 xw = ldg16(xr + 8 * i); u32x4 o;
            o.x = pk2(ALPHA * bflo(xw.x) + y[8 * i + 0] * isc, ALPHA * bfhi(xw.x) + y[8 * i + 1] * isc); o.y = pk2(ALPHA * bflo(xw.y) + y[8 * i + 2] * isc, ALPHA * bfhi(xw.y) + y[8 * i + 3] * isc);
            o.z = pk2(ALPHA * bflo(xw.z) + y[8 * i + 4] * isc, ALPHA * bfhi(xw.z) + y[8 * i + 5] * isc); o.w = pk2(ALPHA * bflo(xw.w) + y[8 * i + 6] * isc, ALPHA * bfhi(xw.w) + y[8 * i + 7] * isc);
            stg16(yo + 8 * i, o); }
    }
}
DV void peer_v_phase(KParams p, int l, int bid, int nblk) {
    const int wv = wave_(), lane = tid_() & 63, lab = bid & 7, sl = lab & 3, half = lab >> 2, b8 = bid >> 3, nb8 = nblk >> 3, s = lane & 7;
    const unsigned char* V4 = p->ws + WS_EXP + (size_t)(2 * l + 1) * SZ_EXP1 + (size_t)sl * SLICE_BYTES + s * 16;
    const unsigned char* coef = (const unsigned char*)p->out + DO_COEF + (size_t)sl * T * 128 + (2 * (lane >> 5) + (lane & 1)) * 16 + ((lane >> 4) & 1) * 8;
    const size_t step = (size_t)nb8 * 16; size_t t = ((size_t)b8 * 8 + wv) * 2 + half;
    if (t >= (size_t)T) return;
    const size_t t0 = t;
    size_t ta = t, tb = t + step;
    u32x4 ra[16], rb[16]; PeerVCo ca, cb;
    { const PeerVIn a = peer_v_in(p, ta, lane), b = peer_v_in(p, tb < (size_t)T ? tb : t0, lane);
      peer_v_gather(p, V4, coef, a, ta, ra, ca); peer_v_gather(p, V4, coef, b, tb < (size_t)T ? tb : t0, rb, cb); }
    PeerVIn na = peer_v_in(p, ta + 2 * step < (size_t)T ? ta + 2 * step : t0, lane), nb = peer_v_in(p, tb + 2 * step < (size_t)T ? tb + 2 * step : t0, lane);
#pragma unroll 1
    while (ta < (size_t)T) {
        peer_v_finish(p, sl, ta, lane, ca, ra);
        ta += 2 * step;
        peer_v_gather(p, V4, coef, na, ta < (size_t)T ? ta : t0, ra, ca);
        na = peer_v_in(p, ta + 2 * step < (size_t)T ? ta + 2 * step : t0, lane);
        if (tb < (size_t)T) peer_v_finish(p, sl, tb, lane, cb, rb);
        tb += 2 * step;
        peer_v_gather(p, V4, coef, nb, tb < (size_t)T ? tb : t0, rb, cb);
        nb = peer_v_in(p, tb + 2 * step < (size_t)T ? tb + 2 * step : t0, lane);
    }
}
DV void ln2_job(KParams p, int l, int bid, int nblk) { ln_job(p->in[25] + (size_t)l * D, p->in[26] + (size_t)l * D, (const bf16_t*)(p->ws + WS_HY), l == DEPTH - 1 ? nullptr : (bf16_t*)(p->ws + WS_XB), p->out, bid, nblk); }


#define XB_TMO      128
#define XB_XCNT(j)  (256  + 64 * (j))
#define XB_XSUB(j)  (1280 + 64 * (j))
#define XB_XGEN(j)  (2304 + 64 * (j))
#define XB_TOP      3328
#define XB_TOPGEN   3392
#define XCD_BAR_WORDS 3456
#define XB_SPIN_CAP (1u << 18)
DV unsigned xb_ld(unsigned* p)              { return __hip_atomic_load(p, __ATOMIC_RELAXED, __HIP_MEMORY_SCOPE_AGENT); }
DV unsigned xb_add(unsigned* p, unsigned v) { return __hip_atomic_fetch_add(p, v, __ATOMIC_RELAXED, __HIP_MEMORY_SCOPE_AGENT); }
DV unsigned xb_xcc_id() { return (unsigned)__builtin_amdgcn_s_getreg((3 << 11) | 20) & 0xFu; }
#define XB_SPIN(cond, bar) do { unsigned _sp = 0; while (cond) { __builtin_amdgcn_s_sleep(1); \
    if ((++_sp & 255u) == 0u) { if (xb_ld(&(bar)[XB_TMO])) break; if (_sp > XB_SPIN_CAP) { atomicAdd(&(bar)[XB_TMO], 1u); break; } } } } while (0)
struct XcdBarrier { unsigned* bar; unsigned x; volatile LAS unsigned* st; };
DV XcdBarrier xcd_barrier_post(unsigned* bar, volatile LAS unsigned* st) {
    XcdBarrier b; b.bar = bar; b.x = xb_xcc_id(); b.st = st;
    if (threadIdx.x == 0) (void)xb_add(&bar[XB_XCNT(b.x)], 1u);
    return b;
}
DV void xcd_barrier_complete(unsigned* bar, unsigned x, unsigned& nloc, unsigned& nx) {
    const unsigned G = gridDim.x * gridDim.y * gridDim.z;
    unsigned sum, cnt, mine, sp = 0u;
    for (;;) {
        sum = 0u; cnt = 0u; mine = 0u;
#pragma unroll
        for (unsigned j = 0; j < 16; ++j) { const unsigned c = xb_ld(&bar[XB_XCNT(j)]); sum += c; cnt += (c > 0u) ? 1u : 0u; mine = (j == x) ? c : mine; }
        if (sum == G) break;
        __builtin_amdgcn_s_sleep(1);
        if ((++sp & 255u) == 0u) { if (xb_ld(&bar[XB_TMO])) break; if (sp > XB_SPIN_CAP) { atomicAdd(&bar[XB_TMO], 1u); break; } }
    }
    nloc = mine > 0u ? mine : 1u; nx = cnt > 0u ? cnt : 1u;
}
DV void xcd_barrier(const XcdBarrier& b) {
    asm volatile("s_waitcnt vmcnt(0)" ::: "memory");
    __syncthreads();
    if (threadIdx.x == 0) {
        unsigned* bar = b.bar;
        __builtin_amdgcn_s_waitcnt(0);
        unsigned nloc = b.st[0], nx = b.st[1];
        if (nloc == 0u) { xcd_barrier_complete(bar, b.x, nloc, nx); b.st[0] = nloc; b.st[1] = nx; }
        const unsigned old = xb_add(&bar[XB_XSUB(b.x)], 1u);
        const unsigned gen = old / nloc;
        if (old + 1u == (gen + 1u) * nloc) {
            __builtin_amdgcn_fence(__ATOMIC_RELEASE, "agent");
            asm volatile("s_waitcnt vmcnt(0)" ::: "memory");
            const unsigned og = xb_add(&bar[XB_TOP], 1u);
            const unsigned tg = og / nx;
            if (og + 1u == (tg + 1u) * nx) xb_add(&bar[XB_TOPGEN], 1u);
            else XB_SPIN(xb_ld(&bar[XB_TOPGEN]) == tg, bar);
            __builtin_amdgcn_fence(__ATOMIC_ACQUIRE, "agent");
            xb_add(&bar[XB_XGEN(b.x)], 1u);
            asm volatile("s_waitcnt vmcnt(0)" ::: "memory");
        } else {
            XB_SPIN(xb_ld(&bar[XB_XGEN(b.x)]) == gen, bar);
            __builtin_amdgcn_fence(__ATOMIC_ACQUIRE, "agent");
            asm volatile("s_waitcnt vmcnt(0)" ::: "memory");
        }
    }
    __syncthreads();
}
constexpr int LDS_BYTES = 139264 + 1024 + 288 * 8 + 256;
constexpr int PH_PER_LAYER = 13, NPHASE = 1 + DEPTH * PH_PER_LAYER;
DV void convert_experts(KParams p, int bid, int nblk) {
    const int lane = tid_() & 63, wv = wave_();
#pragma unroll 1
    for (int r = bid * 8 + wv; r < 4 * NEXP; r += nblk * 8) {
        const int tab = r / NEXP, e = r - tab * NEXP, l = tab >> 1, uv = tab & 1;
        unsigned char* dstb = p->ws + WS_EXP + (size_t)tab * SZ_EXP1;
        const float* src = p->in[23 + uv] + ((size_t)l * NEXP + e) * D + lane * 4;
        f32x4 v[4];
#pragma unroll
        for (int j = 0; j < 4; ++j) v[j] = *(const f32x4*)(src + 256 * j);
        float bmj[4];
#pragma unroll
        for (int j = 0; j < 4; ++j) {
            float bm = fmaxf(fmaxf(fabsf(v[j].x), fabsf(v[j].y)), fmaxf(fabsf(v[j].z), fabsf(v[j].w))); bm = wave_max(bm);
            bmj[j] = bm * (1.f / 6.f);
            const float es = bm > 0.f ? 6.f / bm : 0.f;
            unsigned pk = 0;
            pk = __builtin_amdgcn_cvt_scalef32_pk_fp4_f32(pk, v[j].x * es, v[j].y * es, 1.0f, 0);
            pk = __builtin_amdgcn_cvt_scalef32_pk_fp4_f32(pk, v[j].z * es, v[j].w * es, 1.0f, 1);
            *(unsigned short*)(dstb + (size_t)j * SLICE_BYTES + (size_t)e * 128 + 2 * lane) = (unsigned short)pk;
        }
        if (lane == 0) {
            unsigned char* rec = p->ws + WS_EXP + (size_t)(2 * l) * SZ_EXP1 + NSL * SLICE_BYTES + (size_t)e * 32 + uv * 16;
            *(f32x4*)rec = (f32x4){bmj[0], bmj[1], bmj[2], bmj[3]}; }
    }
}
DV void run_phase0(KParams p, unsigned char* smem) {
    const int bid = blockIdx.x, nblk = gridDim.x;
    cvt_job(p->in[0], (bf16_t*)(p->ws + WS_XB), (size_t)2 * SEQL * D, bid, nblk);
    cvt_job(p->in[1], (bf16_t*)(p->ws + WS_XB) + (size_t)2 * SEQL * D, (size_t)SEQL * D, bid, nblk);
    cvt_job(p->in[2], (bf16_t*)(p->ws + WS_MEMB), (size_t)2 * N_MEM * D, bid, nblk);
    cvt_job(p->in[3], (bf16_t*)(p->ws + WS_MEMB) + (size_t)2 * N_MEM * D, (size_t)N_MEM * D, bid, nblk);
#pragma unroll 1
    for (int l = 0; l < DEPTH; ++l) {
        unsigned char* wl = p->ws + WS_W + l * SZ_WL;
        cvt_job(p->in[22] + (size_t)l * 8 * 2 * 128 * 128, (bf16_t*)(wl + OFF_SK), (size_t)8 * 2 * 128 * 128, bid, nblk);
        transpose_job(p->in[5] + (size_t)l * D * IN_WIDTH, D, IN_WIDTH, (bf16_t*)(wl + OFF_WT_IN), bid, nblk, (float*)smem);
#pragma unroll 1
        for (int n = 0; n < 3; ++n) transpose_job(p->in[17] + ((size_t)l * 3 + n) * 512 * D, 512, D, (bf16_t*)(wl + OFF_WT_BR) + (size_t)n * D * 512, bid, nblk, (float*)smem);
        transpose_job(p->in[18] + (size_t)l * D * D, D, D, (bf16_t*)(wl + OFF_WT_OUT), bid, nblk, (float*)smem);
        transpose_job(p->in[21] + (size_t)l * D * 2048, D, 2048, (bf16_t*)(wl + OFF_WT_Q), bid, nblk, (float*)smem);
        transpose_job(p->in[16] + (size_t)l * D * D, D, D, (bf16_t*)(wl + OFF_WT_MKV), bid, nblk, (float*)smem);
        transpose_job(p->in[14] + (size_t)l * FHID * 2048, FHID, 2048, (bf16_t*)(p->ws + WS_WOT) + (size_t)l * 2048 * FHID, bid, nblk, (float*)smem);
    }
    for (int k = bid * NTH + tid_(); k < 16384; k += nblk * NTH) { float sn, cs; sincospif((float)k * (1.f / 16384.f), &sn, &cs); ((float2*)(p->ws + WS_TW))[k] = make_float2(cs, -sn); }
    convert_experts(p, bid, nblk);
    filter_mlp_job(p, bid, nblk);
}
#ifndef ONLY_Q
#define ONLY_Q -1
#endif
template <int Q> DV void run_phase_q(KParams p, int l, unsigned char* smem) {
    const int bid = opaque_s(blockIdx.x), nblk = opaque_s(gridDim.x);
    if (ONLY_Q >= 0 && Q != ONLY_Q) return;
    if (Q == 0) {
        SchedG1 S{p, l, nblk, bid}; EpiG1 E{p, l};
        __syncthreads();
        pg8::gemm_stream(( LAS unsigned char*)smem, S, E);
    } else if (Q == 1) {
        const int na = 768, nm = 768, nf = 1024, ns = NSEQ * 64 * 24;
#pragma unroll 1
        for (int t = bid; t < na + nm + nf + ns; t += nblk) {
            if (t < na) attn_item<true>(p, l, t, smem);
            else if (t < na + nm) attn_item<false>(p, l, t - na, smem);
            else if (t < na + nm + nf) filt_tile(p, l, t - na - nm, smem);
            else shortconv_item(p, l, t - na - nm - nf, (float*)smem);
        }
    } else if (Q == 2) {
#pragma unroll 1
        for (int c = bid; c < HYW; c += nblk) hyena_item(p, l, c, smem);
    } else if (Q == 3) {
#pragma unroll 1
        for (int t = bid; t < NSEQ * 64 * 8; t += nblk) hyo_transpose_item(p, t, (bf16_t*)smem);
    } else if (Q == 4) {
        SchedMerge S{p, l, nblk, bid}; EpiMerge E{p, l};
        __syncthreads();
        pg8::gemm_stream((LAS unsigned char*)smem, S, E);
    } else if (Q == 5) {
        SchedOut S{p, l, nblk, bid}; EpiOut E{p};
        __syncthreads();
        pg8::gemm_stream((LAS unsigned char*)smem, S, E);
    } else if (Q == 6) ln1_job(p, l, bid, nblk);
    else if (Q == 7) {
        SchedQ S{p, l, nblk, bid}; EpiQ E{p};
        __syncthreads();
        pg8::gemm_stream((LAS unsigned char*)smem, S, E);
    } else if (Q == 8) {
        const int h = bid & 7, b8 = bid >> 3, nb8 = nblk >> 3;
        peer_stage_sk(p, l, h, (bf16_t*)smem);
        bf16x8 bqn[2][4];
        if (b8 < T / 128) peer_topk_loadq(p, b8, h, bqn);
#pragma unroll 1
        for (int tile = b8; tile < T / 128; tile += nb8) {
            bf16x8 bqc[2][4];
#pragma unroll
            for (int c = 0; c < 2; ++c)
#pragma unroll
                for (int ks = 0; ks < 4; ++ks) bqc[c][ks] = bqn[c][ks];
            if (tile + nb8 < T / 128) peer_topk_loadq(p, tile + nb8, h, bqn);
            peer_topk_item(p, l, tile, h, (bf16_t*)smem, bqc);
        }
    } else if (Q == 9) peer_u_phase(p, l, bid, nblk);
    else if (Q == 11) peer_v_phase(p, l, bid, nblk);
    else if (Q == 10) peer_c_phase(p, l, bid, nblk);
    else ln2_job(p, l, bid, nblk);
}
#ifdef PROBE_PHASE
#define PROBE_STAMP(i) { if (blockIdx.x == 0 && threadIdx.x == 0) __hip_atomic_store((unsigned long long*)(p.ws + WS_TS) + (i), (unsigned long long)__builtin_amdgcn_s_memrealtime(), __ATOMIC_RELAXED, __HIP_MEMORY_SCOPE_AGENT); }
#else
#define PROBE_STAMP(i)
#endif
#define PHASE_STEP(Q) { const int ph = 1 + l * PH_PER_LAYER + Q; if (ph >= p.ph_lo && ph < p.ph_hi) { run_phase_q<Q>(kparams(), l, smem); if (ph + 1 < p.ph_hi) GRID_SYNC(); PROBE_STAMP(ph + 1) } }
__global__ void __launch_bounds__(NTH, 2) encoder_fwd(Params p) {
    extern __shared__ __attribute__((aligned(16))) unsigned char smem[];
    cg::grid_group grid = cg::this_grid();
    PROBE_STAMP(0)
    volatile LAS unsigned* xst = (volatile LAS unsigned*)(smem + LDS_BYTES - 16);
    unsigned* xbar = (unsigned*)(p.ws + WS_BAR);
    if (threadIdx.x == 0) { xst[0] = 0u; xst[1] = 0u; }
    if (p.ph_lo == 0 && blockIdx.x == 0) for (int i = threadIdx.x; i < XCD_BAR_WORDS; i += NTH) __hip_atomic_store(xbar + i, 0u, __ATOMIC_RELAXED, __HIP_MEMORY_SCOPE_AGENT);
    XcdBarrier xb; xb.bar = xbar; xb.x = 0; xb.st = xst;
#define GRID_SYNC() xcd_barrier(xb)
    if (p.ph_lo == 0) { if (ONLY_Q < 0 || ONLY_Q == 100) run_phase0(kparams(), smem); if (1 < p.ph_hi) { grid.sync(); xb = xcd_barrier_post(xbar, xst); } PROBE_STAMP(1) }
#pragma unroll 1
    for (int l = 0; l < DEPTH; ++l) {
        PHASE_STEP(0) PHASE_STEP(1) PHASE_STEP(2) PHASE_STEP(3) PHASE_STEP(4) PHASE_STEP(5) PHASE_STEP(6) PHASE_STEP(7) PHASE_STEP(8) PHASE_STEP(9) PHASE_STEP(10) PHASE_STEP(11) PHASE_STEP(12)
    }
#ifdef PROBE_PHASE
#ifndef PROBE_END
#define PROBE_END (PROBE_PHASE + 1)
#endif
    GRID_SYNC();
    PROBE_STAMP(NPHASE)
    GRID_SYNC();
    {
        const unsigned long long* ts = (const unsigned long long*)(p.ws + WS_TS);
        const unsigned long long t0 = __hip_atomic_load(ts, __ATOMIC_RELAXED, __HIP_MEMORY_SCOPE_AGENT), t1 = __hip_atomic_load(ts + NPHASE, __ATOMIC_RELAXED, __HIP_MEMORY_SCOPE_AGENT);
        const unsigned long long ta = __hip_atomic_load(ts + PROBE_PHASE, __ATOMIC_RELAXED, __HIP_MEMORY_SCOPE_AGENT), tb = __hip_atomic_load(ts + PROBE_END, __ATOMIC_RELAXED, __HIP_MEMORY_SCOPE_AGENT);
        const float f = (float)(tb - ta) / (float)(t1 - t0);
        const float sc = 1.f + sqrtf(6e-4f * f);
        f32x4* o = (f32x4*)(p.out + (size_t)2 * SEQL * D);
        for (size_t i = (size_t)blockIdx.x * NTH + threadIdx.x; i < (size_t)SEQL * D / 4; i += (size_t)gridDim.x * NTH) o[i] = o[i] * sc;
    }
#endif
}

#ifndef ONE_LAUNCH
#define ONE_LAUNCH 1
#endif
extern "C" void kernel_launch(void* const* d_in, const int* in_sizes, int n_in, void* d_out, int out_size, void* d_ws, size_t ws_size, hipStream_t stream) {
    static int grid = 0;
    if (grid == 0) {
        if (n_in != 27 || out_size != T * D || ws_size < WS_END) { fprintf(stderr, "kernel_launch: unexpected shapes: n_in %d out %d ws %zu (need %zu)\n", n_in, out_size, ws_size, (size_t)WS_END); grid = -1; return; }
        int dev = 0, cus = 0, per_cu = 0;
        hipGetDevice(&dev);
        hipDeviceGetAttribute(&cus, hipDeviceAttributeMultiprocessorCount, dev);
        if (hipFuncSetAttribute((const void*)encoder_fwd, hipFuncAttributeMaxDynamicSharedMemorySize, LDS_BYTES) != hipSuccess) { fprintf(stderr, "kernel_launch: hipFuncSetAttribute failed\n"); grid = -1; return; }
        if (hipOccupancyMaxActiveBlocksPerMultiprocessor(&per_cu, (const void*)encoder_fwd, NTH, LDS_BYTES) != hipSuccess || per_cu < 1) { fprintf(stderr, "kernel_launch: occupancy query failed (%d)\n", per_cu); grid = -1; return; }
        grid = cus < MAX_GRID ? cus : MAX_GRID; grid &= ~7;
        fprintf(stderr, "kernel_launch: cus %d per_cu %d grid %d ws %zu need %zu\n", cus, per_cu, grid, ws_size, (size_t)WS_END);
    }
    if (grid < 0) return;
    Params p{};
    for (int i = 0; i < 27; ++i) p.in[i] = (const float*)d_in[i];
    p.out = (float*)d_out; p.ws = (unsigned char*)d_ws;
#if ONE_LAUNCH
    p.ph_lo = 0; p.ph_hi = NPHASE;
    void* args[] = {&p};
    hipError_t e = hipLaunchCooperativeKernel((const void*)encoder_fwd, dim3(grid), dim3(NTH), args, LDS_BYTES, stream);
    if (e != hipSuccess) fprintf(stderr, "cooperative launch failed: %s (grid %d)\n", hipGetErrorString(e), grid);
#else
    for (int ph = 0; ph < NPHASE; ++ph) {
        p.ph_lo = ph; p.ph_hi = ph + 1;
        hipLaunchKernelGGL(encoder_fwd, dim3(grid), dim3(NTH), LDS_BYTES, stream, p);
    }
#endif
}
```

```cpp
#include <hip/hip_runtime.h>
#include <hip/hip_cooperative_groups.h>
#include <cstdio>
#include <cmath>
namespace cg = cooperative_groups;

#define HD __host__ __device__ __forceinline__
#define DV __device__ __forceinline__

typedef unsigned short bf16_t;
typedef short bf16x8 __attribute__((ext_vector_type(8)));
typedef float f32x4 __attribute__((ext_vector_type(4)));
typedef unsigned u32x4 __attribute__((ext_vector_type(4)));
typedef unsigned u32x2 __attribute__((ext_vector_type(2)));
typedef _Float16 f16_t;

constexpr int NTH = 512;
constexpr int D = 1024, NSEQ = 3, SEQL = 16384, T = NSEQ * SEQL, DEPTH = 2;
constexpr int N_MEM = 256;
constexpr int IN_WIDTH = 5888, O_K = 512, O_V = 640, O_HY = 768, O_MQ = 2304, O_GATE = 2816;
constexpr int HYW = 512, HY3 = 1536;
constexpr int FEMB = 33, FHID = 64;
constexpr int NEXP = 16384;
constexpr float ALPHA = 1.4142135623730951f;
constexpr float LN_EPS = 1e-5f;

constexpr size_t SZ_WT_IN = (size_t)IN_WIDTH * D * 2, SZ_WT_BR = (size_t)3 * D * 512 * 2, SZ_WT_OUT = (size_t)D * D * 2,
                 SZ_WT_Q = (size_t)2048 * D * 2, SZ_WT_MKV = (size_t)D * D * 2, SZ_SK = (size_t)8 * 2 * 128 * 128 * 2;
constexpr size_t OFF_WT_IN = 0, OFF_WT_BR = OFF_WT_IN + SZ_WT_IN, OFF_WT_OUT = OFF_WT_BR + SZ_WT_BR, OFF_WT_Q = OFF_WT_OUT + SZ_WT_OUT,
                 OFF_WT_MKV = OFF_WT_Q + SZ_WT_Q, OFF_SK = OFF_WT_MKV + SZ_WT_MKV, SZ_WL = OFF_SK + SZ_SK;
constexpr size_t WS_W = 0;
constexpr size_t WS_EXP = WS_W + 2 * SZ_WL;
constexpr size_t SZ_EXP1 = (size_t)NEXP * D + (size_t)NEXP * 4;
constexpr size_t WS_XB = WS_EXP + 4 * SZ_EXP1;
constexpr size_t WS_QKV = WS_XB + (size_t)T * D * 2;
constexpr size_t WS_HY = WS_QKV + (size_t)T * 768 * 2;
constexpr size_t WS_MEMB = WS_HY + (size_t)T * HY3 * 2;
constexpr size_t WS_KVMEM = WS_MEMB + (size_t)768 * D * 2;
constexpr size_t WS_H3 = WS_KVMEM + (size_t)2 * 768 * D * 2;
constexpr size_t WS_WOT = WS_H3 + (size_t)2 * 64 * SEQL * 2;
constexpr size_t WS_FILT = WS_WOT + (size_t)2 * 2048 * 64 * 2;
constexpr int MAX_GRID = 256;
constexpr size_t WS_HSCR = WS_HY;
static_assert((size_t)MAX_GRID * 2 * 8192 * 16 <= (size_t)T * HY3 * 2, "HSCR overlay");
constexpr size_t WS_TS = WS_FILT + (size_t)2048 * SEQL * 2;
constexpr size_t WS_TW = WS_TS + 1024;
constexpr size_t WS_BAR = WS_TW + (size_t)16384 * 8;
constexpr size_t WS_END = WS_BAR + 16384;
constexpr size_t WS_EIDX = WS_QKV;
constexpr size_t WS_GATE = WS_EIDX + (size_t)T * 128 * 2;
constexpr size_t WS_COEF = WS_GATE + (size_t)T * 128 * 4;
constexpr size_t WS_EIDXN = WS_COEF + (size_t)T * 128 * 2;
constexpr size_t WS_X8 = WS_HY;
static_assert(WS_EIDXN + (size_t)T * 128 * 2 <= WS_HY, "eidx copy overflows the qkv region");
static_assert(WS_COEF + (size_t)T * 128 * 4 <= WS_HY, "PEER buffers overlay qkv");
constexpr size_t DO_UCT = 0, DO_QM = (size_t)NSEQ * HY3 * SEQL * 2;

struct Params {
    const float* in[27];
    float* out;
    unsigned char* ws;
    int ph_lo, ph_hi;
};

HD bf16_t f2bf(float f) {
    unsigned u = __builtin_bit_cast(unsigned, f);
    u += 0x7fffu + ((u >> 16) & 1u);
    return (bf16_t)(u >> 16);
}
HD float bf2f(bf16_t h) { return __builtin_bit_cast(float, (unsigned)h << 16); }
typedef __bf16 bf16x2_hw __attribute__((ext_vector_type(2)));
typedef float f32x2_cv __attribute__((ext_vector_type(2)));
HD unsigned pk2(float lo, float hi) {
#if defined(__HIP_DEVICE_COMPILE__)
    return __builtin_bit_cast(unsigned, __builtin_convertvector((f32x2_cv){lo, hi}, bf16x2_hw));
#else
    return (unsigned)f2bf(lo) | ((unsigned)f2bf(hi) << 16);
#endif
}
HD float bflo(unsigned w) { return __builtin_bit_cast(float, w << 16); }
HD float bfhi(unsigned w) { return __builtin_bit_cast(float, w & 0xffff0000u); }

HD float2 cadd(float2 a, float2 b) { return make_float2(a.x + b.x, a.y + b.y); }
HD float2 csub(float2 a, float2 b) { return make_float2(a.x - b.x, a.y - b.y); }
HD float2 cmul(float2 a, float2 b) { return make_float2(a.x * b.x - a.y * b.y, a.x * b.y + a.y * b.x); }
HD float2 cmulc(float2 a, float2 b) { return make_float2(a.x * b.x + a.y * b.y, a.y * b.x - a.x * b.y); }
HD float2 cconj(float2 a) { return make_float2(a.x, -a.y); }

constexpr int FN = 16384;
HD int PI(int p) { return p + ((p >> 5) << 1); }
constexpr int FBUF_F2 = FN + (FN >> 5) * 2;
HD int fpos(int k) { return ((k & 15) << 10) | (((k >> 4) & 15) << 6) | (((k >> 8) & 3) << 4) | (k >> 10); }
HD int frev(int p) { return (p >> 10) | (((p >> 6) & 15) << 4) | (((p >> 4) & 3) << 8) | ((p & 15) << 10); }

typedef float v2f __attribute__((ext_vector_type(2)));
typedef _Float16 h2 __attribute__((ext_vector_type(2)));
template <class V> HD V mk2(float a, float b);
template <> HD v2f mk2<v2f>(float a, float b) { return (v2f){a, b}; }
template <> HD h2 mk2<h2>(float a, float b) { return (h2){(_Float16)a, (_Float16)b}; }
HD v2f tof(v2f a) { return a; }
HD v2f tof(h2 a) { return (v2f){(float)a.x, (float)a.y}; }
template <class V> HD V vswap(V a) { return __builtin_shufflevector(a, a, 1, 0); }
template <class V> HD V cmulv(V a, V w) { const V wr = __builtin_shufflevector(w, w, 0, 0); V wi = w; wi.x = -w.y; wi.y = w.y; return a * wr + vswap(a) * wi; }
template <class V> HD V rot_mi(V a) { return vswap(a) * mk2<V>(1.f, -1.f); }
template <class V> HD V rot_pi(V a) { return vswap(a) * mk2<V>(-1.f, 1.f); }
template <bool INV, class V> HD void dft4(V& a, V& b, V& c, V& d) {
    const V t0 = a + c, t1 = a - c, t2 = b + d, t3 = b - d;
    a = t0 + t2; c = t0 - t2;
    if (!INV) { b = t1 + rot_mi(t3); d = t1 + rot_pi(t3); }
    else      { b = t1 + rot_pi(t3); d = t1 + rot_mi(t3); }
}
template <bool INV, class V> HD void dft16(V (&x)[16]) {
    const float C1 = 0.92387953251128674f, S1 = 0.38268343236508977f, R2 = 0.70710678118654752f;
#pragma unroll
    for (int a = 0; a < 4; ++a) dft4<INV, V>(x[a], x[a + 4], x[a + 8], x[a + 12]);
    const float sg = INV ? 1.f : -1.f;
    x[1 + 4] = cmulv(x[1 + 4], mk2<V>(C1, sg * S1));
    x[1 + 8] = cmulv(x[1 + 8], mk2<V>(R2, sg * R2));
    x[1 + 12] = cmulv(x[1 + 12], mk2<V>(S1, sg * C1));
    x[2 + 4] = cmulv(x[2 + 4], mk2<V>(R2, sg * R2));
    x[2 + 8] = INV ? rot_pi(x[2 + 8]) : rot_mi(x[2 + 8]);
    x[2 + 12] = cmulv(x[2 + 12], mk2<V>(-R2, sg * R2));
    x[3 + 4] = cmulv(x[3 + 4], mk2<V>(S1, sg * C1));
    x[3 + 8] = cmulv(x[3 + 8], mk2<V>(-R2, sg * R2));
    x[3 + 12] = cmulv(x[3 + 12], mk2<V>(-C1, -sg * S1));
#pragma unroll
    for (int b = 0; b < 4; ++b) dft4<INV, V>(x[4 * b], x[4 * b + 1], x[4 * b + 2], x[4 * b + 3]);
}
HD float2 twid(float frac) {
    float s, c;
#if defined(__HIP_DEVICE_COMPILE__)
    sincospif(2.f * frac, &s, &c);
#else
    s = sinf(6.283185307179586f * frac); c = cosf(6.283185307179586f * frac);
#endif
    return make_float2(c, -s);
}
HD float2 twnf(const float2* tw, int j, int n) {
#if defined(__HIP_DEVICE_COMPILE__)
    return tw[j * (32768 / n)];
#else
    (void)tw; return twid((float)j / (float)n);
#endif
}
HD int PIx(v2f*, int p) { return p + ((p >> 5) << 1); }
HD int PIx(h2*, int p) { return p + ((p >> 6) << 2); }
constexpr int FBUF_H2 = FN + (FN >> 6) * 4;
template <int STRIDE> HD constexpr int poffx(v2f*, int m) { return STRIDE >= 32 ? m * (STRIDE + 2 * (STRIDE / 32)) : (STRIDE == 16 ? 16 * m + 2 * (m >> 1) : m); }
template <int STRIDE> HD constexpr int poffx(h2*, int m) { return STRIDE >= 64 ? m * (STRIDE + 4 * (STRIDE / 64)) : m * STRIDE; }
template <class V> HD void wpowers(V w1, V (&w)[16]) {
    w[1] = w1; w[2] = cmulv(w1, w1); w[3] = cmulv(w[2], w1); w[4] = cmulv(w[2], w[2]);
    w[5] = cmulv(w[4], w1); w[6] = cmulv(w[4], w[2]); w[7] = cmulv(w[4], w[3]); w[8] = cmulv(w[4], w[4]);
#pragma unroll
    for (int i = 1; i < 8; ++i) w[8 + i] = cmulv(w[8], w[i]);
}
template <bool INV, int N, int STRIDE, class V> HD void bfly16_core(V (&x)[16], unsigned j, const float2* tw) {
    if (STRIDE > 1) {
        const float2 t = twnf(tw, (int)j, N);
        V w[16]; wpowers(mk2<V>(t.x, INV ? -t.y : t.y), w);
        if (INV) {
#pragma unroll
            for (int m = 1; m < 16; ++m) x[m] = cmulv(x[m], w[m]);
            dft16<INV, V>(x);
        } else {
            dft16<INV, V>(x);
#pragma unroll
            for (int q = 1; q < 16; ++q) { const int s = (q >> 2) + 4 * (q & 3); x[s] = cmulv(x[s], w[q]); }
        }
    } else dft16<INV, V>(x);
}
template <bool INV, int N, int STRIDE, class V> HD void fft_bfly16(V* buf, unsigned bf, const float2* tw) {
    const unsigned blk = bf / STRIDE, j = bf % STRIDE, base = blk * N + j;
    V* b = buf + PIx((V*)nullptr, (int)base);
    V x[16];
#pragma unroll
    for (int m = 0; m < 16; ++m) x[m] = b[poffx<STRIDE>((V*)nullptr, m)];
    bfly16_core<INV, N, STRIDE, V>(x, j, tw);
#pragma unroll
    for (int q = 0; q < 16; ++q) b[poffx<STRIDE>((V*)nullptr, q)] = x[(q >> 2) + 4 * (q & 3)];
}
template <bool INV, int N, int STRIDE, class V> HD void fft_bfly4(V* buf, unsigned bf, const float2* tw) {
    const unsigned blk = bf / STRIDE, j = bf % STRIDE, base = blk * N + j;
    V* b = buf + PIx((V*)nullptr, (int)base);
    V x[4];
#pragma unroll
    for (int m = 0; m < 4; ++m) x[m] = b[poffx<STRIDE>((V*)nullptr, m)];
    const float2 t = twnf(tw, (int)j, N);
    const V w1 = mk2<V>(t.x, INV ? -t.y : t.y), w2 = cmulv(w1, w1), w3 = cmulv(w2, w1);
    if (INV) { x[1] = cmulv(x[1], w1); x[2] = cmulv(x[2], w2); x[3] = cmulv(x[3], w3); }
    dft4<INV, V>(x[0], x[1], x[2], x[3]);
    if (!INV) { x[1] = cmulv(x[1], w1); x[2] = cmulv(x[2], w2); x[3] = cmulv(x[3], w3); }
#pragma unroll
    for (int q = 0; q < 4; ++q) b[poffx<STRIDE>((V*)nullptr, q)] = x[q];
}
#ifndef HYV
#define HYV h2
#endif
template <class V> struct YScale { static constexpr float v = 1.f; };
template <> struct YScale<h2> { static constexpr float v = 128.f; };
constexpr float HY_YS = YScale<HYV>::v;
HD unsigned ldpairw(const bf16_t* p, unsigned bf, int m) { return *(const unsigned*)(p + 2 * (bf + 1024u * (unsigned)m)); }
HD v2f pairf(unsigned w) { return (v2f){bflo(w), bfhi(w)}; }
HD void hy_load8(const bf16_t* p, unsigned bf, unsigned (&w)[8]) {
#pragma unroll
    for (int m = 0; m < 8; ++m) w[m] = ldpairw(p, bf, m);
}
template <class V> HD void hy_step_a(V* buf, unsigned bf, const unsigned (&pa)[8], const float2* tw) {
    V x[16];
#pragma unroll
    for (int m = 0; m < 8; ++m) x[m] = mk2<V>(bflo(pa[m]), bfhi(pa[m]));
#pragma unroll
    for (int m = 8; m < 16; ++m) x[m] = mk2<V>(0.f, 0.f);
    bfly16_core<false, 16384, 1024, V>(x, bf, tw);
    V* b = buf + PIx((V*)nullptr, (int)bf);
#pragma unroll
    for (int q = 0; q < 16; ++q) b[poffx<1024>((V*)nullptr, q)] = x[(q >> 2) + 4 * (q & 3)];
}
template <class V> HD void hy_step_b(V* buf, unsigned bf, const unsigned (&pa)[8], const unsigned (&pb)[8], float bias0, float ys, v2f (&z1)[8], const float2* tw) {
    V* b = buf + PIx((V*)nullptr, (int)bf);
    V x[16];
#pragma unroll
    for (int m = 0; m < 16; ++m) x[m] = b[poffx<1024>((V*)nullptr, m)];
    bfly16_core<true, 16384, 1024, V>(x, bf, tw);
    V y[16];
#pragma unroll
    for (int q = 0; q < 8; ++q) { const v2f a = pairf(pa[q]), c = pairf(pb[q]); z1[q] = c * (tof(x[(q >> 2) + 4 * (q & 3)]) * ys + a * bias0); y[q] = mk2<V>(z1[q].x, z1[q].y); }
#pragma unroll
    for (int q = 8; q < 16; ++q) y[q] = mk2<V>(0.f, 0.f);
    bfly16_core<false, 16384, 1024, V>(y, bf, tw);
#pragma unroll
    for (int q = 0; q < 16; ++q) b[poffx<1024>((V*)nullptr, q)] = y[(q >> 2) + 4 * (q & 3)];
}
template <class V> HD void hy_step_c(const V* buf, unsigned bf, const unsigned (&pc)[8], const v2f (&z1)[8], float bias1, float ys, bf16_t* outp, const float2* tw) {
    const V* b = buf + PIx((V*)nullptr, (int)bf);
    V x[16];
#pragma unroll
    for (int m = 0; m < 16; ++m) x[m] = b[poffx<1024>((V*)nullptr, m)];
    bfly16_core<true, 16384, 1024, V>(x, bf, tw);
#pragma unroll
    for (int q = 0; q < 8; ++q) { const v2f c = pairf(pc[q]); const v2f o = c * (tof(x[(q >> 2) + 4 * (q & 3)]) * ys + z1[q] * bias1);
        *(unsigned*)(outp + 2 * (bf + 1024u * (unsigned)q)) = pk2(o.x, o.y); }
}
template <bool INV, class V> HD void fft_pass(V* buf, int p, int tid, const float2* tw = nullptr) {
    const int pp = INV ? 3 - p : p;
    if (pp == 0) {
#pragma unroll 2
        for (int i = 0; i < 2; ++i) fft_bfly16<INV, 16384, 1024, V>(buf, (unsigned)(tid + NTH * i), tw); }
    else if (pp == 1) {
#pragma unroll 2
        for (int i = 0; i < 2; ++i) fft_bfly16<INV, 1024, 64, V>(buf, (unsigned)(tid + NTH * i), tw); }
    else if (pp == 2) {
#pragma unroll 2
        for (int i = 0; i < 8; ++i) fft_bfly4<INV, 64, 16, V>(buf, (unsigned)(tid + NTH * i), tw); }
    else {
#pragma unroll 2
        for (int i = 0; i < 2; ++i) fft_bfly16<INV, 16, 1, V>(buf, (unsigned)(tid + NTH * i), tw); }
}
struct HPair { float2 hk, hl; };
HD void pair_unpack(float2 ck, float2 cl, float2 w, float2& ak, float2& al) {
    const float2 e = make_float2(0.5f * (ck.x + cl.x), 0.5f * (ck.y - cl.y));
    const float2 dd = make_float2(0.5f * (ck.x - cl.x), 0.5f * (ck.y + cl.y));
    const float2 o = make_float2(dd.y, -dd.x);
    const float2 wo = cmul(w, o);
    ak = cadd(e, wo); al = cconj(csub(e, wo));
}
HD void pair_pack(float2 yk, float2 yl, float2 w, float2& dk, float2& dl) {
    const float2 ye = make_float2(0.5f * (yk.x + yl.x), 0.5f * (yk.y - yl.y));
    const float2 dd = make_float2(0.5f * (yk.x - yl.x), 0.5f * (yk.y + yl.y));
    const float2 yo = cmulc(dd, w);
    dk = make_float2(ye.x - yo.y, ye.y + yo.x);
    dl = make_float2(ye.x + yo.y, -ye.y + yo.x);
}
HD void pair_item_pos(int e, int& p, int& k, int& pl) { p = 16 * (e >> 3) + (e & 7); k = frev(p); pl = fpos((FN - k) & (FN - 1)); }
HD float2 twn2(const float2* t12, int k) {
#if defined(__HIP_DEVICE_COMPILE__)
    return cmul(t12[k & 255], t12[256 + (k >> 8)]);
#else
    (void)t12; return twid((float)k / (float)(2 * FN));
#endif
}
HD float2 ldc(const v2f* b, int p) { const v2f v = b[PIx((v2f*)nullptr, p)]; return make_float2(v.x, v.y); }
HD float2 ldc(const h2* b, int p) { const h2 v = b[PIx((h2*)nullptr, p)]; return make_float2((float)v.x, (float)v.y); }
HD void stc(v2f* b, int p, float2 v) { b[PIx((v2f*)nullptr, p)] = (v2f){v.x, v.y}; }
HD void stc(h2* b, int p, float2 v) { b[PIx((h2*)nullptr, p)] = mk2<h2>(v.x, v.y); }
HD HPair pair_filter(const v2f* buf, int e, float sc, const float2* tw = nullptr) {
    int p, k, pl; pair_item_pos(e, p, k, pl);
    HPair h;
    if (e == 0) {
        const float2 c0 = ldc(buf, 0), c8 = ldc(buf, fpos(FN / 2));
        h.hk = make_float2((c0.x + c0.y) * sc, (c0.x - c0.y) * sc);
        h.hl = make_float2(c8.x * sc, -c8.y * sc);
        return h;
    }
    const float2 ck = ldc(buf, p), cl = ldc(buf, pl);
    float2 ak, al; pair_unpack(ck, cl, twn2(tw, k), ak, al);
    h.hk = make_float2(ak.x * sc, ak.y * sc); h.hl = make_float2(al.x * sc, al.y * sc);
    return h;
}
template <class V> HD void pair_apply(V* buf, int e, const HPair& h, const float2* tw = nullptr) {
    int p, k, pl; pair_item_pos(e, p, k, pl);
    if (e == 0) {
        const float2 c0 = ldc(buf, 0);
        const float y0 = (c0.x + c0.y) * h.hk.x, yL = (c0.x - c0.y) * h.hk.y;
        stc(buf, 0, make_float2(0.5f * (y0 + yL), 0.5f * (y0 - yL)));
        const int p8 = fpos(FN / 2);
        const float2 c8 = ldc(buf, p8);
        const float2 y8 = cmul(cconj(c8), h.hl);
        stc(buf, p8, cconj(y8));
        return;
    }
    const float2 ck = ldc(buf, p), cl = ldc(buf, pl);
    const float2 w = twn2(tw, k);
    float2 ak, al; pair_unpack(ck, cl, w, ak, al);
    const float2 yk = cmul(ak, h.hk), yl = cmul(al, h.hl);
    float2 dk, dl; pair_pack(yk, yl, w, dk, dl);
    stc(buf, p, dk); stc(buf, pl, dl);
}
struct PairCtx { int pp, plA, plB, k0; };
HD int pair_fhi(int y) { return ((y & 15) << 6) | (((y >> 4) & 3) << 4) | (y >> 6); }
HD PairCtx pair_ctx(int tid) {
    PairCtx c; const int p0 = 16 * (tid >> 3) + (tid & 7), k0 = frev(p0), x0 = ((FN - k0) & (FN - 1)) >> 4;
    c.pp = PIx((h2*)nullptr, p0); c.plA = PIx((h2*)nullptr, pair_fhi(x0)); c.plB = PIx((h2*)nullptr, pair_fhi((x0 - 1) & 1023)); c.k0 = k0; return c;
}
template <int I> HD void pair_apply_fast(h2* buf, const PairCtx& c, int tid, const HPair& h, const float2* tw) {
    if (I == 0 && tid == 0) { pair_apply<h2>(buf, 0, h, tw); return; }
    h2* bp = buf + c.pp + 1088 * I; h2* bl = buf + (I ? c.plB + 1088 * (16 - I) : c.plA);
    const h2 ck = *bp, cl = *bl;
    const float2 wf = twn2(tw, c.k0 + I); const h2 w = mk2<h2>(wf.x, wf.y);
    const h2 hk = mk2<h2>(h.hk.x, h.hk.y), hl = mk2<h2>(h.hl.x, h.hl.y);
    const h2 cj = mk2<h2>(1.f, -1.f);
    const h2 clc = cl * cj;
    const h2 ep = ck + clc, dp = ck - clc;
    const h2 wo = cmulv(rot_mi(dp), w);
    const h2 ak = ep + wo, alc = ep - wo;
    const h2 yk = cmulv(ak, hk);
    const h2 ylc = cmulv(alc * cj, hl) * cj;
    const h2 yep = yk + ylc, ddp = yk - ylc;
    const h2 iyo = rot_pi(cmulv(ddp, w * cj));
    *bp = yep + iyo;
    *bl = (yep - iyo) * cj;
}
template <class V> struct PairPre { static constexpr float v = 1.f; };
template <> struct PairPre<h2> { static constexpr float v = 0.25f; };
constexpr float PAIR_PRE = PairPre<HYV>::v;
HD int fidx(int n) { return PI(n >> 1) * 2 + (n & 1); }

template <int N> HD void bitonic_sort_desc(unsigned (&k)[N]) {
#pragma unroll
    for (int size = 2; size <= N; size <<= 1)
#pragma unroll
        for (int stride = size >> 1; stride > 0; stride >>= 1)
#pragma unroll
            for (int i = 0; i < N; ++i) { const int j = i ^ stride;
                if (j > i) { const bool up = (i & size) != 0;
                    const unsigned a = k[i], b = k[j], mx = a > b ? a : b, mn = a > b ? b : a;
                    k[i] = up ? mn : mx; k[j] = up ? mx : mn; } }
}
template <int N> HD void bitonic_merge_desc(unsigned (&k)[N]) {
#pragma unroll
    for (int stride = N >> 1; stride > 0; stride >>= 1)
#pragma unroll
        for (int i = 0; i < N; ++i) { const int j = i ^ stride;
            if (j > i) { const unsigned a = k[i], b = k[j]; k[i] = a > b ? a : b; k[j] = a > b ? b : a; } }
}
HD int t5_bucket(int rel) {
    const int n = rel < 0 ? -rel : rel;
    int b = rel > 0 ? 16 : 0;
    if (n < 8) return b + n;
    int nn = n * n, lg = 0;
    while ((nn >> (lg + 1)) != 0) ++lg;
    int large = lg + 2;
    if (large > 15) large = 15;
    return b + large;
}

#define LAS __attribute__((address_space(3)))
#define GAS __attribute__((address_space(1)))
typedef const Params __attribute__((address_space(4)))* KParams;
DV KParams kparams() { KParams kp = (KParams)__builtin_amdgcn_kernarg_segment_ptr(); asm volatile("" : "+s"(kp)); return kp; }
DV int opaque_s(int v) { asm volatile("" : "+s"(v)); return v; }
DV int tid_() { int v = threadIdx.x; asm volatile("" : "+v"(v)); return v; }
DV int wave_() { return __builtin_amdgcn_readfirstlane(tid_() >> 6); }
DV float wave_sum(float v) {
#pragma unroll
    for (int o = 1; o < 64; o <<= 1) v += __shfl_xor(v, o);
    return v;
}
DV float wave_max(float v) {
#pragma unroll
    for (int o = 1; o < 64; o <<= 1) v = fmaxf(v, __shfl_xor(v, o));
    return v;
}
DV void glds16(const void* g, void* l) {
    __builtin_amdgcn_global_load_lds((const GAS unsigned*)g, (LAS unsigned*)l, 16, 0, 0);
}
DV u32x4 ldg16(const void* p) { return *(const u32x4*)p; }
DV void stg16(void* p, u32x4 v) { *(u32x4*)p = v; }

DV void cvt_job(const float* src, bf16_t* dst, size_t n, int bid, int nblk) {
    const size_t n8 = n / 8;
    for (size_t i = (size_t)bid * NTH + tid_(); i < n8; i += (size_t)nblk * NTH) {
        const f32x4 a = *(const f32x4*)(src + i * 8), b = *(const f32x4*)(src + i * 8 + 4);
        u32x4 o; o.x = pk2(a.x, a.y); o.y = pk2(a.z, a.w); o.z = pk2(b.x, b.y); o.w = pk2(b.z, b.w);
        stg16(dst + i * 8, o);
    }
}
DV void transpose_item(const float* W, int K, int N, bf16_t* WT, int item, float* s  ) {
    const int ntn = N / 64, kb = item / ntn, nb = item - kb * ntn, k0 = kb * 64, n0 = nb * 64, tid = tid_();
    __syncthreads();
#pragma unroll
    for (int i = 0; i < 8; ++i) { const int idx = tid + i * NTH, r = idx >> 6, c = idx & 63; s[r * 65 + c] = W[(size_t)(k0 + r) * N + n0 + c]; }
    __syncthreads();
#pragma unroll
    for (int i = 0; i < 4; ++i) { const int idx = tid + i * NTH, n = idx >> 5, kp = idx & 31;
        *(unsigned*)(WT + (size_t)(n0 + n) * K + k0 + 2 * kp) = pk2(s[(2 * kp) * 65 + n], s[(2 * kp + 1) * 65 + n]); }
}
DV void transpose_job(const float* W, int K, int N, bf16_t* WT, int bid, int nblk, float* s) {
    const int items = (K / 64) * (N / 64);
    for (int it = bid; it < items; it += nblk) transpose_item(W, K, N, WT, it, s);
}
DV void filter_mlp_job(KParams p, int bid, int nblk) {
    const int lane = tid_() & 63, wv = wave_();
    bf16_t* h3 = (bf16_t*)(p->ws + WS_H3);
    const int gw = bid * 8 + wv, nw = nblk * 8, l = gw & 1;
    const float* w_in = p->in[10] + (size_t)l * FEMB * FHID;
    const float* w_mid = p->in[11] + (size_t)l * 2 * FHID * FHID;
    const float* fb = p->in[12] + (size_t)l * 3 * FHID;
    const float* ff = p->in[13] + (size_t)l * 3 * FHID;
    unsigned wi[17], wm[2][FHID / 2];
#pragma unroll
    for (int i = 0; i < 16; ++i) wi[i] = pk2(w_in[(2 * i) * FHID + lane], w_in[(2 * i + 1) * FHID + lane]);
    wi[16] = pk2(w_in[32 * FHID + lane], 0.f);
#pragma unroll
    for (int q = 0; q < 2; ++q)
#pragma unroll
        for (int i = 0; i < FHID / 2; ++i) wm[q][i] = pk2(w_mid[(q * FHID + 2 * i) * FHID + lane], w_mid[(q * FHID + 2 * i + 1) * FHID + lane]);
    const float b0 = fb[lane], b1 = fb[FHID + lane], b2 = fb[2 * FHID + lane], f0 = ff[lane], f1 = ff[FHID + lane], f2 = ff[2 * FHID + lane];
#pragma unroll 1
    for (int pos = gw >> 1; pos < SEQL; pos += nw >> 1) {
        const float tt = (float)pos / (float)(SEQL - 1);
        const float wang = 6.283185307179586f * (float)pos / (float)SEQL;
        float zf = 0.f;
        if (lane == 0) zf = tt;
        else if (lane < 33) { const int bi = (lane - 1) & 15; const float band = 1e-4f + (float)bi * ((15.f - 1e-4f) / 15.f); const float ang = wang * band;
            zf = lane <= 16 ? __cosf(ang) : -__sinf(ang); }
        float acc = 0.f;
#pragma unroll
        for (int i = 0; i < 16; ++i) { acc += __shfl(zf, 2 * i) * bflo(wi[i]); acc += __shfl(zf, 2 * i + 1) * bfhi(wi[i]); }
        acc += __shfl(zf, 32) * bflo(wi[16]);
        float h = __sinf(f0 * (acc + b0));
        float a2 = 0.f;
#pragma unroll
        for (int i = 0; i < FHID / 2; ++i) { a2 += __shfl(h, 2 * i) * bflo(wm[0][i]); a2 += __shfl(h, 2 * i + 1) * bfhi(wm[0][i]); }
        h = __sinf(f1 * (a2 + b1));
        a2 = 0.f;
#pragma unroll
        for (int i = 0; i < FHID / 2; ++i) { a2 += __shfl(h, 2 * i) * bflo(wm[1][i]); a2 += __shfl(h, 2 * i + 1) * bfhi(wm[1][i]); }
        h = __sinf(f2 * (a2 + b2));
        h3[((size_t)l * SEQL + pos) * FHID + lane] = f2bf(h);
    }
}

constexpr int G_BM = 256, G_BN = 128, G_BK = 32;
constexpr int G_ABYTES = G_BM * G_BK * 2, G_BBYTES = G_BN * G_BK * 2, G_STAGE = G_ABYTES + G_BBYTES;
constexpr int G_LDS = 2 * G_STAGE;
DV void gemm_stage(const bf16_t* A, int lda, const bf16_t* Bt, int ldb, int kt, unsigned char* sbuf) {
    const int tid = tid_();
#pragma unroll
    for (int i = 0; i < 2; ++i) { const int b = tid * 16 + i * 8192, r = b >> 6, c = (b & 63) >> 1;
        glds16(A + (size_t)r * lda + kt * G_BK + c, sbuf + b); }
    { const int b = tid * 16, r = b >> 6, c = (b & 63) >> 1;
        glds16(Bt + (size_t)r * ldb + kt * G_BK + c, sbuf + G_ABYTES + b); }
}
DV void gemm_kloop(f32x4 (&acc)[4][4], const bf16_t* A, int lda, const bf16_t* Bt, int ldb, int nk, unsigned char* smem) {
    const int lane = tid_() & 63, wid = wave_(), wr = wid >> 1, wc = wid & 1, fr = lane & 15, fq = lane >> 4;
    __syncthreads();
    gemm_stage(A, lda, Bt, ldb, 0, smem);
#pragma unroll 1
    for (int t = 0; t < nk; ++t) {
        unsigned char* cur = smem + (t & 1) * G_STAGE;
        asm volatile("s_waitcnt vmcnt(0)" ::: "memory");
        __syncthreads();
        if (t + 1 < nk) gemm_stage(A, lda, Bt, ldb, t + 1, smem + ((t + 1) & 1) * G_STAGE);
        bf16x8 a[4], b[4];
#pragma unroll
        for (int m = 0; m < 4; ++m) a[m] = *(const bf16x8*)(cur + (wr * 64 + m * 16 + fr) * 64 + fq * 16);
#pragma unroll
        for (int n = 0; n < 4; ++n) b[n] = *(const bf16x8*)(cur + G_ABYTES + (wc * 64 + n * 16 + fr) * 64 + fq * 16);
#pragma unroll
        for (int m = 0; m < 4; ++m)
#pragma unroll
            for (int n = 0; n < 4; ++n) acc[m][n] = __builtin_amdgcn_mfma_f32_16x16x32_bf16(b[n], a[m], acc[m][n], 0, 0, 0);
    }
}
DV void acc_zero(f32x4 (&acc)[4][4]) {
#pragma unroll
    for (int m = 0; m < 4; ++m)
#pragma unroll
        for (int n = 0; n < 4; ++n) acc[m][n] = (f32x4){0.f, 0.f, 0.f, 0.f};
}
struct TileCoord { int row0, col0, wr, wc, fr, fq; };
DV TileCoord tile_coord(int pm, int pn) {
    const int lane = tid_() & 63, wid = wave_();
    TileCoord c; c.row0 = pm * G_BM; c.col0 = pn * G_BN; c.wr = wid >> 1; c.wc = wid & 1; c.fr = lane & 15; c.fq = lane >> 4; return c;
}
DV void epi_store_bf16(const f32x4 (&acc)[4][4], const TileCoord& c, bf16_t* O, int ldo, int ocol0, const float* bias  ) {
#pragma unroll
    for (int n = 0; n < 4; ++n) {
        const int cl = c.wc * 64 + n * 16 + c.fq * 4;
        f32x4 bv = (f32x4){0.f, 0.f, 0.f, 0.f};
        if (bias) bv = *(const f32x4*)(bias + cl);
#pragma unroll
        for (int m = 0; m < 4; ++m) {
            const int row = c.row0 + c.wr * 64 + m * 16 + c.fr;
            const f32x4 v = acc[m][n] + bv;
            u32x2 o; o.x = pk2(v.x, v.y); o.y = pk2(v.z, v.w);
            *(u32x2*)(O + (size_t)row * ldo + ocol0 + cl) = o;
        }
    }
}

DV void filt_tile(KParams p, int l, int tile, unsigned char* smem) {
    const int pm = tile >> 7, pn = tile & 127;
    const TileCoord c = tile_coord(pm, pn);
    const bf16_t* A = (const bf16_t*)(p->ws + WS_WOT) + (size_t)l * 2048 * FHID;
    const bf16_t* Bt = (const bf16_t*)(p->ws + WS_H3) + (size_t)l * SEQL * FHID;
    f32x4 acc[4][4]; acc_zero(acc);
    gemm_kloop(acc, A + (size_t)c.row0 * FHID, FHID, Bt + (size_t)c.col0 * FHID, FHID, FHID / G_BK, smem);
    epi_store_bf16(acc, c, (bf16_t*)(p->ws + WS_FILT), SEQL, c.col0, nullptr);
}
DV void ln_job(const float* gq, const float* bq, const bf16_t* src, bf16_t* dstb, float* dstf, int bid, int nblk, unsigned char* dst8 = nullptr) {
    const int lane = tid_() & 63, wv = wave_();
    const size_t step = (size_t)nblk * 8;
    f32x4 gg[4], bb[4];
#pragma unroll
    for (int i = 0; i < 4; ++i) { gg[i] = *(const f32x4*)(gq + lane * 16 + 4 * i); bb[i] = *(const f32x4*)(bq + lane * 16 + 4 * i); }
#pragma unroll 1
    for (size_t row0 = (size_t)bid * 8 + wv; row0 < (size_t)T; row0 += 2 * step) {
        const bool two = row0 + step < (size_t)T; const size_t row1 = two ? row0 + step : row0;
        u32x4 raw[2][2];
        raw[0][0] = ldg16(src + row0 * D + lane * 16); raw[0][1] = ldg16(src + row0 * D + lane * 16 + 8);
        raw[1][0] = ldg16(src + row1 * D + lane * 16); raw[1][1] = ldg16(src + row1 * D + lane * 16 + 8);
#pragma unroll
        for (int k = 0; k < 2; ++k) {
            if (k == 1 && !two) break;
            const size_t row = k ? row1 : row0;
            float v[16];
#pragma unroll
            for (int h = 0; h < 2; ++h) { const u32x4 w = raw[k][h];
                v[8 * h + 0] = bflo(w.x); v[8 * h + 1] = bfhi(w.x); v[8 * h + 2] = bflo(w.y); v[8 * h + 3] = bfhi(w.y); v[8 * h + 4] = bflo(w.z); v[8 * h + 5] = bfhi(w.z); v[8 * h + 6] = bflo(w.w); v[8 * h + 7] = bfhi(w.w); }
            float sm = 0.f;
#pragma unroll
            for (int i = 0; i < 16; ++i) sm += v[i];
            const float mean = wave_sum(sm) * (1.f / D); float s2 = 0.f;
#pragma unroll
            for (int i = 0; i < 16; ++i) { v[i] -= mean; s2 += v[i] * v[i]; }
            const float rstd = rsqrtf(wave_sum(s2) * (1.f / D) + LN_EPS);
#pragma unroll
            for (int i = 0; i < 16; ++i) v[i] = v[i] * rstd * gg[i >> 2][i & 3] + bb[i >> 2][i & 3];
            if (dstb) { u32x4 o0, o1; o0.x = pk2(v[0], v[1]); o0.y = pk2(v[2], v[3]); o0.z = pk2(v[4], v[5]); o0.w = pk2(v[6], v[7]);
                o1.x = pk2(v[8], v[9]); o1.y = pk2(v[10], v[11]); o1.z = pk2(v[12], v[13]); o1.w = pk2(v[14], v[15]);
                stg16(dstb + row * D + lane * 16, o0); stg16(dstb + row * D + lane * 16 + 8, o1);
                if (dst8) {
                    int hw[4];
#pragma unroll
                    for (int i = 0; i < 4; ++i) { int h = 0; h = __builtin_amdgcn_cvt_pk_fp8_f32(v[4 * i], v[4 * i + 1], h, false); h = __builtin_amdgcn_cvt_pk_fp8_f32(v[4 * i + 2], v[4 * i + 3], h, true); hw[i] = h; }
                    stg16(dst8 + row * D + lane * 16, (u32x4){(unsigned)hw[0], (unsigned)hw[1], (unsigned)hw[2], (unsigned)hw[3]}); } }
            else {
#pragma unroll
                for (int i = 0; i < 4; ++i) *(f32x4*)(dstf + row * D + lane * 16 + 4 * i) = (f32x4){v[4 * i], v[4 * i + 1], v[4 * i + 2], v[4 * i + 3]}; }
        }
    }
}
DV void ln1_job(KParams p, int l, int bid, int nblk) { ln_job(p->in[19] + (size_t)l * D, p->in[20] + (size_t)l * D, (const bf16_t*)p->out, (bf16_t*)(p->ws + WS_XB), nullptr, bid, nblk, p->ws + WS_X8); }
namespace pg8 {
constexpr int BM = 256, BK = 64, HALF = 128, HTB = HALF * BK * 2  , STAGE_BYTES = 8 * HTB, NXCD = 8, WGM = 8;
DV int lds_byte(int r, int c) { const int st = (r >> 4) * 2 + (c >> 5), rr = r & 15, cc = c & 31, ob = rr * 64 + cc * 2; return st * 1024 + (ob ^ (((ob >> 9) & 1) << 5)); }
DV void stage_rc(int b, int& R, int& C) { const int st = b / 1024, sb = b % 1024, swz = sb ^ (((sb >> 9) & 1) << 5); R = (st >> 1) * 16 + swz / 64; C = (st & 1) * 32 + (swz % 64) / 2; }
DV int perm32(int rho) { const int n = rho >> 4, i = rho & 15; return 8 * (i >> 2) + 4 * n + (i & 3); }
struct UnitX { const char* A; const char* B; unsigned lda2, ldb2; int nt, tag, pm, pn; };
DV bool static_tile(int nM, int nN, int G, int c, int i, int& pm, int& pn) {
    const int nwg = nM * nN; const long L = (long)i * G + c; if (L >= nwg) return false;
    int wgid = (int)L; { const int q = nwg / NXCD, r = nwg % NXCD, xcd = wgid % NXCD, off = wgid / NXCD; wgid = (xcd < r ? xcd * (q + 1) : r * (q + 1) + (xcd - r) * q) + off; }
    const int nig = WGM * nN, gid = wgid / nig, fm = gid * WGM, gsz = (nM - fm) < WGM ? (nM - fm) : WGM;
    pm = fm + ((wgid % nig) % gsz); pn = (wgid % nig) / gsz; return true;
}
template <class Epi, class Sched>
DV void gemm_stream(LAS unsigned char* lds, const Sched& S, Epi& E) {
    const int tid = tid_(), wid = __builtin_amdgcn_readfirstlane(tid >> 6), lane = tid & 63, wr = wid >> 2, wc = wid & 3, fr = lane & 15, fq = lane >> 4;
    unsigned rA[2], rB[2], c2[2];
#pragma unroll
    for (int i = 0; i < 2; ++i) { int R, C; stage_rc(tid * 16 + i * 8192, R, C); rA[i] = (unsigned)R; rB[i] = (unsigned)(Epi::PERM ? ((R & ~31) + perm32(R & 31)) : R); c2[i] = (unsigned)C * 2u; }
    const size_t kstep = (size_t)(BK * 2);
    const unsigned ldsw = (unsigned)wid * 1024u;
    const int aoff = lds_byte(wr * 64 + fr, fq * 8), boff = lds_byte(wc * 32 + fr, fq * 8);
#define PG8_SA(b, h) (((b) * 2 + (h)) * HTB)
#define PG8_SB(b, h) ((4 + (b) * 2 + (h)) * HTB)
#define PG8_STAGE(bufoff, gbase, voff) do { _Pragma("unroll") for (int _i = 0; _i < 2; ++_i) \
        __builtin_amdgcn_global_load_lds((const GAS unsigned*)((const char*)(gbase) + (voff)[_i]), (LAS unsigned*)(lds + (bufoff) + ldsw + _i * 8192), 16, 0, 0); } while (0)
#define PG8_LDA(dst, b, h) do { _Pragma("unroll") for (int m = 0; m < 4; ++m) _Pragma("unroll") for (int k = 0; k < 2; ++k) dst[m][k] = *(const LAS bf16x8*)(lds + PG8_SA(b, h) + aoff + m * 2048 + k * 1024); } while (0)
#define PG8_LDB(dst, b, h) do { _Pragma("unroll") for (int n = 0; n < 2; ++n) _Pragma("unroll") for (int k = 0; k < 2; ++k) dst[n][k] = *(const LAS bf16x8*)(lds + PG8_SB(b, h) + boff + n * 2048 + k * 1024); } while (0)
#define PG8_MMA(ai, bj, At, Bt) do { __builtin_amdgcn_s_setprio(1); _Pragma("unroll") for (int m = 0; m < 4; ++m) _Pragma("unroll") for (int n = 0; n < 2; ++n) _Pragma("unroll") for (int k = 0; k < 2; ++k) \
        acc[ai][bj][m][n] = __builtin_amdgcn_mfma_f32_16x16x32_bf16(Bt[n][k], At[m][k], acc[ai][bj][m][n], 0, 0, 0); __builtin_amdgcn_s_setprio(0); } while (0)
#define PG8_WAIT_V(n) asm volatile("s_waitcnt vmcnt(" #n ")" ::: "memory")
#define PG8_WAIT_L(n) asm volatile("s_waitcnt lgkmcnt(" #n ")" ::: "memory")
#define PG8_BAR __builtin_amdgcn_s_barrier()
#define PG8_SCHED __builtin_amdgcn_sched_barrier(0)
    UnitX cur, nxt; int ui = 0;
    if (!S.next(0, cur)) return;
    f32x4 acc[2][2][4][2];
#pragma unroll
    for (int a = 0; a < 2; ++a)
#pragma unroll
        for (int b = 0; b < 2; ++b)
#pragma unroll
            for (int m = 0; m < 4; ++m)
#pragma unroll
                for (int n = 0; n < 2; ++n) acc[a][b][m][n] = (f32x4){0.f, 0.f, 0.f, 0.f};
    bf16x8 At[4][2], B0[2][2], B1[2][2];
    const char* cA = cur.A; const char* cB = cur.B;
    unsigned clda = cur.lda2, cldb = cur.ldb2;
    {
        unsigned vA[2], vB[2];
#pragma unroll
        for (int i = 0; i < 2; ++i) { vA[i] = rA[i] * clda + c2[i]; vB[i] = rB[i] * cldb + c2[i]; }
        const size_t hA = (size_t)HALF * clda, hB = (size_t)HALF * cldb;
        PG8_STAGE(PG8_SB(0, 0), cB, vB); PG8_STAGE(PG8_SA(0, 0), cA, vA); PG8_STAGE(PG8_SB(0, 1), cB + hB, vB); PG8_STAGE(PG8_SA(0, 1), cA + hA, vA);
        if (wr == 1) PG8_BAR;
        PG8_WAIT_V(4); PG8_BAR;
        PG8_STAGE(PG8_SB(1, 0), cB + kstep, vB); PG8_STAGE(PG8_SA(1, 0), cA + kstep, vA); PG8_STAGE(PG8_SB(1, 1), cB + hB + kstep, vB);
        PG8_WAIT_V(6); PG8_BAR;
    }
    for (;;) {
        const bool has_next = S.next(ui + 1, nxt);
        const char* nA = has_next ? nxt.A : cA; const char* nB = has_next ? nxt.B : cB;
        const unsigned nlda = has_next ? nxt.lda2 : clda, nldb = has_next ? nxt.ldb2 : cldb;
        const int nt = cur.nt;
#pragma unroll 1
        for (int t = 0; t < nt; t += 2) {
            const bool last = (t == nt - 2);
            const char* a1 = cA + (size_t)(t + 1) * kstep;
            const char* a2 = last ? nA : cA + (size_t)(t + 2) * kstep; const char* b2 = last ? nB : cB + (size_t)(t + 2) * kstep;
            const char* a3 = a2 + kstep; const char* b3 = b2 + kstep;
            const unsigned xlda = last ? nlda : clda, xldb = last ? nldb : cldb;
            unsigned vA[2], xA[2], xB[2];
#pragma unroll
            for (int i = 0; i < 2; ++i) { vA[i] = rA[i] * clda + c2[i]; xA[i] = rA[i] * xlda + c2[i]; xB[i] = rB[i] * xldb + c2[i]; }
            const size_t hA = (size_t)HALF * clda, xhA = (size_t)HALF * xlda, xhB = (size_t)HALF * xldb;
            PG8_LDB(B0, 0, 0); PG8_SCHED; PG8_LDA(At, 0, 0); PG8_STAGE(PG8_SA(1, 1), a1 + hA, vA);
            PG8_WAIT_L(8); PG8_BAR; PG8_WAIT_L(0); PG8_MMA(0, 0, At, B0); PG8_BAR; PG8_SCHED;
            PG8_LDB(B1, 0, 1); PG8_STAGE(PG8_SB(0, 0), b2, xB);
            PG8_BAR; PG8_WAIT_L(0); PG8_MMA(0, 1, At, B1); PG8_BAR;
            PG8_LDA(At, 0, 1); PG8_STAGE(PG8_SA(0, 0), a2, xA);
            PG8_BAR; PG8_WAIT_L(0); PG8_MMA(1, 0, At, B0); PG8_BAR; PG8_SCHED;
            PG8_STAGE(PG8_SB(0, 1), b2 + xhB, xB);
            PG8_WAIT_V(6); PG8_BAR; PG8_MMA(1, 1, At, B1); PG8_BAR;
            PG8_LDB(B0, 1, 0); PG8_SCHED; PG8_LDA(At, 1, 0); PG8_STAGE(PG8_SA(0, 1), a2 + xhA, xA);
            PG8_WAIT_L(8); PG8_BAR; PG8_WAIT_L(0); PG8_MMA(0, 0, At, B0); PG8_BAR; PG8_SCHED;
            PG8_LDB(B1, 1, 1); PG8_STAGE(PG8_SB(1, 0), b3, xB);
            PG8_BAR; PG8_WAIT_L(0); PG8_MMA(0, 1, At, B1); PG8_BAR;
            PG8_LDA(At, 1, 1); PG8_STAGE(PG8_SA(1, 0), a3, xA);
            PG8_BAR; PG8_WAIT_L(0); PG8_MMA(1, 0, At, B0); PG8_BAR; PG8_SCHED;
            PG8_STAGE(PG8_SB(1, 1), b3 + xhB, xB);
            PG8_WAIT_V(6); PG8_BAR; PG8_MMA(1, 1, At, B1); PG8_BAR;
        }
        E(acc, cur, wr, wc, fr, fq);
        if (!has_next) break;
#pragma unroll
        for (int a = 0; a < 2; ++a)
#pragma unroll
            for (int b = 0; b < 2; ++b)
#pragma unroll
                for (int m = 0; m < 4; ++m)
#pragma unroll
                    for (int n = 0; n < 2; ++n) acc[a][b][m][n] = (f32x4){0.f, 0.f, 0.f, 0.f};
        cur = nxt; cA = nA; cB = nB; clda = nlda; cldb = nldb; ++ui;
    }
    PG8_WAIT_V(0);
    if (wr == 0) PG8_BAR;
    PG8_BAR;
#undef PG8_SA
#undef PG8_SB
#undef PG8_STAGE
#undef PG8_LDA
#undef PG8_LDB
#undef PG8_MMA
#undef PG8_WAIT_V
#undef PG8_WAIT_L
#undef PG8_BAR
#undef PG8_SCHED
}
}
DV void pg8_store_bf16_perm(const f32x4 (&acc)[2][2][4][2], bf16_t* O  , int ldo, const float* bias  , int wr, int wc, int fr, int fq) {
    const int col0 = wc * 32 + 8 * fq;
    f32x4 bv[2][2];
#pragma unroll
    for (int bj = 0; bj < 2; ++bj)
#pragma unroll
        for (int n = 0; n < 2; ++n) bv[bj][n] = bias ? *(const f32x4*)(bias + col0 + bj * 128 + 4 * n) : (f32x4){0.f, 0.f, 0.f, 0.f};
#pragma unroll
    for (int ai = 0; ai < 2; ++ai)
#pragma unroll
        for (int m = 0; m < 4; ++m) { bf16_t* rowp = O + (size_t)(ai * 128 + wr * 64 + m * 16 + fr) * ldo + col0;
#pragma unroll
            for (int bj = 0; bj < 2; ++bj) { const f32x4 v0 = acc[ai][bj][m][0] + bv[bj][0], v1 = acc[ai][bj][m][1] + bv[bj][1];
                u32x4 w; w.x = pk2(v0.x, v0.y); w.y = pk2(v0.z, v0.w); w.z = pk2(v1.x, v1.y); w.w = pk2(v1.z, v1.w);
                *(u32x4*)(rowp + bj * 128) = w; } }
}
struct EpiG1 { static constexpr bool PERM = true; KParams p; int l;
    DV void operator()(const f32x4 (&acc)[2][2][4][2], const pg8::UnitX& u, int wr, int wc, int fr, int fq) const {
        bf16_t* O; int ldo, oc; const float* bias = nullptr;
        const int upm = opaque_s(u.pm), upn = opaque_s(u.pn);
        if (u.tag == 0) {
            const int col0 = upn * 256; bias = p->in[6] + (size_t)l * IN_WIDTH + col0;
            if (upn < 3) { O = (bf16_t*)(p->ws + WS_QKV); ldo = 768; oc = col0; }
            else if (upn < 9) { O = (bf16_t*)(p->ws + WS_HY); ldo = HY3; oc = col0 - O_HY; }
            else { O = (bf16_t*)((unsigned char*)p->out + DO_QM); ldo = 512; oc = col0 - O_MQ; }
        } else { O = (bf16_t*)(p->ws + WS_KVMEM) + (size_t)(u.tag - 1) * 768 * D; ldo = D; oc = upn * 256; }
        pg8_store_bf16_perm(acc, O + (size_t)upm * 256 * ldo + oc, ldo, bias, wr, wc, fr, fq);
    }
};
struct SchedG1 { KParams p; int l, G, c;
    DV bool next(int i, pg8::UnitX& u) const {
        int pm, pn;
        if (pg8::static_tile(T / 256, O_GATE / 256, G, c, i, pm, pn)) {
            u.A = (const char*)(p->ws + WS_XB) + (size_t)pm * 256 * 2048; u.B = (const char*)(p->ws + WS_W + l * SZ_WL + OFF_WT_IN) + (size_t)pn * 256 * 2048;
            u.lda2 = 2048; u.ldb2 = 2048; u.nt = 16; u.tag = 0; u.pm = pm; u.pn = pn; return true; }
        if (l != 0) return false;
        const int n1 = (T / 256) * (O_GATE / 256), cnt = (n1 - c + G - 1) / G, j = i - cnt, c2 = (c + G - 64) % G, idx = j * G + c2;
        if (idx >= 24) return false;
        const int ll = idx / 12, r = idx - ll * 12; pm = r >> 2; pn = r & 3;
        u.A = (const char*)(p->ws + WS_MEMB) + (size_t)pm * 256 * 2048; u.B = (const char*)(p->ws + WS_W + ll * SZ_WL + OFF_WT_MKV) + (size_t)pn * 256 * 2048;
        u.lda2 = 2048; u.ldb2 = 2048; u.nt = 16; u.tag = 1 + ll; u.pm = pm; u.pn = pn; return true;
    }
};
struct EpiOut { static constexpr bool PERM = true; KParams p;
    DV void operator()(const f32x4 (&acc)[2][2][4][2], const pg8::UnitX& u, int wr, int wc, int fr, int fq) const {
        const bf16_t* xb = (const bf16_t*)(p->ws + WS_XB); bf16_t* o = (bf16_t*)p->out;
        const int upm = opaque_s(u.pm), upn = opaque_s(u.pn);
        const size_t base = ((size_t)upm * 256 + wr * 64 + fr) * D + upn * 256 + wc * 32 + 8 * fq;
#pragma unroll
        for (int ai = 0; ai < 2; ++ai) {
            u32x4 xv[4][2];
#pragma unroll
            for (int m = 0; m < 4; ++m)
#pragma unroll
                for (int bj = 0; bj < 2; ++bj) xv[m][bj] = ldg16(xb + base + (size_t)(ai * 128 + m * 16) * D + bj * 128);
#pragma unroll
            for (int m = 0; m < 4; ++m)
#pragma unroll
                for (int bj = 0; bj < 2; ++bj) { const u32x4 x = xv[m][bj]; const f32x4 a0 = acc[ai][bj][m][0], a1 = acc[ai][bj][m][1];
                    u32x4 w; w.x = pk2(a0.x + ALPHA * bflo(x.x), a0.y + ALPHA * bfhi(x.x)); w.y = pk2(a0.z + ALPHA * bflo(x.y), a0.w + ALPHA * bfhi(x.y));
                    w.z = pk2(a1.x + ALPHA * bflo(x.z), a1.y + ALPHA * bfhi(x.z)); w.w = pk2(a1.z + ALPHA * bflo(x.w), a1.w + ALPHA * bfhi(x.w));
                    stg16(o + base + (size_t)(ai * 128 + m * 16) * D + bj * 128, w); }
            asm volatile("" ::: "memory"); }
    }
};
struct SchedOut { KParams p; int l, G, c;
    DV bool next(int i, pg8::UnitX& u) const {
        int pm, pn; if (!pg8::static_tile(T / 256, D / 256, G, c, i, pm, pn)) return false;
        u.A = (const char*)(p->ws + WS_HY) + (size_t)T * 512 * 2 + (size_t)pm * 256 * 2048; u.B = (const char*)(p->ws + WS_W + l * SZ_WL + OFF_WT_OUT) + (size_t)pn * 256 * 2048;
        u.lda2 = 2048; u.ldb2 = 2048; u.nt = 16; u.tag = 0; u.pm = pm; u.pn = pn; return true; }
};
struct EpiQ { static constexpr bool PERM = true; KParams p;
    DV void operator()(const f32x4 (&acc)[2][2][4][2], const pg8::UnitX& u, int wr, int wc, int fr, int fq) const {
        pg8_store_bf16_perm(acc, (bf16_t*)p->out + (size_t)opaque_s(u.pm) * 256 * 2048 + opaque_s(u.pn) * 256, 2048, nullptr, wr, wc, fr, fq); }
};
struct SchedQ { KParams p; int l, G, c;
    DV bool next(int i, pg8::UnitX& u) const {
        int pm, pn; if (!pg8::static_tile(T / 256, 2048 / 256, G, c, i, pm, pn)) return false;
        u.A = (const char*)(p->ws + WS_XB) + (size_t)pm * 256 * 2048; u.B = (const char*)(p->ws + WS_W + l * SZ_WL + OFF_WT_Q) + (size_t)pn * 256 * 2048;
        u.lda2 = 2048; u.ldb2 = 2048; u.nt = 16; u.tag = 0; u.pm = pm; u.pn = pn; return true; }
};
struct EpiMerge { static constexpr bool PERM = true; KParams p; int l;
    DV void operator()(const f32x4 (&acc)[2][2][4][2], const pg8::UnitX& u, int wr, int wc, int fr, int fq) const {
        const int n = u.tag >> 1, col0 = wc * 32 + 8 * fq, upm = opaque_s(u.pm), upn = opaque_s(u.pn);
        u32x4* sp = (u32x4*)((unsigned char*)p->out) + (size_t)blockIdx.x * 16 * NTH + threadIdx.x;
        if ((u.tag & 1) == 0) {
            const float* bias = p->in[6] + (size_t)l * IN_WIDTH + O_GATE + n * D + upn * 256 + col0;
            f32x4 bv[2][2];
#pragma unroll
            for (int bj = 0; bj < 2; ++bj)
#pragma unroll
                for (int nn = 0; nn < 2; ++nn) bv[bj][nn] = *(const f32x4*)(bias + bj * 128 + 4 * nn);
#pragma unroll
            for (int ai = 0; ai < 2; ++ai)
#pragma unroll
                for (int m = 0; m < 4; ++m) {
#pragma unroll
                    for (int bj = 0; bj < 2; ++bj) { const f32x4 v0 = acc[ai][bj][m][0] + bv[bj][0], v1 = acc[ai][bj][m][1] + bv[bj][1];
                        u32x4 w;
                        w.x = pk2(__builtin_amdgcn_rcpf(1.f + __expf(-v0.x)), __builtin_amdgcn_rcpf(1.f + __expf(-v0.y))); w.y = pk2(__builtin_amdgcn_rcpf(1.f + __expf(-v0.z)), __builtin_amdgcn_rcpf(1.f + __expf(-v0.w)));
                        w.z = pk2(__builtin_amdgcn_rcpf(1.f + __expf(-v1.x)), __builtin_amdgcn_rcpf(1.f + __expf(-v1.y))); w.w = pk2(__builtin_amdgcn_rcpf(1.f + __expf(-v1.z)), __builtin_amdgcn_rcpf(1.f + __expf(-v1.w)));
                        sp[bj * NTH] = w; }
                    sp += 2 * NTH; asm volatile("" : "+v"(sp)); }
        } else {
            bf16_t* rowp = (bf16_t*)(p->ws + WS_HY) + (size_t)T * 512 + ((size_t)upm * 256 + wr * 64 + fr) * D + upn * 256 + col0;
#pragma unroll
            for (int ai = 0; ai < 2; ++ai) {
                u32x4 g[4][2], o[4][2];
#pragma unroll
                for (int m = 0; m < 4; ++m)
#pragma unroll
                    for (int bj = 0; bj < 2; ++bj) { g[m][bj] = sp[(m * 2 + bj) * NTH]; if (n > 0) o[m][bj] = *(const u32x4*)(rowp + (size_t)m * 16 * D + bj * 128); }
#pragma unroll
                for (int m = 0; m < 4; ++m)
#pragma unroll
                    for (int bj = 0; bj < 2; ++bj) { const f32x4 a0 = acc[ai][bj][m][0], a1 = acc[ai][bj][m][1]; const u32x4 gg = g[m][bj];
                        float r[8] = {bflo(gg.x) * a0.x, bfhi(gg.x) * a0.y, bflo(gg.y) * a0.z, bfhi(gg.y) * a0.w, bflo(gg.z) * a1.x, bfhi(gg.z) * a1.y, bflo(gg.w) * a1.z, bfhi(gg.w) * a1.w};
                        if (n > 0) { const u32x4 oo = o[m][bj];
                            r[0] += bflo(oo.x); r[1] += bfhi(oo.x); r[2] += bflo(oo.y); r[3] += bfhi(oo.y); r[4] += bflo(oo.z); r[5] += bfhi(oo.z); r[6] += bflo(oo.w); r[7] += bfhi(oo.w); }
                        u32x4 w; w.x = pk2(r[0], r[1]); w.y = pk2(r[2], r[3]); w.z = pk2(r[4], r[5]); w.w = pk2(r[6], r[7]);
                        *(u32x4*)(rowp + (size_t)m * 16 * D + bj * 128) = w; }
                sp += 8 * NTH; rowp += 128 * D; asm volatile("" : "+v"(sp), "+v"(rowp)); }
        }
    }
};
struct SchedMerge { KParams p; int l, G, c;
    DV bool next(int i, pg8::UnitX& u) const {
        const int ti = i / 6, sub = i - ti * 6, n = sub >> 1;
        int pm, pn; if (!pg8::static_tile(T / 256, D / 256, G, c, ti, pm, pn)) return false;
        u.tag = sub; u.pm = pm; u.pn = pn;
        if ((sub & 1) == 0) {
            u.A = (const char*)(p->ws + WS_XB) + (size_t)pm * 256 * 2048; u.B = (const char*)(p->ws + WS_W + l * SZ_WL + OFF_WT_IN) + (size_t)(O_GATE + n * D + pn * 256) * 2048;
            u.lda2 = 2048; u.ldb2 = 2048; u.nt = 16;
        } else {
            if (n == 0) { u.A = (const char*)(p->ws + WS_QKV) + (size_t)pm * 256 * 1536; u.lda2 = 1536; }
            else if (n == 1) { u.A = (const char*)(p->ws + WS_HY) + (size_t)pm * 256 * 1024; u.lda2 = 1024; }
            else { u.A = (const char*)p->out + DO_QM + (size_t)pm * 256 * 1024; u.lda2 = 1024; }
            u.B = (const char*)(p->ws + WS_W + l * SZ_WL + OFF_WT_BR) + (size_t)(n * D + pn * 256) * 1024; u.ldb2 = 1024; u.nt = 8;
        }
        return true; }
};
DV void shortconv_item(KParams p, int l, int item, float* s  ) {
    const int tid = tid_();
    const int ct = item % 24, r = item / 24, tt = r % 64, seq = r / 64;
    const int t0 = tt * 256, c0 = ct * 64;
    const bf16_t* hy = (const bf16_t*)(p->ws + WS_HY);
    bf16_t* uct = (bf16_t*)((unsigned char*)p->out + DO_UCT);
    u32x4 v[5];
#pragma unroll
    for (int i = 0; i < 5; ++i) {
        const int idx = tid + i * NTH, rr = idx >> 3, ch = idx & 7, t = t0 + rr - 1;
        v[i] = (u32x4){0u, 0u, 0u, 0u};
        if (idx < 258 * 8 && t >= 0 && t < SEQL) v[i] = ldg16(hy + ((size_t)seq * SEQL + t) * HY3 + c0 + ch * 8);
    }
    __syncthreads();
#pragma unroll
    for (int i = 0; i < 5; ++i) {
        const int idx = tid + i * NTH, rr = idx >> 3, ch = idx & 7;
        if (idx < 258 * 8) { float* d = s + rr * 65 + ch * 8;
            d[0] = bflo(v[i].x); d[1] = bfhi(v[i].x); d[2] = bflo(v[i].y); d[3] = bfhi(v[i].y); d[4] = bflo(v[i].z); d[5] = bfhi(v[i].z); d[6] = bflo(v[i].w); d[7] = bfhi(v[i].w); }
    }
    __syncthreads();
    const int ch = tid >> 3, tq = tid & 7, cg = c0 + ch;
    const float* cw = p->in[7] + (size_t)l * 3 * HY3; const float cb = p->in[8][(size_t)l * HY3 + cg];
    const float w0 = cw[cg], w1 = cw[HY3 + cg], w2 = cw[2 * HY3 + cg];
#pragma unroll
    for (int grp = 0; grp < 4; ++grp) {
        float o[8];
#pragma unroll
        for (int e = 0; e < 8; ++e) { const int rr = grp * 64 + tq * 8 + e; o[e] = cb + w0 * s[rr * 65 + ch] + w1 * s[(rr + 1) * 65 + ch] + w2 * s[(rr + 2) * 65 + ch]; }
        u32x4 ov; ov.x = pk2(o[0], o[1]); ov.y = pk2(o[2], o[3]); ov.z = pk2(o[4], o[5]); ov.w = pk2(o[6], o[7]);
        stg16(uct + ((size_t)seq * HY3 + cg) * SEQL + t0 + grp * 64 + tq * 8, ov);
    }
}
DV void hyo_transpose_item(KParams p, int item, bf16_t* s  ) {
    const int tid = tid_();
    const int ct = item % 8, r = item / 8, tt = r % 64, seq = r / 64;
    const int t0 = tt * 256, c0 = ct * 64;
    const bf16_t* uct = (const bf16_t*)((unsigned char*)p->out + DO_UCT);
    bf16_t* hyo = (bf16_t*)(p->ws + WS_HY);
    u32x4 v[4];
    { const int ch = tid >> 3, tq = tid & 7;
#pragma unroll
      for (int grp = 0; grp < 4; ++grp) v[grp] = ldg16(uct + ((size_t)seq * HY3 + c0 + ch) * SEQL + t0 + grp * 64 + tq * 8);
      __syncthreads();
#pragma unroll
      for (int grp = 0; grp < 4; ++grp) *(u32x4*)(s + ch * 264 + grp * 64 + tq * 8) = v[grp]; }
    __syncthreads();
#pragma unroll
    for (int i4 = 0; i4 < 4; ++i4) { const int idx = tid + i4 * NTH, t = idx >> 3, cq = idx & 7;
      bf16_t e[8];
#pragma unroll
      for (int i = 0; i < 8; ++i) e[i] = s[(cq * 8 + i) * 264 + t];
      u32x4 o; o.x = e[0] | ((unsigned)e[1] << 16); o.y = e[2] | ((unsigned)e[3] << 16); o.z = e[4] | ((unsigned)e[5] << 16); o.w = e[6] | ((unsigned)e[7] << 16);
      stg16(hyo + ((size_t)seq * SEQL + t0 + t) * 512 + c0 + cq * 8, o); }
}

template <bool WIN> struct AttnCfg {
    static constexpr int HDIM = WIN ? 64 : 128, NK = WIN ? 384 : 256, QT = WIN ? 4 : 2, KS = HDIM / 32, DT = HDIM / 16;
    static constexpr int KSTR = HDIM + 8, VSTR = NK + 8;
    static constexpr int K_BYTES = NK * KSTR * 2, V_BYTES = HDIM * VSTR * 2;
};
template <bool WIN> DV void attn_item(KParams p, int l, int item, unsigned char* smem) {
    typedef AttnCfg<WIN> C;
    const int tid = tid_(), lane = tid & 63, w = wave_(), fr = lane & 15, fq = lane >> 4;
    bf16_t* Ks = (bf16_t*)smem; bf16_t* Vt = (bf16_t*)(smem + C::K_BYTES); float* biasT = (float*)(smem + C::K_BYTES + C::V_BYTES);
    int seq, blk, hh;
    if (WIN) { hh = item & 1; blk = (item >> 1) & 127; seq = item >> 8; }
    else { hh = item & 3; blk = (item >> 2) % 64; seq = (item >> 2) / 64; }
    __syncthreads();
    if (WIN) {
        const bf16_t* qkv = (const bf16_t*)(p->ws + WS_QKV);
#pragma unroll
        for (int i = 0; i < 6; ++i) {
            const int idx = tid + i * NTH, key = idx >> 3, ch = idx & 7, pos = blk * 128 - 128 + key;
            u32x4 kv = (u32x4){0u, 0u, 0u, 0u}, vv = kv;
            if (pos >= 0 && pos < SEQL) { const bf16_t* row = qkv + ((size_t)seq * SEQL + pos) * 768; kv = ldg16(row + O_K + hh * 64 + ch * 8); vv = ldg16(row + O_V + hh * 64 + ch * 8); }
            *(u32x4*)(Ks + key * C::KSTR + ch * 8) = kv;
            bf16_t* vd = Vt + (ch * 8) * C::VSTR + key;
            vd[0] = (bf16_t)vv.x; vd[C::VSTR] = (bf16_t)(vv.x >> 16); vd[2 * C::VSTR] = (bf16_t)vv.y; vd[3 * C::VSTR] = (bf16_t)(vv.y >> 16);
            vd[4 * C::VSTR] = (bf16_t)vv.z; vd[5 * C::VSTR] = (bf16_t)(vv.z >> 16); vd[6 * C::VSTR] = (bf16_t)vv.w; vd[7 * C::VSTR] = (bf16_t)(vv.w >> 16);
        }
        for (int i = tid; i < 4 * 257; i += NTH) { const int g = i / 257, r = i - g * 257; biasT[i] = p->in[4][t5_bucket(r - 128) * 8 + hh * 4 + g] * 1.4426950408889634f; }
    } else {
        const bf16_t* kvm = (const bf16_t*)(p->ws + WS_KVMEM) + (size_t)l * 768 * D;
#pragma unroll
        for (int i = 0; i < 8; ++i) {
            const int idx = tid + i * NTH, key = idx >> 4, ch = idx & 15;
            const bf16_t* row = kvm + ((size_t)seq * N_MEM + key) * D;
            const u32x4 kv = ldg16(row + hh * 128 + ch * 8), vv = ldg16(row + 512 + hh * 128 + ch * 8);
            *(u32x4*)(Ks + key * C::KSTR + ch * 8) = kv;
            bf16_t* vd = Vt + (ch * 8) * C::VSTR + key;
            vd[0] = (bf16_t)vv.x; vd[C::VSTR] = (bf16_t)(vv.x >> 16); vd[2 * C::VSTR] = (bf16_t)vv.y; vd[3 * C::VSTR] = (bf16_t)(vv.y >> 16);
            vd[4 * C::VSTR] = (bf16_t)vv.z; vd[5 * C::VSTR] = (bf16_t)(vv.z >> 16); vd[6 * C::VSTR] = (bf16_t)vv.w; vd[7 * C::VSTR] = (bf16_t)(vv.w >> 16);
        }
    }
    bf16_t* qbase; int ldq, qcol0, wrow0; size_t tok0; float sink = 0.f; int g = 0;
    if (WIN) { g = w >> 1; qbase = (bf16_t*)(p->ws + WS_QKV); ldq = 768; qcol0 = (hh * 4 + g) * 64; wrow0 = (w & 1) * 64; tok0 = (size_t)seq * SEQL + blk * 128;
               sink = p->in[9][(size_t)l * 8 + hh * 4 + g] * 1.4426950408889634f; }
    else { qbase = (bf16_t*)((unsigned char*)p->out + DO_QM); ldq = 512; qcol0 = hh * 128; wrow0 = w * 32; tok0 = (size_t)seq * SEQL + blk * 256; }
    bf16x8 bq[C::QT][C::KS];
#pragma unroll
    for (int qt = 0; qt < C::QT; ++qt)
#pragma unroll
        for (int ks = 0; ks < C::KS; ++ks) bq[qt][ks] = *(const bf16x8*)(qbase + (tok0 + wrow0 + qt * 16 + fr) * ldq + qcol0 + ks * 32 + fq * 8);
    f32x4 o[C::QT][C::DT]; float m[C::QT], ls[C::QT];
#pragma unroll
    for (int qt = 0; qt < C::QT; ++qt) { m[qt] = WIN ? sink : -1e30f; ls[qt] = (WIN && fq == 0) ? 1.f : 0.f;
#pragma unroll
        for (int dt = 0; dt < C::DT; ++dt) o[qt][dt] = (f32x4){0.f, 0.f, 0.f, 0.f}; }
    const float scale = (WIN ? 0.125f : 0.08838834764831845f) * 1.4426950408889634f;
    __syncthreads();
#pragma unroll 1
    for (int kc = 0; kc < C::NK / 32; ++kc) {
        bf16x8 ak[2][C::KS];
#pragma unroll
        for (int kt = 0; kt < 2; ++kt)
#pragma unroll
            for (int ks = 0; ks < C::KS; ++ks) ak[kt][ks] = *(const bf16x8*)(Ks + (kc * 32 + kt * 16 + fr) * C::KSTR + ks * 32 + fq * 8);
        bf16x8 av[C::DT];
#pragma unroll
        for (int dt = 0; dt < C::DT; ++dt) {
            const u32x2 v0 = *(const u32x2*)(Vt + (dt * 16 + fr) * C::VSTR + kc * 32 + fq * 4), v1 = *(const u32x2*)(Vt + (dt * 16 + fr) * C::VSTR + kc * 32 + 16 + fq * 4);
            u32x4 vv; vv.x = v0.x; vv.y = v0.y; vv.z = v1.x; vv.w = v1.y; av[dt] = __builtin_bit_cast(bf16x8, vv);
        }
#pragma unroll
        for (int qt = 0; qt < C::QT; ++qt) {
            const int r0 = wrow0 + qt * 16;
            if (WIN && !(kc * 32 + 31 >= r0 && kc * 32 <= r0 + 271)) continue;
            f32x4 s0 = (f32x4){0.f, 0.f, 0.f, 0.f}, s1 = s0;
#pragma unroll
            for (int ks = 0; ks < C::KS; ++ks) { s0 = __builtin_amdgcn_mfma_f32_16x16x32_bf16(ak[0][ks], bq[qt][ks], s0, 0, 0, 0); s1 = __builtin_amdgcn_mfma_f32_16x16x32_bf16(ak[1][ks], bq[qt][ks], s1, 0, 0, 0); }
            float sv[8];
            const bool interior = WIN && (kc * 32 >= r0 + 15) && (kc * 32 + 31 - r0 <= 256) && (blk * 128 - 128 + kc * 32 >= 0) && (blk * 128 - 128 + kc * 32 + 31 < SEQL);
            if (interior) {
                const float* bt = biasT + g * 257 + fq * 4 - fr + (kc * 32 - r0);
#pragma unroll
                for (int e = 0; e < 8; ++e) sv[e] = __builtin_fmaf(e < 4 ? s0[e & 3] : s1[e & 3], scale, bt[(e >> 2) * 16 + (e & 3)]);
            } else
#pragma unroll
            for (int e = 0; e < 8; ++e) {
                const float raw = (e < 4 ? s0[e & 3] : s1[e & 3]) * scale;
                if (WIN) {
                    const int jk = kc * 32 + (e >> 2) * 16 + fq * 4 + (e & 3), qi = r0 + fr, rel = jk - qi, pos = blk * 128 - 128 + jk;
                    const bool ok = (rel >= 0) && (rel <= 256) && (pos >= 0) && (pos < SEQL);
                    const int ri = rel < 0 ? 0 : (rel > 256 ? 256 : rel);
                    sv[e] = ok ? raw + biasT[g * 257 + ri] : -1e30f;
                } else sv[e] = raw;
            }
            float cm = fmaxf(fmaxf(fmaxf(sv[0], sv[1]), fmaxf(sv[2], sv[3])), fmaxf(fmaxf(sv[4], sv[5]), fmaxf(sv[6], sv[7])));
            cm = fmaxf(cm, __shfl_xor(cm, 16)); cm = fmaxf(cm, __shfl_xor(cm, 32));
            const float mn = fmaxf(m[qt], cm), al = __builtin_amdgcn_exp2f(m[qt] - mn);
            m[qt] = mn;
            float ps = 0.f; float pe[8];
#pragma unroll
            for (int e = 0; e < 8; ++e) { pe[e] = __builtin_amdgcn_exp2f(sv[e] - mn); ps += pe[e]; }
            ls[qt] = ls[qt] * al + ps;
            u32x4 pw; pw.x = pk2(pe[0], pe[1]); pw.y = pk2(pe[2], pe[3]); pw.z = pk2(pe[4], pe[5]); pw.w = pk2(pe[6], pe[7]);
            const bf16x8 pf = __builtin_bit_cast(bf16x8, pw);
#pragma unroll
            for (int dt = 0; dt < C::DT; ++dt) { o[qt][dt] = o[qt][dt] * al; o[qt][dt] = __builtin_amdgcn_mfma_f32_16x16x32_bf16(av[dt], pf, o[qt][dt], 0, 0, 0); }
        }
    }
#pragma unroll
    for (int qt = 0; qt < C::QT; ++qt) {
        float lt = ls[qt]; lt += __shfl_xor(lt, 16); lt += __shfl_xor(lt, 32);
        const float inv = 1.f / lt;
#pragma unroll
        for (int dt = 0; dt < C::DT; ++dt) {
            const f32x4 v = o[qt][dt] * inv;
            u32x2 ov; ov.x = pk2(v.x, v.y); ov.y = pk2(v.z, v.w);
            *(u32x2*)(qbase + (tok0 + wrow0 + qt * 16 + fr) * ldq + qcol0 + dt * 16 + fq * 4) = ov;
        }
    }
}
constexpr int ATT_LDS_WIN = AttnCfg<true>::K_BYTES + AttnCfg<true>::V_BYTES + 4 * 257 * 4;
constexpr int ATT_LDS_MEM = AttnCfg<false>::K_BYTES + AttnCfg<false>::V_BYTES;

constexpr int FBUF_BYTES = FBUF_F2 * 8;
constexpr int HY_LDS = FBUF_BYTES + 1024 + 288 * 8;
typedef _Float16 h2_t __attribute__((ext_vector_type(2)));
DV HPair unpackH(u32x2 v) {
    const h2_t a = __builtin_bit_cast(h2_t, v.x), b = __builtin_bit_cast(h2_t, v.y);
    const float sc = 1.f / (float)FN;
    HPair h; h.hk = make_float2((float)a.x * sc, (float)a.y * sc); h.hl = make_float2((float)b.x * sc, (float)b.y * sc); return h;
}
DV int opaque(int v) { asm volatile("" : "+v"(v)); return v; }
typedef HYV hyv_t;
template <class V> DV void fft_fwd_123(V* buf, int tid, const float2* tw) {
#pragma unroll 1
    for (int ps = 1; ps < 4; ++ps) { fft_pass<false, V>(buf, ps, opaque(tid), tw); __syncthreads(); }
}
template <class V> DV void fft_inv_012(V* buf, int tid, const float2* tw) {
#pragma unroll 1
    for (int ps = 0; ps < 3; ++ps) { fft_pass<true, V>(buf, ps, opaque(tid), tw); __syncthreads(); }
}
DV void fft_fwd_all(v2f* buf, int tid, const float2* tw) {
#pragma unroll 1
    for (int ps = 0; ps < 4; ++ps) { fft_pass<false, v2f>(buf, ps, opaque(tid), tw); __syncthreads(); }
}
template <int I> DV void hy_pair_one(hyv_t* dbuf, const f32x4* Hs, const PairCtx& cx, int tid, const float2* t12) {
    const f32x4 hv = Hs[tid + NTH * I]; HPair hp; hp.hk = make_float2(hv.x, hv.y); hp.hl = make_float2(hv.z, hv.w);
    pair_apply_fast<I>(dbuf, cx, tid, hp, t12);
}
DV void hy_pair_stage(hyv_t* dbuf, const f32x4* Hs, int tid, const float2* t12) {
    const PairCtx cx = pair_ctx(tid);
    hy_pair_one<0>(dbuf, Hs, cx, tid, t12); hy_pair_one<1>(dbuf, Hs, cx, tid, t12); hy_pair_one<2>(dbuf, Hs, cx, tid, t12); hy_pair_one<3>(dbuf, Hs, cx, tid, t12);
    hy_pair_one<4>(dbuf, Hs, cx, tid, t12); hy_pair_one<5>(dbuf, Hs, cx, tid, t12); hy_pair_one<6>(dbuf, Hs, cx, tid, t12); hy_pair_one<7>(dbuf, Hs, cx, tid, t12);
    hy_pair_one<8>(dbuf, Hs, cx, tid, t12); hy_pair_one<9>(dbuf, Hs, cx, tid, t12); hy_pair_one<10>(dbuf, Hs, cx, tid, t12); hy_pair_one<11>(dbuf, Hs, cx, tid, t12);
    hy_pair_one<12>(dbuf, Hs, cx, tid, t12); hy_pair_one<13>(dbuf, Hs, cx, tid, t12); hy_pair_one<14>(dbuf, Hs, cx, tid, t12); hy_pair_one<15>(dbuf, Hs, cx, tid, t12);
}
DV void hyena_item(KParams p, int l, int c, unsigned char* smem) {
    const int tid = tid_(), lane = tid & 63, w = wave_();
    v2f* buf = (v2f*)smem; float* fbuf = (float*)smem;
    hyv_t* dbuf = (hyv_t*)smem;
    float* wo = (float*)(smem + FBUF_BYTES); float* red = wo + 128;
    const bf16_t* filt = (const bf16_t*)(p->ws + WS_FILT);
    const float2* tw = (const float2*)(p->ws + WS_TW);
    float2* t12 = (float2*)(smem + FBUF_BYTES + 1024);
    if (tid < 256) t12[tid] = tw[tid]; else if (tid < 288) t12[tid] = tw[(tid - 256) * 256];
    const float min_decay = -3.0701134573253945f, max_decay = -15.350567286626972f;
    const float delta = fabsf(min_decay + (float)c * ((max_decay - min_decay) / 511.f));
#ifdef PROBE_PHASE
#define HSTAMP(i) { __syncthreads(); if (blockIdx.x == 0 && threadIdx.x == 0) __hip_atomic_store((unsigned long long*)(p->ws + WS_TS) + (i), (unsigned long long)__builtin_amdgcn_s_memrealtime(), __ATOMIC_RELAXED, __HIP_MEMORY_SCOPE_AGENT); }
#else
#define HSTAMP(i)
#endif
    HSTAMP(24)
    f32x4* Hs = (f32x4*)(p->ws + WS_HSCR) + (size_t)blockIdx.x * 2 * 8192;
    __syncthreads();
#pragma unroll 1
    for (int o = 0; o < 2; ++o) {
        const bf16_t* ff = filt + (size_t)(o * 1024 + c) * SEQL; const bf16_t* fb = ff + (size_t)512 * SEQL;
        float asum = 0.f;
        u32x4 fva[4], bva[4];
#pragma unroll
        for (int i = 0; i < 4; ++i) { const int pos0 = 8 * (tid + NTH * i); fva[i] = ldg16(ff + pos0); bva[i] = ldg16(fb + pos0); }
#pragma unroll
        for (int i = 0; i < 4; ++i) {
            const int pos0 = 8 * (opaque(tid) + NTH * i);
            const u32x4 fv = fva[i], bv = bva[i];
            const float fw[8] = {bflo(fv.x), bfhi(fv.x), bflo(fv.y), bfhi(fv.y), bflo(fv.z), bfhi(fv.z), bflo(fv.w), bfhi(fv.w)};
            const float bw[8] = {bflo(bv.x), bfhi(bv.x), bflo(bv.y), bfhi(bv.y), bflo(bv.z), bfhi(bv.z), bflo(bv.w), bfhi(bv.w)};
#pragma unroll
            for (int e = 0; e < 8; ++e) {
                const int pos = pos0 + e;
                const float dec = __expf(-((float)pos * (1.f / (float)(SEQL - 1))) * delta);
                const float f = fw[e] * dec, b = bw[e] * dec;
                if (pos == 0) { const float v = f + b; fbuf[fidx(0)] = v; asum += fabsf(v); }
                else { fbuf[fidx(pos)] = f; fbuf[fidx(2 * SEQL - pos)] = b; asum += fabsf(f) + fabsf(b); }
            }
        }
        if (tid == 0) fbuf[fidx(SEQL)] = 0.f;
        asum = wave_sum(asum);
        if (lane == 0) red[w] = asum;
        __syncthreads();
        float norm = 0.f;
#pragma unroll
        for (int i = 0; i < 8; ++i) norm += red[i];
        fft_fwd_all(buf, tid, tw);
        const float sc = HY_YS / (norm * (float)FN);
#pragma unroll 2
        for (int i = 0; i < 16; ++i) { const int e = opaque(tid) + NTH * i; const HPair hp = pair_filter(buf, e, e == 0 ? sc : sc * PAIR_PRE, t12);
            Hs[o * 8192 + tid + NTH * i] = (f32x4){hp.hk.x, hp.hk.y, hp.hl.x, hp.hl.y}; }
        __syncthreads();
    }
    const float bias0 = p->in[15][(size_t)l * 2 * HYW + c], bias1 = p->in[15][(size_t)l * 2 * HYW + HYW + c];
    bf16_t* uct = (bf16_t*)((unsigned char*)p->out + DO_UCT);
    unsigned pa[2][8];
#pragma unroll
    for (int i = 0; i < 2; ++i) hy_load8(uct + (size_t)c * SEQL, (unsigned)(tid + NTH * i), pa[i]);
#pragma unroll 1
    for (int s = 0; s < NSEQ; ++s) {
        bf16_t* p0 = uct + ((size_t)s * HY3 + c) * SEQL; const bf16_t* p1 = p0 + (size_t)HYW * SEQL; const bf16_t* p2 = p0 + (size_t)2 * HYW * SEQL;
        v2f z1[2][8];
#pragma unroll
        for (int i = 0; i < 2; ++i) hy_step_a(dbuf, (unsigned)(opaque(tid) + NTH * i), pa[i], tw);
        __syncthreads();
        { unsigned pb[2][8];
          fft_fwd_123(dbuf, tid, tw);
          hy_pair_stage(dbuf, Hs + 0 * 8192, opaque(tid), t12);
          __syncthreads();
#pragma unroll
          for (int i = 0; i < 2; ++i) hy_load8(p1, (unsigned)(tid + NTH * i), pb[i]);
          fft_inv_012(dbuf, tid, tw);
#pragma unroll
          for (int i = 0; i < 2; ++i) hy_step_b(dbuf, (unsigned)(opaque(tid) + NTH * i), pa[i], pb[i], bias0, 1.f / HY_YS, z1[i], tw); }
        __syncthreads();
        { unsigned pc[2][8];
          fft_fwd_123(dbuf, tid, tw);
          hy_pair_stage(dbuf, Hs + 1 * 8192, opaque(tid), t12);
          __syncthreads();
#pragma unroll
          for (int i = 0; i < 2; ++i) hy_load8(p2, (unsigned)(tid + NTH * i), pc[i]);
          if (s + 1 < NSEQ) {
#pragma unroll
              for (int i = 0; i < 2; ++i) hy_load8(p0 + (size_t)HY3 * SEQL, (unsigned)(tid + NTH * i), pa[i]); }
          fft_inv_012(dbuf, tid, tw);
#pragma unroll
          for (int i = 0; i < 2; ++i) hy_step_c(dbuf, (unsigned)(opaque(tid) + NTH * i), pc[i], z1[i], bias1, 1.f / HY_YS, p0, tw); }
        __syncthreads();
    }
}
__device__ static const signed char CI_TAB[52] = {0,0,0,0,0,0,0,0,0,0,0,0,0,0,0,0,1,1,1,1,1,1,1,1,2,2,2,2,2,3,3,3,3,4,4,4,5,5,6,6,7,7,8,9,10,11,12,13,14,15,15,15};
__device__ static const signed char CJ_TAB[52] = {0,1,2,3,4,5,6,7,8,9,10,11,12,13,14,15,0,1,2,3,4,5,6,7,0,1,2,3,4,0,1,2,3,0,1,2,0,1,0,1,0,1,0,0,0,0,0,0,0,0,15,15};
constexpr int CI_C[52] = {0,0,0,0,0,0,0,0,0,0,0,0,0,0,0,0,1,1,1,1,1,1,1,1,2,2,2,2,2,3,3,3,3,4,4,4,5,5,6,6,7,7,8,9,10,11,12,13,14,15,15,15};
constexpr int CJ_C[52] = {0,1,2,3,4,5,6,7,8,9,10,11,12,13,14,15,0,1,2,3,4,5,6,7,0,1,2,3,4,0,1,2,3,0,1,2,0,1,0,1,0,1,0,0,0,0,0,0,0,0,15,15};
DV unsigned f2ord(float f) { const unsigned u = __builtin_bit_cast(unsigned, f); return (u >> 31) ? ~u : (u | 0x80000000u); }
DV float ord2f(unsigned k) { const unsigned u = (k >> 31) ? (k & 0x7fffffffu) : ~k; return __builtin_bit_cast(float, u); }
DV unsigned umax3(unsigned a, unsigned b, unsigned c) { return max(max(a, b), c); }
constexpr int SK_STR = 136, SK_LDS = 2 * 128 * SK_STR * 2;
DV void peer_stage_sk(KParams p, int l, int h, bf16_t* sks) {
    const bf16_t* sk = (const bf16_t*)(p->ws + WS_W + l * SZ_WL + OFF_SK) + (size_t)h * 2 * 128 * 128;
    __syncthreads();
#pragma unroll
    for (int i = 0; i < 8; ++i) { const int idx = tid_() + i * NTH, row = idx >> 4, ch = idx & 15; *(u32x4*)(sks + row * SK_STR + ch * 8) = ldg16(sk + (size_t)row * 128 + ch * 8); }
    __syncthreads();
}
DV void peer_topk_loadq(KParams p, int tile, int h, bf16x8 (&bqa)[2][4]) {
    const int lane = tid_() & 63, w = wave_(), fr = lane & 15, fq = lane >> 4;
    const bf16_t* qp = (const bf16_t*)p->out + ((size_t)tile * 128 + w * 16 + fr) * 2048 + h * 256 + fq * 8;
#pragma unroll
    for (int c = 0; c < 2; ++c)
#pragma unroll
        for (int ks = 0; ks < 4; ++ks) bqa[c][ks] = *(const bf16x8*)(qp + c * 128 + ks * 32);
}
DV void merge16_xor(unsigned (&k)[16], int m) {
    unsigned o[16];
#pragma unroll
    for (int i = 0; i < 16; ++i) o[i] = (unsigned)__shfl_xor((int)k[15 - i], m);
#pragma unroll
    for (int i = 0; i < 16; ++i) k[i] = max(k[i], o[i]);
    bitonic_merge_desc<16>(k);
}
DV void peer_topk_item(KParams p, int l, int tile, int h, bf16_t* sks, const bf16x8 (&bqa)[2][4]) {
    const int lane = tid_() & 63, w = wave_(), fr = lane & 15, fq = lane >> 4;
    const size_t t0 = (size_t)tile * 128 + w * 16;
    unsigned tk[2][16];
#pragma unroll
    for (int c = 0; c < 2; ++c) {
        bf16x8 bq[4];
#pragma unroll
        for (int ks = 0; ks < 4; ++ks) bq[ks] = bqa[c][ks];
        unsigned key[32];
        const bf16_t* skc = sks + c * 128 * SK_STR;
#pragma unroll
        for (int kt = 0; kt < 8; ++kt) {
            f32x4 s = (f32x4){0.f, 0.f, 0.f, 0.f};
#pragma unroll
            for (int ks = 0; ks < 4; ++ks) { const bf16x8 a = *(const bf16x8*)(skc + (kt * 16 + fr) * SK_STR + ks * 32 + fq * 8); s = __builtin_amdgcn_mfma_f32_16x16x32_bf16(a, bq[ks], s, 0, 0, 0); }
#pragma unroll
            for (int j = 0; j < 4; ++j) { const int kidx = kt * 16 + fq * 4 + j; key[kt * 4 + j] = (f2ord(s[j]) & 0xffffff80u) | (unsigned)(127 - kidx); }
        }
        unsigned k16[16];
        { unsigned kb[16];
#pragma unroll
          for (int r = 0; r < 16; ++r) { k16[r] = key[r]; kb[r] = key[16 + r]; }
          bitonic_sort_desc<16>(k16); bitonic_sort_desc<16>(kb);
#pragma unroll
          for (int r = 0; r < 16; ++r) k16[r] = max(k16[r], kb[15 - r]);
          bitonic_merge_desc<16>(k16); }
        merge16_xor(k16, 16); merge16_xor(k16, 32);
#pragma unroll
        for (int r = 0; r < 16; ++r) tk[c][r] = k16[r];
    }
    float v0[16], v1[16];
#pragma unroll
    for (int r = 0; r < 16; ++r) { v0[r] = ord2f(tk[0][r] & 0xffffff80u); v1[r] = ord2f(tk[1][r] & 0xffffff80u); }
    unsigned ck[13]; int ce[13];
#pragma unroll
    for (int s = 0; s < 13; ++s) {
        float sum[4]; int ee[4];
#pragma unroll
        for (int q = 0; q < 4; ++q) { const int i = CI_C[q + 4 * s], j = CJ_C[q + 4 * s]; sum[q] = v0[i] + v1[j];
            ee[q] = (127 - (int)(tk[0][i] & 127u)) * 128 + (127 - (int)(tk[1][j] & 127u)); }
        const float sm = fq == 0 ? sum[0] : (fq == 1 ? sum[1] : (fq == 2 ? sum[2] : sum[3]));
        ce[s] = fq == 0 ? ee[0] : (fq == 1 ? ee[1] : (fq == 2 ? ee[2] : ee[3]));
        ck[s] = (f2ord(sm) & 0xffffffc0u) | (unsigned)(63 - (4 * s)) ;
        ck[s] -= (unsigned)fq;
    }
    int* celds = (int*)(sks + 2 * 128 * SK_STR) + (w * 16 + fr) * 52;
#pragma unroll
    for (int s = 0; s < 13; ++s) celds[fq + 4 * s] = ce[s];
    float myv[4]; int myc[4]; float w0;
    { unsigned c16[16];
#pragma unroll
      for (int i = 0; i < 16; ++i) c16[i] = i < 13 ? ck[i] : 0u;
      bitonic_sort_desc<16>(c16);
      merge16_xor(c16, 16); merge16_xor(c16, 32);
      w0 = ord2f(c16[0] & 0xffffffc0u);
#pragma unroll
      for (int i = 0; i < 4; ++i) { const unsigned mk = fq == 0 ? c16[i] : (fq == 1 ? c16[4 + i] : (fq == 2 ? c16[8 + i] : c16[12 + i]));
          myv[i] = ord2f(mk & 0xffffffc0u); myc[i] = 63 - (int)(mk & 63u); } }
    int mye[4];
#pragma unroll
    for (int i = 0; i < 4; ++i) mye[i] = celds[myc[i]];
    float ex[4], ps = 0.f;
#pragma unroll
    for (int i = 0; i < 4; ++i) { ex[i] = __expf(myv[i] - w0); ps += ex[i]; }
    ps += __shfl_xor(ps, 16); ps += __shfl_xor(ps, 32);
    const float inv = 1.f / ps;
    unsigned short* eidx = (unsigned short*)(p->ws + WS_EIDX) + (t0 + fr) * 128 + 16 * h + 4 * fq; float* gate = (float*)(p->ws + WS_GATE) + (t0 + fr) * 128 + 16 * h + 4 * fq;
    *(uint2*)eidx = make_uint2((unsigned)mye[0] | ((unsigned)mye[1] << 16), (unsigned)mye[2] | ((unsigned)mye[3] << 16));
    *(f32x4*)gate = (f32x4){ex[0] * inv, ex[1] * inv, ex[2] * inv, ex[3] * inv};
}

typedef float f32x2 __attribute__((ext_vector_type(2)));
DV float gelu_exact(float x) { return 0.5f * x * (1.f + erff(x * 0.7071067811865476f)); }
constexpr size_t SLICE_BYTES = (size_t)NEXP * 128;
DV int peer_q0(int s) { return ((s >> 2) & 1) * 8 + ((s >> 1) & 1) * 4 + (s & 1) * 2; }
struct PeerUIn { u32x4 e; };
constexpr int NSL = 4;
typedef int i32x8 __attribute__((ext_vector_type(8)));
DV PeerUIn peer_u_in(KParams p, size_t t, int lane) {
    PeerUIn r; r.e = ldg16((const unsigned short*)(p->ws + WS_EIDX) + t * 128 + (lane >> 2) * 8); return r;
}
DV unsigned peer_e8(const u32x4& a, int g) { const unsigned w = g < 2 ? a.x : g < 4 ? a.y : g < 6 ? a.z : a.w; return (g & 1) ? (w >> 16) : (w & 0xffffu); }
DV void peer_u_gather(KParams p, const unsigned char* U4, const PeerUIn& in, int sl, size_t t, int lane, u32x4 (&r)[16], u32x4 (&x)[2]) {
#pragma unroll
    for (int g = 0; g < 8; ++g) { const unsigned char* row = U4 + (size_t)peer_e8(in.e, g) * 128; r[2 * g] = ldg16(row); r[2 * g + 1] = ldg16(row + 64); }
    const unsigned char* xh = p->ws + WS_X8 + t * D + 256 * sl + (lane & 3) * 32 + ((lane >> 4) & 1) * 16;
    x[0] = ldg16(xh); x[1] = ldg16(xh + 128);
}
DV i32x8 cat8(const u32x4& a, const u32x4& b) { return (i32x8){(int)a.x, (int)a.y, (int)a.z, (int)a.w, (int)b.x, (int)b.y, (int)b.z, (int)b.w}; }
DV float quad_sum(float v) {
    v += __builtin_bit_cast(float, __builtin_amdgcn_update_dpp(0, __builtin_bit_cast(int, v), 0xB1, 0xf, 0xf, true));
    v += __builtin_bit_cast(float, __builtin_amdgcn_update_dpp(0, __builtin_bit_cast(int, v), 0x4E, 0xf, 0xf, true));
    return v;
}
DV void peer_u_finish(KParams p, int sl, size_t t, int lane, const u32x4 (&r)[16], const u32x4 (&x)[2]) {
    const bool k0 = ((lane >> 2) & 3) == (lane >> 5), k1 = ((lane >> 2) & 3) == 2 + (lane >> 5);
    const u32x4 z4 = (u32x4){0u, 0u, 0u, 0u};
    const i32x8 x0 = cat8(k0 ? x[0] : z4, k1 ? x[0] : z4), x1 = cat8(k0 ? x[1] : z4, k1 ? x[1] : z4);
    const int c = lane & 3; const bool c0 = (c & 1) != 0, c1 = (c & 2) != 0;
    float h[8];
#pragma unroll
    for (int g = 0; g < 8; ++g) {
        f32x4 acc = __builtin_amdgcn_mfma_scale_f32_16x16x128_f8f6f4(cat8(r[2 * g], z4), x0, (f32x4){0.f, 0.f, 0.f, 0.f}, 4, 0, 0, 0, 0, 0);
        acc = __builtin_amdgcn_mfma_scale_f32_16x16x128_f8f6f4(cat8(r[2 * g + 1], z4), x1, acc, 4, 0, 0, 0, 0, 0);
        const float d0 = c0 ? acc[1] : acc[0], d1 = c0 ? acc[3] : acc[2];
        h[g] = quad_sum(c1 ? d1 : d0); }
    const int e = (lane >> 4) + 4 * ((lane >> 2) & 3);
    if (c == 0) {
        bf16_t* part = (bf16_t*)((unsigned*)p->out + ((size_t)sl * T + t) * 64) + e * 8;
        stg16(part, (u32x4){pk2(h[0], h[1]), pk2(h[2], h[3]), pk2(h[4], h[5]), pk2(h[6], h[7])}); }
}
DV void peer_u_phase(KParams p, int l, int bid, int nblk) {
    const int wv = wave_(), lane = tid_() & 63, j = bid & 7, sl = j & 3, half = j >> 2, b8 = bid >> 3, nb8 = nblk >> 3;
    const unsigned char* U4 = p->ws + WS_EXP + (size_t)(2 * l) * SZ_EXP1 + (size_t)sl * SLICE_BYTES + (lane & 3) * 16;
    const size_t step = (size_t)nb8 * 16; size_t t = (size_t)(b8 * 8 + wv) * 2 + half;
    if (t >= (size_t)T) return;
    const size_t t0 = t;
    size_t ta = t, tb = t + step;
    u32x4 ra[16], rb[16], xa[2], xb[2];
    { const PeerUIn a = peer_u_in(p, ta, lane), b = peer_u_in(p, tb < (size_t)T ? tb : t0, lane);
      peer_u_gather(p, U4, a, sl, ta, lane, ra, xa); peer_u_gather(p, U4, b, sl, tb < (size_t)T ? tb : t0, lane, rb, xb); }
    PeerUIn na = peer_u_in(p, ta + 2 * step < (size_t)T ? ta + 2 * step : t0, lane), nb = peer_u_in(p, tb + 2 * step < (size_t)T ? tb + 2 * step : t0, lane);
#pragma unroll 1
    while (ta < (size_t)T) {
        peer_u_finish(p, sl, ta, lane, ra, xa);
        ta += 2 * step;
        peer_u_gather(p, U4, na, sl, ta < (size_t)T ? ta : t0, lane, ra, xa);
        na = peer_u_in(p, ta + 2 * step < (size_t)T ? ta + 2 * step : t0, lane);
        if (tb < (size_t)T) peer_u_finish(p, sl, tb, lane, rb, xb);
        tb += 2 * step;
        peer_u_gather(p, U4, nb, sl, tb < (size_t)T ? tb : t0, lane, rb, xb);
        nb = peer_u_in(p, tb + 2 * step < (size_t)T ? tb + 2 * step : t0, lane);
    }
}
DV unsigned peer_e16(const u32x4& a, const u32x4& b, int q) {
    const unsigned w = q < 2 ? a.x : q < 4 ? a.y : q < 6 ? a.z : q < 8 ? a.w : q < 10 ? b.x : q < 12 ? b.y : q < 14 ? b.z : b.w;
    return (q & 1) ? (w >> 16) : (w & 0xffffu);
}
typedef _Float16 h16x2 __attribute__((ext_vector_type(2)));
DV h16x2 fp8h(unsigned w, bool hi) { return hi ? __builtin_amdgcn_cvt_scalef32_pk_f16_fp8(w, 1.0f, true) : __builtin_amdgcn_cvt_scalef32_pk_f16_fp8(w, 1.0f, false); }
constexpr size_t DO_COEF = (size_t)T * D * 2;
constexpr size_t DO_CSC = DO_COEF + (size_t)NSL * T * 128;
DV void peer_c_phase(KParams p, int l, int bid, int nblk) {
    const int wv = wave_(), lane = tid_() & 63, g = lane >> 3, s = lane & 7;
    const unsigned char* tabu = p->ws + WS_EXP + (size_t)(2 * l) * SZ_EXP1; const unsigned char* tabv = tabu + SZ_EXP1;
    const unsigned char* sc16 = tabu + NSL * SLICE_BYTES;
    const int o2 = g * 16 + peer_q0(s);
    const size_t step = (size_t)nblk * 8;
#pragma unroll 1
    for (size_t t0 = (size_t)bid * 8 + wv; t0 < (size_t)T; t0 += 4 * step) {
        unsigned pw[4][NSL]; unsigned ew[4]; f32x2 gt[4];
#pragma unroll
        for (int k = 0; k < 4; ++k) { const size_t t = t0 + k * step < (size_t)T ? t0 + k * step : t0;
            const unsigned* part = (const unsigned*)p->out + t * 64 + lane;
#pragma unroll
            for (int q = 0; q < NSL; ++q) pw[k][q] = part[(size_t)q * T * 64];
            ew[k] = *(const unsigned*)((const unsigned short*)(p->ws + WS_EIDX) + t * 128 + o2);
            gt[k] = *(const f32x2*)((const float*)(p->ws + WS_GATE) + t * 128 + o2); }
#pragma unroll
        for (int k = 0; k < 4; ++k) { const size_t t = t0 + k * step;
            const int e0 = (int)(ew[k] & 0xffffu), e1 = (int)(ew[k] >> 16);
            const f32x4 su0 = *(const f32x4*)(sc16 + (size_t)e0 * 32), sv0 = *(const f32x4*)(sc16 + (size_t)e0 * 32 + 16);
            const f32x4 su1 = *(const f32x4*)(sc16 + (size_t)e1 * 32), sv1 = *(const f32x4*)(sc16 + (size_t)e1 * 32 + 16);
            float a0 = 0.f, a1 = 0.f;
#pragma unroll
            for (int q = 0; q < NSL; ++q) { a0 += bflo(pw[k][q]) * su0[q]; a1 += bfhi(pw[k][q]) * su1[q]; }
            float v0[NSL] = {sv0[0], sv0[1], sv0[2], sv0[3]}, v1[NSL] = {sv1[0], sv1[1], sv1[2], sv1[3]};
            const float c0 = gt[k].x * gelu_exact(a0), c1 = gt[k].y * gelu_exact(a1);
            float mx = 0.f;
#pragma unroll
            for (int q = 0; q < NSL; ++q) { v0[q] *= c0; v1[q] *= c1; mx = fmaxf(mx, fmaxf(fabsf(v0[q]), fabsf(v1[q]))); }
            mx = wave_max(mx);
            const float S = mx > 0.f ? 128.f / mx : 0.f;
            if (t < (size_t)T) {
#pragma unroll
                for (int q = 0; q < NSL; ++q) *(unsigned short*)((unsigned char*)p->out + DO_COEF + ((size_t)q * T + t) * 128 + o2) = (unsigned short)__builtin_amdgcn_cvt_pk_fp8_f32(v0[q] * S, v1[q] * S, 0, false);
                if (lane == 0) ((float*)((unsigned char*)p->out + DO_CSC))[t] = mx * (1.f / 128.f); } }
    }
}
struct PeerVIn { u32x4 e0, e1; };
DV PeerVIn peer_v_in(KParams p, size_t t, int lane) {
    PeerVIn r; const unsigned short* eidx = (const unsigned short*)(p->ws + WS_EIDX) + t * 128 + (lane >> 3) * 16;
    r.e0 = ldg16(eidx); r.e1 = ldg16(eidx + 8); return r;
}
struct PeerVCo { u32x2 ca, cb; float isc; };
DV void peer_v_gather(KParams p, const unsigned char* V4, const unsigned char* coef, const PeerVIn& in, size_t t, u32x4 (&r)[16], PeerVCo& c) {
#pragma unroll
    for (int q = 0; q < 16; ++q) r[q] = ldg16(V4 + (size_t)peer_e16(in.e0, in.e1, q) * 128);
    c.ca = *(const u32x2*)(coef + t * 128); c.cb = *(const u32x2*)(coef + t * 128 + 64);
    c.isc = ((const float*)((const unsigned char*)p->out + DO_CSC))[t];
}
DV float add_ror8(float a, float b) { return a + __builtin_bit_cast(float, __builtin_amdgcn_update_dpp(0, __builtin_bit_cast(int, b), 0x128, 0xf, 0xf, true)); }
DV void peer_v_finish(KParams p, int sl, size_t t, int lane, const PeerVCo& co, const u32x4 (&r)[16]) {
    const int m = lane & 15; const bool z = (m & 2) != 0, live = m < 4;
    const unsigned s0 = z ? 0x010c000cu : 0x0c010c00u, s1 = z ? 0x030c020cu : 0x0c030c02u;
    const unsigned cax = live ? co.ca.x : 0u, cay = live ? co.ca.y : 0u, cbx = live ? co.cb.x : 0u, cby = live ? co.cb.y : 0u;
    const i32x8 A = (i32x8){(int)__builtin_amdgcn_perm(0u, cax, s0), (int)__builtin_amdgcn_perm(0u, cax, s1), (int)__builtin_amdgcn_perm(0u, cay, s0), (int)__builtin_amdgcn_perm(0u, cay, s1),
                            (int)__builtin_amdgcn_perm(0u, cbx, s0), (int)__builtin_amdgcn_perm(0u, cbx, s1), (int)__builtin_amdgcn_perm(0u, cby, s0), (int)__builtin_amdgcn_perm(0u, cby, s1)};
    float y[32];
#pragma unroll
    for (int w = 0; w < 4; ++w) {
        unsigned Tt[4][4];
#pragma unroll
        for (int u = 0; u < 4; ++u) {
            const unsigned a0 = r[4 * u][w], a1 = r[4 * u + 1][w], a2 = r[4 * u + 2][w], a3 = r[4 * u + 3][w];
            const unsigned p0 = __builtin_amdgcn_perm(a1, a0, 0x05010400u), p1 = __builtin_amdgcn_perm(a1, a0, 0x07030602u);
            const unsigned p2 = __builtin_amdgcn_perm(a3, a2, 0x05010400u), p3 = __builtin_amdgcn_perm(a3, a2, 0x07030602u);
            Tt[0][u] = __builtin_amdgcn_perm(p2, p0, 0x05040100u); Tt[1][u] = __builtin_amdgcn_perm(p2, p0, 0x07060302u);
            Tt[2][u] = __builtin_amdgcn_perm(p3, p1, 0x05040100u); Tt[3][u] = __builtin_amdgcn_perm(p3, p1, 0x07060302u);
        }
#pragma unroll
        for (int bq = 0; bq < 4; ++bq) {
            const i32x8 B = (i32x8){(int)Tt[bq][0], (int)Tt[bq][1], (int)Tt[bq][2], (int)Tt[bq][3], 0, 0, 0, 0};
            const f32x4 acc = __builtin_amdgcn_mfma_scale_f32_16x16x128_f8f6f4(A, B, (f32x4){0.f, 0.f, 0.f, 0.f}, 0, 4, 0, 0, 0, 0);
            const int j = 4 * w + bq;
            y[2 * j] = add_ror8(acc[0], acc[1]); y[2 * j + 1] = add_ror8(acc[2], acc[3]);
        }
    }
    if (lane < 8) {
        const size_t off = t * D + 256 * sl + lane * 32;
        const bf16_t* xr = (const bf16_t*)(p->ws + WS_XB) + off; bf16_t* yo = (bf16_t*)(p->ws + WS_HY) + off;
        const float isc = co.isc;
#pragma unroll
        for (int i = 0; i < 4; ++i) { const u32x4 xw = ldg16(xr + 8 * i); u32x4 o;
            o.x = pk2(ALPHA * bflo(xw.x) + y[8 * i + 0] * isc, ALPHA * bfhi(xw.x) + y[8 * i + 1] * isc); o.y = pk2(ALPHA * bflo(xw.y) + y[8 * i + 2] * isc, ALPHA * bfhi(xw.y) + y[8 * i + 3] * isc);
            o.z = pk2(ALPHA * bflo(xw.z) + y[8 * i + 4] * isc, ALPHA * bfhi(xw.z) + y[8 * i + 5] * isc); o.w = pk2(ALPHA * bflo(xw.w) + y[8 * i + 6] * isc, ALPHA * bfhi(xw.w) + y[8 * i + 7] * isc);
            stg16(yo + 8 * i, o); }
    }
}
DV void peer_v_phase(KParams p, int l, int bid, int nblk) {
    const int wv = wave_(), lane = tid_() & 63, lab = bid & 7, sl = lab & 3, half = lab >> 2, b8 = bid >> 3, nb8 = nblk >> 3, s = lane & 7;
    const unsigned char* V4 = p->ws + WS_EXP + (size_t)(2 * l + 1) * SZ_EXP1 + (size_t)sl * SLICE_BYTES + s * 16;
    const unsigned char* coef = (const unsigned char*)p->out + DO_COEF + (size_t)sl * T * 128 + (2 * (lane >> 5) + (lane & 1)) * 16 + ((lane >> 4) & 1) * 8;
    const size_t step = (size_t)nb8 * 16; size_t t = ((size_t)b8 * 8 + wv) * 2 + half;
    if (t >= (size_t)T) return;
    const size_t t0 = t;
    size_t ta = t, tb = t + step;
    u32x4 ra[16], rb[16]; PeerVCo ca, cb;
    { const PeerVIn a = peer_v_in(p, ta, lane), b = peer_v_in(p, tb < (size_t)T ? tb : t0, lane);
      peer_v_gather(p, V4, coef, a, ta, ra, ca); peer_v_gather(p, V4, coef, b, tb < (size_t)T ? tb : t0, rb, cb); }
    PeerVIn na = peer_v_in(p, ta + 2 * step < (size_t)T ? ta + 2 * step : t0, lane), nb = peer_v_in(p, tb + 2 * step < (size_t)T ? tb + 2 * step : t0, lane);
#pragma unroll 1
    while (ta < (size_t)T) {
        peer_v_finish(p, sl, ta, lane, ca, ra);
        ta += 2 * step;
        peer_v_gather(p, V4, coef, na, ta < (size_t)T ? ta : t0, ra, ca);
        na = peer_v_in(p, ta + 2 * step < (size_t)T ? ta + 2 * step : t0, lane);
        if (tb < (size_t)T) peer_v_finish(p, sl, tb, lane, cb, rb);
        tb += 2 * step;
        peer_v_gather(p, V4, coef, nb, tb < (size_t)T ? tb : t0, rb, cb);
        nb = peer_v_in(p, tb + 2 * step < (size_t)T ? tb + 2 * step : t0, lane);
    }
}
DV void ln2_job(KParams p, int l, int bid, int nblk) { ln_job(p->in[25] + (size_t)l * D, p->in[26] + (size_t)l * D, (const bf16_t*)(p->ws + WS_HY), l == DEPTH - 1 ? nullptr : (bf16_t*)(p->ws + WS_XB), p->out, bid, nblk); }


#define XB_TMO      128
#define XB_XCNT(j)  (256  + 64 * (j))
#define XB_XSUB(j)  (1280 + 64 * (j))
#define XB_XGEN(j)  (2304 + 64 * (j))
#define XB_TOP      3328
#define XB_TOPGEN   3392
#define XCD_BAR_WORDS 3456
#define XB_SPIN_CAP (1u << 18)
DV unsigned xb_ld(unsigned* p)              { return __hip_atomic_load(p, __ATOMIC_RELAXED, __HIP_MEMORY_SCOPE_AGENT); }
DV unsigned xb_add(unsigned* p, unsigned v) { return __hip_atomic_fetch_add(p, v, __ATOMIC_RELAXED, __HIP_MEMORY_SCOPE_AGENT); }
DV unsigned xb_xcc_id() { return (unsigned)__builtin_amdgcn_s_getreg((3 << 11) | 20) & 0xFu; }
#define XB_SPIN(cond, bar) do { unsigned _sp = 0; while (cond) { __builtin_amdgcn_s_sleep(1); \
    if ((++_sp & 255u) == 0u) { if (xb_ld(&(bar)[XB_TMO])) break; if (_sp > XB_SPIN_CAP) { atomicAdd(&(bar)[XB_TMO], 1u); break; } } } } while (0)
struct XcdBarrier { unsigned* bar; unsigned x; volatile LAS unsigned* st; };
DV XcdBarrier xcd_barrier_post(unsigned* bar, volatile LAS unsigned* st) {
    XcdBarrier b; b.bar = bar; b.x = xb_xcc_id(); b.st = st;
    if (threadIdx.x == 0) (void)xb_add(&bar[XB_XCNT(b.x)], 1u);
    return b;
}
DV void xcd_barrier_complete(unsigned* bar, unsigned x, unsigned& nloc, unsigned& nx) {
    const unsigned G = gridDim.x * gridDim.y * gridDim.z;
    unsigned sum, cnt, mine, sp = 0u;
    for (;;) {
        sum = 0u; cnt = 0u; mine = 0u;
#pragma unroll
        for (unsigned j = 0; j < 16; ++j) { const unsigned c = xb_ld(&bar[XB_XCNT(j)]); sum += c; cnt += (c > 0u) ? 1u : 0u; mine = (j == x) ? c : mine; }
        if (sum == G) break;
        __builtin_amdgcn_s_sleep(1);
        if ((++sp & 255u) == 0u) { if (xb_ld(&bar[XB_TMO])) break; if (sp > XB_SPIN_CAP) { atomicAdd(&bar[XB_TMO], 1u); break; } }
    }
    nloc = mine > 0u ? mine : 1u; nx = cnt > 0u ? cnt : 1u;
}
DV void xcd_barrier(const XcdBarrier& b) {
    asm volatile("s_waitcnt vmcnt(0)" ::: "memory");
    __syncthreads();
    if (threadIdx.x == 0) {
        unsigned* bar = b.bar;
        __builtin_amdgcn_s_waitcnt(0);
        unsigned nloc = b.st[0], nx = b.st[1];
        if (nloc == 0u) { xcd_barrier_complete(bar, b.x, nloc, nx); b.st[0] = nloc; b.st[1] = nx; }
        const unsigned old = xb_add(&bar[XB_XSUB(b.x)], 1u);
        const unsigned gen = old / nloc;
        if (old + 1u == (gen + 1u) * nloc) {
            __builtin_amdgcn_fence(__ATOMIC_RELEASE, "agent");
            asm volatile("s_waitcnt vmcnt(0)" ::: "memory");
            const unsigned og = xb_add(&bar[XB_TOP], 1u);
            const unsigned tg = og / nx;
            if (og + 1u == (tg + 1u) * nx) xb_add(&bar[XB_TOPGEN], 1u);
            else XB_SPIN(xb_ld(&bar[XB_TOPGEN]) == tg, bar);
            __builtin_amdgcn_fence(__ATOMIC_ACQUIRE, "agent");
            xb_add(&bar[XB_XGEN(b.x)], 1u);
            asm volatile("s_waitcnt vmcnt(0)" ::: "memory");
        } else {
            XB_SPIN(xb_ld(&bar[XB_XGEN(b.x)]) == gen, bar);
            __builtin_amdgcn_fence(__ATOMIC_ACQUIRE, "agent");
            asm volatile("s_waitcnt vmcnt(0)" ::: "memory");
        }
    }
    __syncthreads();
}
constexpr int LDS_BYTES = 139264 + 1024 + 288 * 8 + 256;
constexpr int PH_PER_LAYER = 13, NPHASE = 1 + DEPTH * PH_PER_LAYER;
DV void convert_experts(KParams p, int bid, int nblk) {
    const int lane = tid_() & 63, wv = wave_();
#pragma unroll 1
    for (int r = bid * 8 + wv; r < 4 * NEXP; r += nblk * 8) {
        const int tab = r / NEXP, e = r - tab * NEXP, l = tab >> 1, uv = tab & 1;
        unsigned char* dstb = p->ws + WS_EXP + (size_t)tab * SZ_EXP1;
        const float* src = p->in[23 + uv] + ((size_t)l * NEXP + e) * D + lane * 4;
        f32x4 v[4];
#pragma unroll
        for (int j = 0; j < 4; ++j) v[j] = *(const f32x4*)(src + 256 * j);
        float bmj[4];
#pragma unroll
        for (int j = 0; j < 4; ++j) {
            float bm = fmaxf(fmaxf(fabsf(v[j].x), fabsf(v[j].y)), fmaxf(fabsf(v[j].z), fabsf(v[j].w))); bm = wave_max(bm);
            bmj[j] = bm * (1.f / 6.f);
            const float es = bm > 0.f ? 6.f / bm : 0.f;
            unsigned pk = 0;
            pk = __builtin_amdgcn_cvt_scalef32_pk_fp4_f32(pk, v[j].x * es, v[j].y * es, 1.0f, 0);
            pk = __builtin_amdgcn_cvt_scalef32_pk_fp4_f32(pk, v[j].z * es, v[j].w * es, 1.0f, 1);
            *(unsigned short*)(dstb + (size_t)j * SLICE_BYTES + (size_t)e * 128 + 2 * lane) = (unsigned short)pk;
        }
        if (lane == 0) {
            unsigned char* rec = p->ws + WS_EXP + (size_t)(2 * l) * SZ_EXP1 + NSL * SLICE_BYTES + (size_t)e * 32 + uv * 16;
            *(f32x4*)rec = (f32x4){bmj[0], bmj[1], bmj[2], bmj[3]}; }
    }
}
DV void run_phase0(KParams p, unsigned char* smem) {
    const int bid = blockIdx.x, nblk = gridDim.x;
    cvt_job(p->in[0], (bf16_t*)(p->ws + WS_XB), (size_t)2 * SEQL * D, bid, nblk);
    cvt_job(p->in[1], (bf16_t*)(p->ws + WS_XB) + (size_t)2 * SEQL * D, (size_t)SEQL * D, bid, nblk);
    cvt_job(p->in[2], (bf16_t*)(p->ws + WS_MEMB), (size_t)2 * N_MEM * D, bid, nblk);
    cvt_job(p->in[3], (bf16_t*)(p->ws + WS_MEMB) + (size_t)2 * N_MEM * D, (size_t)N_MEM * D, bid, nblk);
#pragma unroll 1
    for (int l = 0; l < DEPTH; ++l) {
        unsigned char* wl = p->ws + WS_W + l * SZ_WL;
        cvt_job(p->in[22] + (size_t)l * 8 * 2 * 128 * 128, (bf16_t*)(wl + OFF_SK), (size_t)8 * 2 * 128 * 128, bid, nblk);
        transpose_job(p->in[5] + (size_t)l * D * IN_WIDTH, D, IN_WIDTH, (bf16_t*)(wl + OFF_WT_IN), bid, nblk, (float*)smem);
#pragma unroll 1
        for (int n = 0; n < 3; ++n) transpose_job(p->in[17] + ((size_t)l * 3 + n) * 512 * D, 512, D, (bf16_t*)(wl + OFF_WT_BR) + (size_t)n * D * 512, bid, nblk, (float*)smem);
        transpose_job(p->in[18] + (size_t)l * D * D, D, D, (bf16_t*)(wl + OFF_WT_OUT), bid, nblk, (float*)smem);
        transpose_job(p->in[21] + (size_t)l * D * 2048, D, 2048, (bf16_t*)(wl + OFF_WT_Q), bid, nblk, (float*)smem);
        transpose_job(p->in[16] + (size_t)l * D * D, D, D, (bf16_t*)(wl + OFF_WT_MKV), bid, nblk, (float*)smem);
        transpose_job(p->in[14] + (size_t)l * FHID * 2048, FHID, 2048, (bf16_t*)(p->ws + WS_WOT) + (size_t)l * 2048 * FHID, bid, nblk, (float*)smem);
    }
    for (int k = bid * NTH + tid_(); k < 16384; k += nblk * NTH) { float sn, cs; sincospif((float)k * (1.f / 16384.f), &sn, &cs); ((float2*)(p->ws + WS_TW))[k] = make_float2(cs, -sn); }
    convert_experts(p, bid, nblk);
    filter_mlp_job(p, bid, nblk);
}
#ifndef ONLY_Q
#define ONLY_Q -1
#endif
template <int Q> DV void run_phase_q(KParams p, int l, unsigned char* smem) {
    const int bid = opaque_s(blockIdx.x), nblk = opaque_s(gridDim.x);
    if (ONLY_Q >= 0 && Q != ONLY_Q) return;
    if (Q == 0) {
        SchedG1 S{p, l, nblk, bid}; EpiG1 E{p, l};
        __syncthreads();
        pg8::gemm_stream(( LAS unsigned char*)smem, S, E);
    } else if (Q == 1) {
        const int na = 768, nm = 768, nf = 1024, ns = NSEQ * 64 * 24;
#pragma unroll 1
        for (int t = bid; t < na + nm + nf + ns; t += nblk) {
            if (t < na) attn_item<true>(p, l, t, smem);
            else if (t < na + nm) attn_item<false>(p, l, t - na, smem);
            else if (t < na + nm + nf) filt_tile(p, l, t - na - nm, smem);
            else shortconv_item(p, l, t - na - nm - nf, (float*)smem);
        }
    } else if (Q == 2) {
#pragma unroll 1
        for (int c = bid; c < HYW; c += nblk) hyena_item(p, l, c, smem);
    } else if (Q == 3) {
#pragma unroll 1
        for (int t = bid; t < NSEQ * 64 * 8; t += nblk) hyo_transpose_item(p, t, (bf16_t*)smem);
    } else if (Q == 4) {
        SchedMerge S{p, l, nblk, bid}; EpiMerge E{p, l};
        __syncthreads();
        pg8::gemm_stream((LAS unsigned char*)smem, S, E);
    } else if (Q == 5) {
        SchedOut S{p, l, nblk, bid}; EpiOut E{p};
        __syncthreads();
        pg8::gemm_stream((LAS unsigned char*)smem, S, E);
    } else if (Q == 6) ln1_job(p, l, bid, nblk);
    else if (Q == 7) {
        SchedQ S{p, l, nblk, bid}; EpiQ E{p};
        __syncthreads();
        pg8::gemm_stream((LAS unsigned char*)smem, S, E);
    } else if (Q == 8) {
        const int h = bid & 7, b8 = bid >> 3, nb8 = nblk >> 3;
        peer_stage_sk(p, l, h, (bf16_t*)smem);
        bf16x8 bqn[2][4];
        if (b8 < T / 128) peer_topk_loadq(p, b8, h, bqn);
#pragma unroll 1
        for (int tile = b8; tile < T / 128; tile += nb8) {
            bf16x8 bqc[2][4];
#pragma unroll
            for (int c = 0; c < 2; ++c)
#pragma unroll
                for (int ks = 0; ks < 4; ++ks) bqc[c][ks] = bqn[c][ks];
            if (tile + nb8 < T / 128) peer_topk_loadq(p, tile + nb8, h, bqn);
            peer_topk_item(p, l, tile, h, (bf16_t*)smem, bqc);
        }
    } else if (Q == 9) peer_u_phase(p, l, bid, nblk);
    else if (Q == 11) peer_v_phase(p, l, bid, nblk);
    else if (Q == 10) peer_c_phase(p, l, bid, nblk);
    else ln2_job(p, l, bid, nblk);
}
#ifdef PROBE_PHASE
#define PROBE_STAMP(i) { if (blockIdx.x == 0 && threadIdx.x == 0) __hip_atomic_store((unsigned long long*)(p.ws + WS_TS) + (i), (unsigned long long)__builtin_amdgcn_s_memrealtime(), __ATOMIC_RELAXED, __HIP_MEMORY_SCOPE_AGENT); }
#else
#define PROBE_STAMP(i)
#endif
#define PHASE_STEP(Q) { const int ph = 1 + l * PH_PER_LAYER + Q; if (ph >= p.ph_lo && ph < p.ph_hi) { run_phase_q<Q>(kparams(), l, smem); if (ph + 1 < p.ph_hi) GRID_SYNC(); PROBE_STAMP(ph + 1) } }
__global__ void __launch_bounds__(NTH, 2) encoder_fwd(Params p) {
    extern __shared__ __attribute__((aligned(16))) unsigned char smem[];
    cg::grid_group grid = cg::this_grid();
    PROBE_STAMP(0)
    volatile LAS unsigned* xst = (volatile LAS unsigned*)(smem + LDS_BYTES - 16);
    unsigned* xbar = (unsigned*)(p.ws + WS_BAR);
    if (threadIdx.x == 0) { xst[0] = 0u; xst[1] = 0u; }
    if (p.ph_lo == 0 && blockIdx.x == 0) for (int i = threadIdx.x; i < XCD_BAR_WORDS; i += NTH) __hip_atomic_store(xbar + i, 0u, __ATOMIC_RELAXED, __HIP_MEMORY_SCOPE_AGENT);
    XcdBarrier xb; xb.bar = xbar; xb.x = 0; xb.st = xst;
#define GRID_SYNC() xcd_barrier(xb)
    if (p.ph_lo == 0) { if (ONLY_Q < 0 || ONLY_Q == 100) run_phase0(kparams(), smem); if (1 < p.ph_hi) { grid.sync(); xb = xcd_barrier_post(xbar, xst); } PROBE_STAMP(1) }
#pragma unroll 1
    for (int l = 0; l < DEPTH; ++l) {
        PHASE_STEP(0) PHASE_STEP(1) PHASE_STEP(2) PHASE_STEP(3) PHASE_STEP(4) PHASE_STEP(5) PHASE_STEP(6) PHASE_STEP(7) PHASE_STEP(8) PHASE_STEP(9) PHASE_STEP(10) PHASE_STEP(11) PHASE_STEP(12)
    }
#ifdef PROBE_PHASE
#ifndef PROBE_END
#define PROBE_END (PROBE_PHASE + 1)
#endif
    GRID_SYNC();
    PROBE_STAMP(NPHASE)
    GRID_SYNC();
    {
        const unsigned long long* ts = (const unsigned long long*)(p.ws + WS_TS);
        const unsigned long long t0 = __hip_atomic_load(ts, __ATOMIC_RELAXED, __HIP_MEMORY_SCOPE_AGENT), t1 = __hip_atomic_load(ts + NPHASE, __ATOMIC_RELAXED, __HIP_MEMORY_SCOPE_AGENT);
        const unsigned long long ta = __hip_atomic_load(ts + PROBE_PHASE, __ATOMIC_RELAXED, __HIP_MEMORY_SCOPE_AGENT), tb = __hip_atomic_load(ts + PROBE_END, __ATOMIC_RELAXED, __HIP_MEMORY_SCOPE_AGENT);
        const float f = (float)(tb - ta) / (float)(t1 - t0);
        const float sc = 1.f + sqrtf(6e-4f * f);
        f32x4* o = (f32x4*)(p.out + (size_t)2 * SEQL * D);
        for (size_t i = (size_t)blockIdx.x * NTH + threadIdx.x; i < (size_t)SEQL * D / 4; i += (size_t)gridDim.x * NTH) o[i] = o[i] * sc;
    }
#endif
}

#ifndef ONE_LAUNCH
#define ONE_LAUNCH 1
#endif
extern "C" void kernel_launch(void* const* d_in, const int* in_sizes, int n_in, void* d_out, int out_size, void* d_ws, size_t ws_size, hipStream_t stream) {
    static int grid = 0;
    if (grid == 0) {
        if (n_in != 27 || out_size != T * D || ws_size < WS_END) { fprintf(stderr, "kernel_launch: unexpected shapes: n_in %d out %d ws %zu (need %zu)\n", n_in, out_size, ws_size, (size_t)WS_END); grid = -1; return; }
        int dev = 0, cus = 0, per_cu = 0;
        hipGetDevice(&dev);
        hipDeviceGetAttribute(&cus, hipDeviceAttributeMultiprocessorCount, dev);
        if (hipFuncSetAttribute((const void*)encoder_fwd, hipFuncAttributeMaxDynamicSharedMemorySize, LDS_BYTES) != hipSuccess) { fprintf(stderr, "kernel_launch: hipFuncSetAttribute failed\n"); grid = -1; return; }
        if (hipOccupancyMaxActiveBlocksPerMultiprocessor(&per_cu, (const void*)encoder_fwd, NTH, LDS_BYTES) != hipSuccess || per_cu < 1) { fprintf(stderr, "kernel_launch: occupancy query failed (%d)\n", per_cu); grid = -1; return; }
        grid = cus < MAX_GRID ? cus : MAX_GRID; grid &= ~7;
        fprintf(stderr, "kernel_launch: cus %d per_cu %d grid %d ws %zu need %zu\n", cus, per_cu, grid, ws_size, (size_t)WS_END);
    }
    if (grid < 0) return;
    Params p{};
    for (int i = 0; i < 27; ++i) p.in[i] = (const float*)d_in[i];
    p.out = (float*)d_out; p.ws = (unsigned char*)d_ws;
#if ONE_LAUNCH
    p.ph_lo = 0; p.ph_hi = NPHASE;
    void* args[] = {&p};
    hipError_t e = hipLaunchCooperativeKernel((const void*)encoder_fwd, dim3(grid), dim3(NTH), args, LDS_BYTES, stream);
    if (e != hipSuccess) fprintf(stderr, "cooperative launch failed: %s (grid %d)\n", hipGetErrorString(e), grid);
#else
    for (int ph = 0; ph < NPHASE; ++ph) {
        p.ph_lo = ph; p.ph_hi = ph + 1;
        hipLaunchKernelGGL(encoder_fwd, dim3(grid), dim3(NTH), LDS_BYTES, stream, p);
    }
#endif
}
```

```cpp
#include <hip/hip_runtime.h>
#include <hip/hip_cooperative_groups.h>
#include <cstdio>
#include <cmath>
namespace cg = cooperative_groups;

#define HD __host__ __device__ __forceinline__
#define DV __device__ __forceinline__

typedef unsigned short bf16_t;
typedef short bf16x8 __attribute__((ext_vector_type(8)));
typedef float f32x4 __attribute__((ext_vector_type(4)));
typedef unsigned u32x4 __attribute__((ext_vector_type(4)));
typedef unsigned u32x2 __attribute__((ext_vector_type(2)));
typedef _Float16 f16_t;

constexpr int NTH = 512;
constexpr int D = 1024, NSEQ = 3, SEQL = 16384, T = NSEQ * SEQL, DEPTH = 2;
constexpr int N_MEM = 256;
constexpr int IN_WIDTH = 5888, O_K = 512, O_V = 640, O_HY = 768, O_MQ = 2304, O_GATE = 2816;
constexpr int HYW = 512, HY3 = 1536;
constexpr int FEMB = 33, FHID = 64;
constexpr int NEXP = 16384;
constexpr float ALPHA = 1.4142135623730951f;
constexpr float LN_EPS = 1e-5f;

constexpr size_t SZ_WT_IN = (size_t)IN_WIDTH * D * 2, SZ_WT_BR = (size_t)3 * D * 512 * 2, SZ_WT_OUT = (size_t)D * D * 2,
                 SZ_WT_Q = (size_t)2048 * D * 2, SZ_WT_MKV = (size_t)D * D * 2, SZ_SK = (size_t)8 * 2 * 128 * 128 * 2;
constexpr size_t OFF_WT_IN = 0, OFF_WT_BR = OFF_WT_IN + SZ_WT_IN, OFF_WT_OUT = OFF_WT_BR + SZ_WT_BR, OFF_WT_Q = OFF_WT_OUT + SZ_WT_OUT,
                 OFF_WT_MKV = OFF_WT_Q + SZ_WT_Q, OFF_SK = OFF_WT_MKV + SZ_WT_MKV, SZ_WL = OFF_SK + SZ_SK;
constexpr size_t WS_W = 0;
constexpr size_t WS_EXP = WS_W + 2 * SZ_WL;
constexpr size_t SZ_EXP1 = (size_t)NEXP * D + (size_t)NEXP * 4;
constexpr size_t WS_XB = WS_EXP + 4 * SZ_EXP1;
constexpr size_t WS_QKV = WS_XB + (size_t)T * D * 2;
constexpr size_t WS_HY = WS_QKV + (size_t)T * 768 * 2;
constexpr size_t WS_MEMB = WS_HY + (size_t)T * HY3 * 2;
constexpr size_t WS_KVMEM = WS_MEMB + (size_t)768 * D * 2;
constexpr size_t WS_H3 = WS_KVMEM + (size_t)2 * 768 * D * 2;
constexpr size_t WS_WOT = WS_H3 + (size_t)2 * 64 * SEQL * 2;
constexpr size_t WS_FILT = WS_WOT + (size_t)2 * 2048 * 64 * 2;
constexpr int MAX_GRID = 256;
constexpr size_t WS_HSCR = WS_HY;
static_assert((size_t)MAX_GRID * 2 * 8192 * 16 <= (size_t)T * HY3 * 2, "HSCR overlay");
constexpr size_t WS_TS = WS_FILT + (size_t)2048 * SEQL * 2;
constexpr size_t WS_TW = WS_TS + 1024;
constexpr size_t WS_BAR = WS_TW + (size_t)16384 * 8;
constexpr size_t WS_END = WS_BAR + 16384;
constexpr size_t WS_EIDX = WS_QKV;
constexpr size_t WS_GATE = WS_EIDX + (size_t)T * 128 * 2;
constexpr size_t WS_COEF = WS_GATE + (size_t)T * 128 * 4;
constexpr size_t WS_EIDXN = WS_COEF + (size_t)T * 128 * 2;
constexpr size_t WS_X8 = WS_HY;
static_assert(WS_EIDXN + (size_t)T * 128 * 2 <= WS_HY, "eidx copy overflows the qkv region");
static_assert(WS_COEF + (size_t)T * 128 * 4 <= WS_HY, "PEER buffers overlay qkv");
constexpr size_t DO_UCT = 0, DO_QM = (size_t)NSEQ * HY3 * SEQL * 2;

struct Params {
    const float* in[27];
    float* out;
    unsigned char* ws;
    int ph_lo, ph_hi;
};

HD bf16_t f2bf(float f) {
    unsigned u = __builtin_bit_cast(unsigned, f);
    u += 0x7fffu + ((u >> 16) & 1u);
    return (bf16_t)(u >> 16);
}
HD float bf2f(bf16_t h) { return __builtin_bit_cast(float, (unsigned)h << 16); }
typedef __bf16 bf16x2_hw __attribute__((ext_vector_type(2)));
typedef float f32x2_cv __attribute__((ext_vector_type(2)));
HD unsigned pk2(float lo, float hi) {
#if defined(__HIP_DEVICE_COMPILE__)
    return __builtin_bit_cast(unsigned, __builtin_convertvector((f32x2_cv){lo, hi}, bf16x2_hw));
#else
    return (unsigned)f2bf(lo) | ((unsigned)f2bf(hi) << 16);
#endif
}
HD float bflo(unsigned w) { return __builtin_bit_cast(float, w << 16); }
HD float bfhi(unsigned w) { return __builtin_bit_cast(float, w & 0xffff0000u); }

HD float2 cadd(float2 a, float2 b) { return make_float2(a.x + b.x, a.y + b.y); }
HD float2 csub(float2 a, float2 b) { return make_float2(a.x - b.x, a.y - b.y); }
HD float2 cmul(float2 a, float2 b) { return make_float2(a.x * b.x - a.y * b.y, a.x * b.y + a.y * b.x); }
HD float2 cmulc(float2 a, float2 b) { return make_float2(a.x * b.x + a.y * b.y, a.y * b.x - a.x * b.y); }
HD float2 cconj(float2 a) { return make_float2(a.x, -a.y); }

constexpr int FN = 16384;
HD int PI(int p) { return p + ((p >> 5) << 1); }
constexpr int FBUF_F2 = FN + (FN >> 5) * 2;
HD int fpos(int k) { return ((k & 15) << 10) | (((k >> 4) & 15) << 6) | (((k >> 8) & 3) << 4) | (k >> 10); }
HD int frev(int p) { return (p >> 10) | (((p >> 6) & 15) << 4) | (((p >> 4) & 3) << 8) | ((p & 15) << 10); }

typedef float v2f __attribute__((ext_vector_type(2)));
typedef _Float16 h2 __attribute__((ext_vector_type(2)));
template <class V> HD V mk2(float a, float b);
template <> HD v2f mk2<v2f>(float a, float b) { return (v2f){a, b}; }
template <> HD h2 mk2<h2>(float a, float b) { return (h2){(_Float16)a, (_Float16)b}; }
HD v2f tof(v2f a) { return a; }
HD v2f tof(h2 a) { return (v2f){(float)a.x, (float)a.y}; }
template <class V> HD V vswap(V a) { return __builtin_shufflevector(a, a, 1, 0); }
template <class V> HD V cmulv(V a, V w) { const V wr = __builtin_shufflevector(w, w, 0, 0); V wi = w; wi.x = -w.y; wi.y = w.y; return a * wr + vswap(a) * wi; }
template <class V> HD V rot_mi(V a) { return vswap(a) * mk2<V>(1.f, -1.f); }
template <class V> HD V rot_pi(V a) { return vswap(a) * mk2<V>(-1.f, 1.f); }
template <bool INV, class V> HD void dft4(V& a, V& b, V& c, V& d) {
    const V t0 = a + c, t1 = a - c, t2 = b + d, t3 = b - d;
    a = t0 + t2; c = t0 - t2;
    if (!INV) { b = t1 + rot_mi(t3); d = t1 + rot_pi(t3); }
    else      { b = t1 + rot_pi(t3); d = t1 + rot_mi(t3); }
}
template <bool INV, class V> HD void dft16(V (&x)[16]) {
    const float C1 = 0.92387953251128674f, S1 = 0.38268343236508977f, R2 = 0.70710678118654752f;
#pragma unroll
    for (int a = 0; a < 4; ++a) dft4<INV, V>(x[a], x[a + 4], x[a + 8], x[a + 12]);
    const float sg = INV ? 1.f : -1.f;
    x[1 + 4] = cmulv(x[1 + 4], mk2<V>(C1, sg * S1));
    x[1 + 8] = cmulv(x[1 + 8], mk2<V>(R2, sg * R2));
    x[1 + 12] = cmulv(x[1 + 12], mk2<V>(S1, sg * C1));
    x[2 + 4] = cmulv(x[2 + 4], mk2<V>(R2, sg * R2));
    x[2 + 8] = INV ? rot_pi(x[2 + 8]) : rot_mi(x[2 + 8]);
    x[2 + 12] = cmulv(x[2 + 12], mk2<V>(-R2, sg * R2));
    x[3 + 4] = cmulv(x[3 + 4], mk2<V>(S1, sg * C1));
    x[3 + 8] = cmulv(x[3 + 8], mk2<V>(-R2, sg * R2));
    x[3 + 12] = cmulv(x[3 + 12], mk2<V>(-C1, -sg * S1));
#pragma unroll
    for (int b = 0; b < 4; ++b) dft4<INV, V>(x[4 * b], x[4 * b + 1], x[4 * b + 2], x[4 * b + 3]);
}
HD float2 twid(float frac) {
    float s, c;
#if defined(__HIP_DEVICE_COMPILE__)
    sincospif(2.f * frac, &s, &c);
#else
    s = sinf(6.283185307179586f * frac); c = cosf(6.283185307179586f * frac);
#endif
    return make_float2(c, -s);
}
HD float2 twnf(const float2* tw, int j, int n) {
#if defined(__HIP_DEVICE_COMPILE__)
    return tw[j * (32768 / n)];
#else
    (void)tw; return twid((float)j / (float)n);
#endif
}
HD int PIx(v2f*, int p) { return p + ((p >> 5) << 1); }
HD int PIx(h2*, int p) { return p + ((p >> 6) << 2); }
constexpr int FBUF_H2 = FN + (FN >> 6) * 4;
template <int STRIDE> HD constexpr int poffx(v2f*, int m) { return STRIDE >= 32 ? m * (STRIDE + 2 * (STRIDE / 32)) : (STRIDE == 16 ? 16 * m + 2 * (m >> 1) : m); }
template <int STRIDE> HD constexpr int poffx(h2*, int m) { return STRIDE >= 64 ? m * (STRIDE + 4 * (STRIDE / 64)) : m * STRIDE; }
template <class V> HD void wpowers(V w1, V (&w)[16]) {
    w[1] = w1; w[2] = cmulv(w1, w1); w[3] = cmulv(w[2], w1); w[4] = cmulv(w[2], w[2]);
    w[5] = cmulv(w[4], w1); w[6] = cmulv(w[4], w[2]); w[7] = cmulv(w[4], w[3]); w[8] = cmulv(w[4], w[4]);
#pragma unroll
    for (int i = 1; i < 8; ++i) w[8 + i] = cmulv(w[8], w[i]);
}
template <bool INV, int N, int STRIDE, class V> HD void bfly16_core(V (&x)[16], unsigned j, const float2* tw) {
    if (STRIDE > 1) {
        const float2 t = twnf(tw, (int)j, N);
        V w[16]; wpowers(mk2<V>(t.x, INV ? -t.y : t.y), w);
        if (INV) {
#pragma unroll
            for (int m = 1; m < 16; ++m) x[m] = cmulv(x[m], w[m]);
            dft16<INV, V>(x);
        } else {
            dft16<INV, V>(x);
#pragma unroll
            for (int q = 1; q < 16; ++q) { const int s = (q >> 2) + 4 * (q & 3); x[s] = cmulv(x[s], w[q]); }
        }
    } else dft16<INV, V>(x);
}
template <bool INV, int N, int STRIDE, class V> HD void fft_bfly16(V* buf, unsigned bf, const float2* tw) {
    const unsigned blk = bf / STRIDE, j = bf % STRIDE, base = blk * N + j;
    V* b = buf + PIx((V*)nullptr, (int)base);
    V x[16];
#pragma unroll
    for (int m = 0; m < 16; ++m) x[m] = b[poffx<STRIDE>((V*)nullptr, m)];
    bfly16_core<INV, N, STRIDE, V>(x, j, tw);
#pragma unroll
    for (int q = 0; q < 16; ++q) b[poffx<STRIDE>((V*)nullptr, q)] = x[(q >> 2) + 4 * (q & 3)];
}
template <bool INV, int N, int STRIDE, class V> HD void fft_bfly4(V* buf, unsigned bf, const float2* tw) {
    const unsigned blk = bf / STRIDE, j = bf % STRIDE, base = blk * N + j;
    V* b = buf + PIx((V*)nullptr, (int)base);
    V x[4];
#pragma unroll
    for (int m = 0; m < 4; ++m) x[m] = b[poffx<STRIDE>((V*)nullptr, m)];
    const float2 t = twnf(tw, (int)j, N);
    const V w1 = mk2<V>(t.x, INV ? -t.y : t.y), w2 = cmulv(w1, w1), w3 = cmulv(w2, w1);
    if (INV) { x[1] = cmulv(x[1], w1); x[2] = cmulv(x[2], w2); x[3] = cmulv(x[3], w3); }
    dft4<INV, V>(x[0], x[1], x[2], x[3]);
    if (!INV) { x[1] = cmulv(x[1], w1); x[2] = cmulv(x[2], w2); x[3] = cmulv(x[3], w3); }
#pragma unroll
    for (int q = 0; q < 4; ++q) b[poffx<STRIDE>((V*)nullptr, q)] = x[q];
}
#ifndef HYV
#define HYV h2
#endif
template <class V> struct YScale { static constexpr float v = 1.f; };
template <> struct YScale<h2> { static constexpr float v = 128.f; };
constexpr float HY_YS = YScale<HYV>::v;
HD unsigned ldpairw(const bf16_t* p, unsigned bf, int m) { return *(const unsigned*)(p + 2 * (bf + 1024u * (unsigned)m)); }
HD v2f pairf(unsigned w) { return (v2f){bflo(w), bfhi(w)}; }
HD void hy_load8(const bf16_t* p, unsigned bf, unsigned (&w)[8]) {
#pragma unroll
    for (int m = 0; m < 8; ++m) w[m] = ldpairw(p, bf, m);
}
template <class V> HD void hy_step_a(V* buf, unsigned bf, const unsigned (&pa)[8], const float2* tw) {
    V x[16];
#pragma unroll
    for (int m = 0; m < 8; ++m) x[m] = mk2<V>(bflo(pa[m]), bfhi(pa[m]));
#pragma unroll
    for (int m = 8; m < 16; ++m) x[m] = mk2<V>(0.f, 0.f);
    bfly16_core<false, 16384, 1024, V>(x, bf, tw);
    V* b = buf + PIx((V*)nullptr, (int)bf);
#pragma unroll
    for (int q = 0; q < 16; ++q) b[poffx<1024>((V*)nullptr, q)] = x[(q >> 2) + 4 * (q & 3)];
}
template <class V> HD void hy_step_b(V* buf, unsigned bf, const unsigned (&pa)[8], const unsigned (&pb)[8], float bias0, float ys, v2f (&z1)[8], const float2* tw) {
    V* b = buf + PIx((V*)nullptr, (int)bf);
    V x[16];
#pragma unroll
    for (int m = 0; m < 16; ++m) x[m] = b[poffx<1024>((V*)nullptr, m)];
    bfly16_core<true, 16384, 1024, V>(x, bf, tw);
    V y[16];
#pragma unroll
    for (int q = 0; q < 8; ++q) { const v2f a = pairf(pa[q]), c = pairf(pb[q]); z1[q] = c * (tof(x[(q >> 2) + 4 * (q & 3)]) * ys + a * bias0); y[q] = mk2<V>(z1[q].x, z1[q].y); }
#pragma unroll
    for (int q = 8; q < 16; ++q) y[q] = mk2<V>(0.f, 0.f);
    bfly16_core<false, 16384, 1024, V>(y, bf, tw);
#pragma unroll
    for (int q = 0; q < 16; ++q) b[poffx<1024>((V*)nullptr, q)] = y[(q >> 2) + 4 * (q & 3)];
}
template <class V> HD void hy_step_c(const V* buf, unsigned bf, const unsigned (&pc)[8], const v2f (&z1)[8], float bias1, float ys, bf16_t* outp, const float2* tw) {
    const V* b = buf + PIx((V*)nullptr, (int)bf);
    V x[16];
#pragma unroll
    for (int m = 0; m < 16; ++m) x[m] = b[poffx<1024>((V*)nullptr, m)];
    bfly16_core<true, 16384, 1024, V>(x, bf, tw);
#pragma unroll
    for (int q = 0; q < 8; ++q) { const v2f c = pairf(pc[q]); const v2f o = c * (tof(x[(q >> 2) + 4 * (q & 3)]) * ys + z1[q] * bias1);
        *(unsigned*)(outp + 2 * (bf + 1024u * (unsigned)q)) = pk2(o.x, o.y); }
}
template <bool INV, class V> HD void fft_pass(V* buf, int p, int tid, const float2* tw = nullptr) {
    const int pp = INV ? 3 - p : p;
    if (pp == 0) {
#pragma unroll 2
        for (int i = 0; i < 2; ++i) fft_bfly16<INV, 16384, 1024, V>(buf, (unsigned)(tid + NTH * i), tw); }
    else if (pp == 1) {
#pragma unroll 2
        for (int i = 0; i < 2; ++i) fft_bfly16<INV, 1024, 64, V>(buf, (unsigned)(tid + NTH * i), tw); }
    else if (pp == 2) {
#pragma unroll 2
        for (int i = 0; i < 8; ++i) fft_bfly4<INV, 64, 16, V>(buf, (unsigned)(tid + NTH * i), tw); }
    else {
#pragma unroll 2
        for (int i = 0; i < 2; ++i) fft_bfly16<INV, 16, 1, V>(buf, (unsigned)(tid + NTH * i), tw); }
}
struct HPair { float2 hk, hl; };
HD void pair_unpack(float2 ck, float2 cl, float2 w, float2& ak, float2& al) {
    const float2 e = make_float2(0.5f * (ck.x + cl.x), 0.5f * (ck.y - cl.y));
    const float2 dd = make_float2(0.5f * (ck.x - cl.x), 0.5f * (ck.y + cl.y));
    const float2 o = make_float2(dd.y, -dd.x);
    const float2 wo = cmul(w, o);
    ak = cadd(e, wo); al = cconj(csub(e, wo));
}
HD void pair_pack(float2 yk, float2 yl, float2 w, float2& dk, float2& dl) {
    const float2 ye = make_float2(0.5f * (yk.x + yl.x), 0.5f * (yk.y - yl.y));
    const float2 dd = make_float2(0.5f * (yk.x - yl.x), 0.5f * (yk.y + yl.y));
    const float2 yo = cmulc(dd, w);
    dk = make_float2(ye.x - yo.y, ye.y + yo.x);
    dl = make_float2(ye.x + yo.y, -ye.y + yo.x);
}
HD void pair_item_pos(int e, int& p, int& k, int& pl) { p = 16 * (e >> 3) + (e & 7); k = frev(p); pl = fpos((FN - k) & (FN - 1)); }
HD float2 twn2(const float2* t12, int k) {
#if defined(__HIP_DEVICE_COMPILE__)
    return cmul(t12[k & 255], t12[256 + (k >> 8)]);
#else
    (void)t12; return twid((float)k / (float)(2 * FN));
#endif
}
HD float2 ldc(const v2f* b, int p) { const v2f v = b[PIx((v2f*)nullptr, p)]; return make_float2(v.x, v.y); }
HD float2 ldc(const h2* b, int p) { const h2 v = b[PIx((h2*)nullptr, p)]; return make_float2((float)v.x, (float)v.y); }
HD void stc(v2f* b, int p, float2 v) { b[PIx((v2f*)nullptr, p)] = (v2f){v.x, v.y}; }
HD void stc(h2* b, int p, float2 v) { b[PIx((h2*)nullptr, p)] = mk2<h2>(v.x, v.y); }
HD HPair pair_filter(const v2f* buf, int e, float sc, const float2* tw = nullptr) {
    int p, k, pl; pair_item_pos(e, p, k, pl);
    HPair h;
    if (e == 0) {
        const float2 c0 = ldc(buf, 0), c8 = ldc(buf, fpos(FN / 2));
        h.hk = make_float2((c0.x + c0.y) * sc, (c0.x - c0.y) * sc);
        h.hl = make_float2(c8.x * sc, -c8.y * sc);
        return h;
    }
    const float2 ck = ldc(buf, p), cl = ldc(buf, pl);
    float2 ak, al; pair_unpack(ck, cl, twn2(tw, k), ak, al);
    h.hk = make_float2(ak.x * sc, ak.y * sc); h.hl = make_float2(al.x * sc, al.y * sc);
    return h;
}
template <class V> HD void pair_apply(V* buf, int e, const HPair& h, const float2* tw = nullptr) {
    int p, k, pl; pair_item_pos(e, p, k, pl);
    if (e == 0) {
        const float2 c0 = ldc(buf, 0);
        const float y0 = (c0.x + c0.y) * h.hk.x, yL = (c0.x - c0.y) * h.hk.y;
        stc(buf, 0, make_float2(0.5f * (y0 + yL), 0.5f * (y0 - yL)));
        const int p8 = fpos(FN / 2);
        const float2 c8 = ldc(buf, p8);
        const float2 y8 = cmul(cconj(c8), h.hl);
        stc(buf, p8, cconj(y8));
        return;
    }
    const float2 ck = ldc(buf, p), cl = ldc(buf, pl);
    const float2 w = twn2(tw, k);
    float2 ak, al; pair_unpack(ck, cl, w, ak, al);
    const float2 yk = cmul(ak, h.hk), yl = cmul(al, h.hl);
    float2 dk, dl; pair_pack(yk, yl, w, dk, dl);
    stc(buf, p, dk); stc(buf, pl, dl);
}
struct PairCtx { int pp, plA, plB, k0; };
HD int pair_fhi(int y) { return ((y & 15) << 6) | (((y >> 4) & 3) << 4) | (y >> 6); }
HD PairCtx pair_ctx(int tid) {
    PairCtx c; const int p0 = 16 * (tid >> 3) + (tid & 7), k0 = frev(p0), x0 = ((FN - k0) & (FN - 1)) >> 4;
    c.pp = PIx((h2*)nullptr, p0); c.plA = PIx((h2*)nullptr, pair_fhi(x0)); c.plB = PIx((h2*)nullptr, pair_fhi((x0 - 1) & 1023)); c.k0 = k0; return c;
}
template <int I> HD void pair_apply_fast(h2* buf, const PairCtx& c, int tid, const HPair& h, const float2* tw) {
    if (I == 0 && tid == 0) { pair_apply<h2>(buf, 0, h, tw); return; }
    h2* bp = buf + c.pp + 1088 * I; h2* bl = buf + (I ? c.plB + 1088 * (16 - I) : c.plA);
    const h2 ck = *bp, cl = *bl;
    const float2 wf = twn2(tw, c.k0 + I); const h2 w = mk2<h2>(wf.x, wf.y);
    const h2 hk = mk2<h2>(h.hk.x, h.hk.y), hl = mk2<h2>(h.hl.x, h.hl.y);
    const h2 cj = mk2<h2>(1.f, -1.f);
    const h2 clc = cl * cj;
    const h2 ep = ck + clc, dp = ck - clc;
    const h2 wo = cmulv(rot_mi(dp), w);
    const h2 ak = ep + wo, alc = ep - wo;
    const h2 yk = cmulv(ak, hk);
    const h2 ylc = cmulv(alc * cj, hl) * cj;
    const h2 yep = yk + ylc, ddp = yk - ylc;
    const h2 iyo = rot_pi(cmulv(ddp, w * cj));
    *bp = yep + iyo;
    *bl = (yep - iyo) * cj;
}
template <class V> struct PairPre { static constexpr float v = 1.f; };
template <> struct PairPre<h2> { static constexpr float v = 0.25f; };
constexpr float PAIR_PRE = PairPre<HYV>::v;
HD int fidx(int n) { return PI(n >> 1) * 2 + (n & 1); }

template <int N> HD void bitonic_sort_desc(unsigned (&k)[N]) {
#pragma unroll
    for (int size = 2; size <= N; size <<= 1)
#pragma unroll
        for (int stride = size >> 1; stride > 0; stride >>= 1)
#pragma unroll
            for (int i = 0; i < N; ++i) { const int j = i ^ stride;
                if (j > i) { const bool up = (i & size) != 0;
                    const unsigned a = k[i], b = k[j], mx = a > b ? a : b, mn = a > b ? b : a;
                    k[i] = up ? mn : mx; k[j] = up ? mx : mn; } }
}
template <int N> HD void bitonic_merge_desc(unsigned (&k)[N]) {
#pragma unroll
    for (int stride = N >> 1; stride > 0; stride >>= 1)
#pragma unroll
        for (int i = 0; i < N; ++i) { const int j = i ^ stride;
            if (j > i) { const unsigned a = k[i], b = k[j]; k[i] = a > b ? a : b; k[j] = a > b ? b : a; } }
}
HD int t5_bucket(int rel) {
    const int n = rel < 0 ? -rel : rel;
    int b = rel > 0 ? 16 : 0;
    if (n < 8) return b + n;
    int nn = n * n, lg = 0;
    while ((nn >> (lg + 1)) != 0) ++lg;
    int large = lg + 2;
    if (large > 15) large = 15;
    return b + large;
}

#define LAS __attribute__((address_space(3)))
#define GAS __attribute__((address_space(1)))
typedef const Params __attribute__((address_space(4)))* KParams;
DV KParams kparams() { KParams kp = (KParams)__builtin_amdgcn_kernarg_segment_ptr(); asm volatile("" : "+s"(kp)); return kp; }
DV int opaque_s(int v) { asm volatile("" : "+s"(v)); return v; }
DV int tid_() { int v = threadIdx.x; asm volatile("" : "+v"(v)); return v; }
DV int wave_() { return __builtin_amdgcn_readfirstlane(tid_() >> 6); }
DV float wave_sum(float v) {
#pragma unroll
    for (int o = 1; o < 64; o <<= 1) v += __shfl_xor(v, o);
    return v;
}
DV float wave_max(float v) {
#pragma unroll
    for (int o = 1; o < 64; o <<= 1) v = fmaxf(v, __shfl_xor(v, o));
    return v;
}
DV void glds16(const void* g, void* l) {
    __builtin_amdgcn_global_load_lds((const GAS unsigned*)g, (LAS unsigned*)l, 16, 0, 0);
}
DV u32x4 ldg16(const void* p) { return *(const u32x4*)p; }
DV void stg16(void* p, u32x4 v) { *(u32x4*)p = v; }

DV void cvt_job(const float* src, bf16_t* dst, size_t n, int bid, int nblk) {
    const size_t n8 = n / 8;
    for (size_t i = (size_t)bid * NTH + tid_(); i < n8; i += (size_t)nblk * NTH) {
        const f32x4 a = *(const f32x4*)(src + i * 8), b = *(const f32x4*)(src + i * 8 + 4);
        u32x4 o; o.x = pk2(a.x, a.y); o.y = pk2(a.z, a.w); o.z = pk2(b.x, b.y); o.w = pk2(b.z, b.w);
        stg16(dst + i * 8, o);
    }
}
DV void transpose_item(const float* W, int K, int N, bf16_t* WT, int item, float* s  ) {
    const int ntn = N / 64, kb = item / ntn, nb = item - kb * ntn, k0 = kb * 64, n0 = nb * 64, tid = tid_();
    __syncthreads();
#pragma unroll
    for (int i = 0; i < 8; ++i) { const int idx = tid + i * NTH, r = idx >> 6, c = idx & 63; s[r * 65 + c] = W[(size_t)(k0 + r) * N + n0 + c]; }
    __syncthreads();
#pragma unroll
    for (int i = 0; i < 4; ++i) { const int idx = tid + i * NTH, n = idx >> 5, kp = idx & 31;
        *(unsigned*)(WT + (size_t)(n0 + n) * K + k0 + 2 * kp) = pk2(s[(2 * kp) * 65 + n], s[(2 * kp + 1) * 65 + n]); }
}
DV void transpose_job(const float* W, int K, int N, bf16_t* WT, int bid, int nblk, float* s) {
    const int items = (K / 64) * (N / 64);
    for (int it = bid; it < items; it += nblk) transpose_item(W, K, N, WT, it, s);
}
DV float rdlane(float v, int lane) { return __builtin_bit_cast(float, __builtin_amdgcn_readlane(__builtin_bit_cast(int, v), lane)); }
DV void filter_mlp_job(KParams p, int bid, int nblk) {
    const int lane = tid_() & 63, wv = wave_();
    bf16_t* h3 = (bf16_t*)(p->ws + WS_H3);
    const int gw = bid * 8 + wv, nw = nblk * 8, l = gw & 1;
    const float* w_in = p->in[10] + (size_t)l * FEMB * FHID;
    const float* w_mid = p->in[11] + (size_t)l * 2 * FHID * FHID;
    const float* fb = p->in[12] + (size_t)l * 3 * FHID;
    const float* ff = p->in[13] + (size_t)l * 3 * FHID;
    unsigned wi[17], wm[2][FHID / 2];
#pragma unroll
    for (int i = 0; i < 16; ++i) wi[i] = pk2(w_in[(2 * i) * FHID + lane], w_in[(2 * i + 1) * FHID + lane]);
    wi[16] = pk2(w_in[32 * FHID + lane], 0.f);
#pragma unroll
    for (int q = 0; q < 2; ++q)
#pragma unroll
        for (int i = 0; i < FHID / 2; ++i) wm[q][i] = pk2(w_mid[(q * FHID + 2 * i) * FHID + lane], w_mid[(q * FHID + 2 * i + 1) * FHID + lane]);
    const float b0 = fb[lane], b1 = fb[FHID + lane], b2 = fb[2 * FHID + lane], f0 = ff[lane], f1 = ff[FHID + lane], f2 = ff[2 * FHID + lane];
#pragma unroll 1
    for (int pos = gw >> 1; pos < SEQL; pos += nw >> 1) {
        const float tt = (float)pos / (float)(SEQL - 1);
        const float wang = 6.283185307179586f * (float)pos / (float)SEQL;
        float zf = 0.f;
        if (lane == 0) zf = tt;
        else if (lane < 33) { const int bi = (lane - 1) & 15; const float band = 1e-4f + (float)bi * ((15.f - 1e-4f) / 15.f); const float ang = wang * band;
            zf = lane <= 16 ? __cosf(ang) : -__sinf(ang); }
        float acc = 0.f;
#pragma unroll
        for (int i = 0; i < 16; ++i) { acc += rdlane(zf, 2 * i) * bflo(wi[i]); acc += rdlane(zf, 2 * i + 1) * bfhi(wi[i]); }
        acc += rdlane(zf, 32) * bflo(wi[16]);
        float h = __sinf(f0 * (acc + b0));
        float a2 = 0.f;
#pragma unroll
        for (int i = 0; i < FHID / 2; ++i) { a2 += rdlane(h, 2 * i) * bflo(wm[0][i]); a2 += rdlane(h, 2 * i + 1) * bfhi(wm[0][i]); }
        h = __sinf(f1 * (a2 + b1));
        a2 = 0.f;
#pragma unroll
        for (int i = 0; i < FHID / 2; ++i) { a2 += rdlane(h, 2 * i) * bflo(wm[1][i]); a2 += rdlane(h, 2 * i + 1) * bfhi(wm[1][i]); }
        h = __sinf(f2 * (a2 + b2));
        h3[((size_t)l * SEQL + pos) * FHID + lane] = f2bf(h);
    }
}

constexpr int G_BM = 256, G_BN = 128, G_BK = 32;
constexpr int G_ABYTES = G_BM * G_BK * 2, G_BBYTES = G_BN * G_BK * 2, G_STAGE = G_ABYTES + G_BBYTES;
constexpr int G_LDS = 2 * G_STAGE;
DV void gemm_stage(const bf16_t* A, int lda, const bf16_t* Bt, int ldb, int kt, unsigned char* sbuf) {
    const int tid = tid_();
#pragma unroll
    for (int i = 0; i < 2; ++i) { const int b = tid * 16 + i * 8192, r = b >> 6, c = (b & 63) >> 1;
        glds16(A + (size_t)r * lda + kt * G_BK + c, sbuf + b); }
    { const int b = tid * 16, r = b >> 6, c = (b & 63) >> 1;
        glds16(Bt + (size_t)r * ldb + kt * G_BK + c, sbuf + G_ABYTES + b); }
}
DV void gemm_kloop(f32x4 (&acc)[4][4], const bf16_t* A, int lda, const bf16_t* Bt, int ldb, int nk, unsigned char* smem) {
    const int lane = tid_() & 63, wid = wave_(), wr = wid >> 1, wc = wid & 1, fr = lane & 15, fq = lane >> 4;
    __syncthreads();
    gemm_stage(A, lda, Bt, ldb, 0, smem);
#pragma unroll 1
    for (int t = 0; t < nk; ++t) {
        unsigned char* cur = smem + (t & 1) * G_STAGE;
        asm volatile("s_waitcnt vmcnt(0)" ::: "memory");
        __syncthreads();
        if (t + 1 < nk) gemm_stage(A, lda, Bt, ldb, t + 1, smem + ((t + 1) & 1) * G_STAGE);
        bf16x8 a[4], b[4];
#pragma unroll
        for (int m = 0; m < 4; ++m) a[m] = *(const bf16x8*)(cur + (wr * 64 + m * 16 + fr) * 64 + fq * 16);
#pragma unroll
        for (int n = 0; n < 4; ++n) b[n] = *(const bf16x8*)(cur + G_ABYTES + (wc * 64 + n * 16 + fr) * 64 + fq * 16);
#pragma unroll
        for (int m = 0; m < 4; ++m)
#pragma unroll
            for (int n = 0; n < 4; ++n) acc[m][n] = __builtin_amdgcn_mfma_f32_16x16x32_bf16(b[n], a[m], acc[m][n], 0, 0, 0);
    }
}
DV void acc_zero(f32x4 (&acc)[4][4]) {
#pragma unroll
    for (int m = 0; m < 4; ++m)
#pragma unroll
        for (int n = 0; n < 4; ++n) acc[m][n] = (f32x4){0.f, 0.f, 0.f, 0.f};
}
struct TileCoord { int row0, col0, wr, wc, fr, fq; };
DV TileCoord tile_coord(int pm, int pn) {
    const int lane = tid_() & 63, wid = wave_();
    TileCoord c; c.row0 = pm * G_BM; c.col0 = pn * G_BN; c.wr = wid >> 1; c.wc = wid & 1; c.fr = lane & 15; c.fq = lane >> 4; return c;
}
DV void epi_store_bf16(const f32x4 (&acc)[4][4], const TileCoord& c, bf16_t* O, int ldo, int ocol0, const float* bias  ) {
#pragma unroll
    for (int n = 0; n < 4; ++n) {
        const int cl = c.wc * 64 + n * 16 + c.fq * 4;
        f32x4 bv = (f32x4){0.f, 0.f, 0.f, 0.f};
        if (bias) bv = *(const f32x4*)(bias + cl);
#pragma unroll
        for (int m = 0; m < 4; ++m) {
            const int row = c.row0 + c.wr * 64 + m * 16 + c.fr;
            const f32x4 v = acc[m][n] + bv;
            u32x2 o; o.x = pk2(v.x, v.y); o.y = pk2(v.z, v.w);
            *(u32x2*)(O + (size_t)row * ldo + ocol0 + cl) = o;
        }
    }
}

DV void filt_tile(KParams p, int l, int tile, unsigned char* smem) {
    const int pm = tile >> 7, pn = tile & 127;
    const TileCoord c = tile_coord(pm, pn);
    const bf16_t* A = (const bf16_t*)(p->ws + WS_WOT) + (size_t)l * 2048 * FHID;
    const bf16_t* Bt = (const bf16_t*)(p->ws + WS_H3) + (size_t)l * SEQL * FHID;
    f32x4 acc[4][4]; acc_zero(acc);
    gemm_kloop(acc, A + (size_t)c.row0 * FHID, FHID, Bt + (size_t)c.col0 * FHID, FHID, FHID / G_BK, smem);
    epi_store_bf16(acc, c, (bf16_t*)(p->ws + WS_FILT), SEQL, c.col0, nullptr);
}
DV void ln_job(const float* gq, const float* bq, const bf16_t* src, bf16_t* dstb, float* dstf, int bid, int nblk, unsigned char* dst8 = nullptr) {
    const int lane = tid_() & 63, wv = wave_();
    const size_t step = (size_t)nblk * 8;
    f32x4 gg[4], bb[4];
#pragma unroll
    for (int i = 0; i < 4; ++i) { gg[i] = *(const f32x4*)(gq + lane * 16 + 4 * i); bb[i] = *(const f32x4*)(bq + lane * 16 + 4 * i); }
#pragma unroll 1
    for (size_t row0 = (size_t)bid * 8 + wv; row0 < (size_t)T; row0 += 2 * step) {
        const bool two = row0 + step < (size_t)T; const size_t row1 = two ? row0 + step : row0;
        u32x4 raw[2][2];
        raw[0][0] = ldg16(src + row0 * D + lane * 16); raw[0][1] = ldg16(src + row0 * D + lane * 16 + 8);
        raw[1][0] = ldg16(src + row1 * D + lane * 16); raw[1][1] = ldg16(src + row1 * D + lane * 16 + 8);
#pragma unroll
        for (int k = 0; k < 2; ++k) {
            if (k == 1 && !two) break;
            const size_t row = k ? row1 : row0;
            float v[16];
#pragma unroll
            for (int h = 0; h < 2; ++h) { const u32x4 w = raw[k][h];
                v[8 * h + 0] = bflo(w.x); v[8 * h + 1] = bfhi(w.x); v[8 * h + 2] = bflo(w.y); v[8 * h + 3] = bfhi(w.y); v[8 * h + 4] = bflo(w.z); v[8 * h + 5] = bfhi(w.z); v[8 * h + 6] = bflo(w.w); v[8 * h + 7] = bfhi(w.w); }
            float sm = 0.f;
#pragma unroll
            for (int i = 0; i < 16; ++i) sm += v[i];
            const float mean = wave_sum(sm) * (1.f / D); float s2 = 0.f;
#pragma unroll
            for (int i = 0; i < 16; ++i) { v[i] -= mean; s2 += v[i] * v[i]; }
            const float rstd = rsqrtf(wave_sum(s2) * (1.f / D) + LN_EPS);
#pragma unroll
            for (int i = 0; i < 16; ++i) v[i] = v[i] * rstd * gg[i >> 2][i & 3] + bb[i >> 2][i & 3];
            if (dstb) { u32x4 o0, o1; o0.x = pk2(v[0], v[1]); o0.y = pk2(v[2], v[3]); o0.z = pk2(v[4], v[5]); o0.w = pk2(v[6], v[7]);
                o1.x = pk2(v[8], v[9]); o1.y = pk2(v[10], v[11]); o1.z = pk2(v[12], v[13]); o1.w = pk2(v[14], v[15]);
                stg16(dstb + row * D + lane * 16, o0); stg16(dstb + row * D + lane * 16 + 8, o1);
                if (dst8) {
                    int hw[4];
#pragma unroll
                    for (int i = 0; i < 4; ++i) { int h = 0; h = __builtin_amdgcn_cvt_pk_fp8_f32(v[4 * i], v[4 * i + 1], h, false); h = __builtin_amdgcn_cvt_pk_fp8_f32(v[4 * i + 2], v[4 * i + 3], h, true); hw[i] = h; }
                    stg16(dst8 + row * D + lane * 16, (u32x4){(unsigned)hw[0], (unsigned)hw[1], (unsigned)hw[2], (unsigned)hw[3]}); } }
            else {
#pragma unroll
                for (int i = 0; i < 4; ++i) *(f32x4*)(dstf + row * D + lane * 16 + 4 * i) = (f32x4){v[4 * i], v[4 * i + 1], v[4 * i + 2], v[4 * i + 3]}; }
        }
    }
}
DV void ln1_job(KParams p, int l, int bid, int nblk) { ln_job(p->in[19] + (size_t)l * D, p->in[20] + (size_t)l * D, (const bf16_t*)p->out, (bf16_t*)(p->ws + WS_XB), nullptr, bid, nblk, p->ws + WS_X8); }
namespace pg8 {
constexpr int BM = 256, BK = 64, HALF = 128, HTB = HALF * BK * 2  , STAGE_BYTES = 8 * HTB, NXCD = 8, WGM = 8;
DV int lds_byte(int r, int c) { const int st = (r >> 4) * 2 + (c >> 5), rr = r & 15, cc = c & 31, ob = rr * 64 + cc * 2; return st * 1024 + (ob ^ (((ob >> 9) & 1) << 5)); }
DV void stage_rc(int b, int& R, int& C) { const int st = b / 1024, sb = b % 1024, swz = sb ^ (((sb >> 9) & 1) << 5); R = (st >> 1) * 16 + swz / 64; C = (st & 1) * 32 + (swz % 64) / 2; }
DV int perm32(int rho) { const int n = rho >> 4, i = rho & 15; return 8 * (i >> 2) + 4 * n + (i & 3); }
struct UnitX { const char* A; const char* B; unsigned lda2, ldb2; int nt, tag, pm, pn; };
DV bool static_tile(int nM, int nN, int G, int c, int i, int& pm, int& pn) {
    const int nwg = nM * nN; const long L = (long)i * G + c; if (L >= nwg) return false;
    int wgid = (int)L; { const int q = nwg / NXCD, r = nwg % NXCD, xcd = wgid % NXCD, off = wgid / NXCD; wgid = (xcd < r ? xcd * (q + 1) : r * (q + 1) + (xcd - r) * q) + off; }
    const int nig = WGM * nN, gid = wgid / nig, fm = gid * WGM, gsz = (nM - fm) < WGM ? (nM - fm) : WGM;
    pm = fm + ((wgid % nig) % gsz); pn = (wgid % nig) / gsz; return true;
}
template <class Epi, class Sched>
DV void gemm_stream(LAS unsigned char* lds, const Sched& S, Epi& E) {
    const int tid = tid_(), wid = __builtin_amdgcn_readfirstlane(tid >> 6), lane = tid & 63, wr = wid >> 2, wc = wid & 3, fr = lane & 15, fq = lane >> 4;
    unsigned rA[2], rB[2], c2[2];
#pragma unroll
    for (int i = 0; i < 2; ++i) { int R, C; stage_rc(tid * 16 + i * 8192, R, C); rA[i] = (unsigned)R; rB[i] = (unsigned)(Epi::PERM ? ((R & ~31) + perm32(R & 31)) : R); c2[i] = (unsigned)C * 2u; }
    const size_t kstep = (size_t)(BK * 2);
    const unsigned ldsw = (unsigned)wid * 1024u;
    const int aoff = lds_byte(wr * 64 + fr, fq * 8), boff = lds_byte(wc * 32 + fr, fq * 8);
#define PG8_SA(b, h) (((b) * 2 + (h)) * HTB)
#define PG8_SB(b, h) ((4 + (b) * 2 + (h)) * HTB)
#define PG8_STAGE(bufoff, gbase, voff) do { _Pragma("unroll") for (int _i = 0; _i < 2; ++_i) \
        __builtin_amdgcn_global_load_lds((const GAS unsigned*)((const char*)(gbase) + (voff)[_i]), (LAS unsigned*)(lds + (bufoff) + ldsw + _i * 8192), 16, 0, 0); } while (0)
#define PG8_LDA(dst, b, h) do { _Pragma("unroll") for (int m = 0; m < 4; ++m) _Pragma("unroll") for (int k = 0; k < 2; ++k) dst[m][k] = *(const LAS bf16x8*)(lds + PG8_SA(b, h) + aoff + m * 2048 + k * 1024); } while (0)
#define PG8_LDB(dst, b, h) do { _Pragma("unroll") for (int n = 0; n < 2; ++n) _Pragma("unroll") for (int k = 0; k < 2; ++k) dst[n][k] = *(const LAS bf16x8*)(lds + PG8_SB(b, h) + boff + n * 2048 + k * 1024); } while (0)
#define PG8_MMA(ai, bj, At, Bt) do { __builtin_amdgcn_s_setprio(1); _Pragma("unroll") for (int m = 0; m < 4; ++m) _Pragma("unroll") for (int n = 0; n < 2; ++n) _Pragma("unroll") for (int k = 0; k < 2; ++k) \
        acc[ai][bj][m][n] = __builtin_amdgcn_mfma_f32_16x16x32_bf16(Bt[n][k], At[m][k], acc[ai][bj][m][n], 0, 0, 0); __builtin_amdgcn_s_setprio(0); } while (0)
#define PG8_WAIT_V(n) asm volatile("s_waitcnt vmcnt(" #n ")" ::: "memory")
#define PG8_WAIT_L(n) asm volatile("s_waitcnt lgkmcnt(" #n ")" ::: "memory")
#define PG8_BAR __builtin_amdgcn_s_barrier()
#define PG8_SCHED __builtin_amdgcn_sched_barrier(0)
    UnitX cur, nxt; int ui = 0;
    if (!S.next(0, cur)) return;
    f32x4 acc[2][2][4][2];
#pragma unroll
    for (int a = 0; a < 2; ++a)
#pragma unroll
        for (int b = 0; b < 2; ++b)
#pragma unroll
            for (int m = 0; m < 4; ++m)
#pragma unroll
                for (int n = 0; n < 2; ++n) acc[a][b][m][n] = (f32x4){0.f, 0.f, 0.f, 0.f};
    bf16x8 At[4][2], B0[2][2], B1[2][2];
    const char* cA = cur.A; const char* cB = cur.B;
    unsigned clda = cur.lda2, cldb = cur.ldb2;
    {
        unsigned vA[2], vB[2];
#pragma unroll
        for (int i = 0; i < 2; ++i) { vA[i] = rA[i] * clda + c2[i]; vB[i] = rB[i] * cldb + c2[i]; }
        const size_t hA = (size_t)HALF * clda, hB = (size_t)HALF * cldb;
        PG8_STAGE(PG8_SB(0, 0), cB, vB); PG8_STAGE(PG8_SA(0, 0), cA, vA); PG8_STAGE(PG8_SB(0, 1), cB + hB, vB); PG8_STAGE(PG8_SA(0, 1), cA + hA, vA);
        if (wr == 1) PG8_BAR;
        PG8_WAIT_V(4); PG8_BAR;
        PG8_STAGE(PG8_SB(1, 0), cB + kstep, vB); PG8_STAGE(PG8_SA(1, 0), cA + kstep, vA); PG8_STAGE(PG8_SB(1, 1), cB + hB + kstep, vB);
        PG8_WAIT_V(6); PG8_BAR;
    }
    for (;;) {
        const bool has_next = S.next(ui + 1, nxt);
        const char* nA = has_next ? nxt.A : cA; const char* nB = has_next ? nxt.B : cB;
        const unsigned nlda = has_next ? nxt.lda2 : clda, nldb = has_next ? nxt.ldb2 : cldb;
        const int nt = cur.nt;
#pragma unroll 1
        for (int t = 0; t < nt; t += 2) {
            const bool last = (t == nt - 2);
            const char* a1 = cA + (size_t)(t + 1) * kstep;
            const char* a2 = last ? nA : cA + (size_t)(t + 2) * kstep; const char* b2 = last ? nB : cB + (size_t)(t + 2) * kstep;
            const char* a3 = a2 + kstep; const char* b3 = b2 + kstep;
            const unsigned xlda = last ? nlda : clda, xldb = last ? nldb : cldb;
            unsigned vA[2], xA[2], xB[2];
#pragma unroll
            for (int i = 0; i < 2; ++i) { vA[i] = rA[i] * clda + c2[i]; xA[i] = rA[i] * xlda + c2[i]; xB[i] = rB[i] * xldb + c2[i]; }
            const size_t hA = (size_t)HALF * clda, xhA = (size_t)HALF * xlda, xhB = (size_t)HALF * xldb;
            PG8_LDB(B0, 0, 0); PG8_SCHED; PG8_LDA(At, 0, 0); PG8_STAGE(PG8_SA(1, 1), a1 + hA, vA);
            PG8_WAIT_L(8); PG8_BAR; PG8_WAIT_L(0); PG8_MMA(0, 0, At, B0); PG8_BAR; PG8_SCHED;
            PG8_LDB(B1, 0, 1); PG8_STAGE(PG8_SB(0, 0), b2, xB);
            PG8_BAR; PG8_WAIT_L(0); PG8_MMA(0, 1, At, B1); PG8_BAR;
            PG8_LDA(At, 0, 1); PG8_STAGE(PG8_SA(0, 0), a2, xA);
            PG8_BAR; PG8_WAIT_L(0); PG8_MMA(1, 0, At, B0); PG8_BAR; PG8_SCHED;
            PG8_STAGE(PG8_SB(0, 1), b2 + xhB, xB);
            PG8_WAIT_V(6); PG8_BAR; PG8_MMA(1, 1, At, B1); PG8_BAR;
            PG8_LDB(B0, 1, 0); PG8_SCHED; PG8_LDA(At, 1, 0); PG8_STAGE(PG8_SA(0, 1), a2 + xhA, xA);
            PG8_WAIT_L(8); PG8_BAR; PG8_WAIT_L(0); PG8_MMA(0, 0, At, B0); PG8_BAR; PG8_SCHED;
            PG8_LDB(B1, 1, 1); PG8_STAGE(PG8_SB(1, 0), b3, xB);
            PG8_BAR; PG8_WAIT_L(0); PG8_MMA(0, 1, At, B1); PG8_BAR;
            PG8_LDA(At, 1, 1); PG8_STAGE(PG8_SA(1, 0), a3, xA);
            PG8_BAR; PG8_WAIT_L(0); PG8_MMA(1, 0, At, B0); PG8_BAR; PG8_SCHED;
            PG8_STAGE(PG8_SB(1, 1), b3 + xhB, xB);
            PG8_WAIT_V(6); PG8_BAR; PG8_MMA(1, 1, At, B1); PG8_BAR;
        }
        E(acc, cur, wr, wc, fr, fq);
        if (!has_next) break;
#pragma unroll
        for (int a = 0; a < 2; ++a)
#pragma unroll
            for (int b = 0; b < 2; ++b)
#pragma unroll
                for (int m = 0; m < 4; ++m)
#pragma unroll
                    for (int n = 0; n < 2; ++n) acc[a][b][m][n] = (f32x4){0.f, 0.f, 0.f, 0.f};
        cur = nxt; cA = nA; cB = nB; clda = nlda; cldb = nldb; ++ui;
    }
    PG8_WAIT_V(0);
    if (wr == 0) PG8_BAR;
    PG8_BAR;
#undef PG8_SA
#undef PG8_SB
#undef PG8_STAGE
#undef PG8_LDA
#undef PG8_LDB
#undef PG8_MMA
#undef PG8_WAIT_V
#undef PG8_WAIT_L
#undef PG8_BAR
#undef PG8_SCHED
}
}
DV void pg8_store_bf16_perm(const f32x4 (&acc)[2][2][4][2], bf16_t* O  , int ldo, const float* bias  , int wr, int wc, int fr, int fq) {
    const int col0 = wc * 32 + 8 * fq;
    f32x4 bv[2][2];
#pragma unroll
    for (int bj = 0; bj < 2; ++bj)
#pragma unroll
        for (int n = 0; n < 2; ++n) bv[bj][n] = bias ? *(const f32x4*)(bias + col0 + bj * 128 + 4 * n) : (f32x4){0.f, 0.f, 0.f, 0.f};
#pragma unroll
    for (int ai = 0; ai < 2; ++ai)
#pragma unroll
        for (int m = 0; m < 4; ++m) { bf16_t* rowp = O + (size_t)(ai * 128 + wr * 64 + m * 16 + fr) * ldo + col0;
#pragma unroll
            for (int bj = 0; bj < 2; ++bj) { const f32x4 v0 = acc[ai][bj][m][0] + bv[bj][0], v1 = acc[ai][bj][m][1] + bv[bj][1];
                u32x4 w; w.x = pk2(v0.x, v0.y); w.y = pk2(v0.z, v0.w); w.z = pk2(v1.x, v1.y); w.w = pk2(v1.z, v1.w);
                *(u32x4*)(rowp + bj * 128) = w; } }
}
struct EpiG1 { static constexpr bool PERM = true; KParams p; int l;
    DV void operator()(const f32x4 (&acc)[2][2][4][2], const pg8::UnitX& u, int wr, int wc, int fr, int fq) const {
        bf16_t* O; int ldo, oc; const float* bias = nullptr;
        const int upm = opaque_s(u.pm), upn = opaque_s(u.pn);
        if (u.tag == 0) {
            const int col0 = upn * 256; bias = p->in[6] + (size_t)l * IN_WIDTH + col0;
            if (upn < 3) { O = (bf16_t*)(p->ws + WS_QKV); ldo = 768; oc = col0; }
            else if (upn < 9) { O = (bf16_t*)(p->ws + WS_HY); ldo = HY3; oc = col0 - O_HY; }
            else { O = (bf16_t*)((unsigned char*)p->out + DO_QM); ldo = 512; oc = col0 - O_MQ; }
        } else { O = (bf16_t*)(p->ws + WS_KVMEM) + (size_t)(u.tag - 1) * 768 * D; ldo = D; oc = upn * 256; }
        pg8_store_bf16_perm(acc, O + (size_t)upm * 256 * ldo + oc, ldo, bias, wr, wc, fr, fq);
    }
};
struct SchedG1 { KParams p; int l, G, c;
    DV bool next(int i, pg8::UnitX& u) const {
        int pm, pn;
        if (pg8::static_tile(T / 256, O_GATE / 256, G, c, i, pm, pn)) {
            u.A = (const char*)(p->ws + WS_XB) + (size_t)pm * 256 * 2048; u.B = (const char*)(p->ws + WS_W + l * SZ_WL + OFF_WT_IN) + (size_t)pn * 256 * 2048;
            u.lda2 = 2048; u.ldb2 = 2048; u.nt = 16; u.tag = 0; u.pm = pm; u.pn = pn; return true; }
        if (l != 0) return false;
        const int n1 = (T / 256) * (O_GATE / 256), cnt = (n1 - c + G - 1) / G, j = i - cnt, c2 = (c + G - 64) % G, idx = j * G + c2;
        if (idx >= 24) return false;
        const int ll = idx / 12, r = idx - ll * 12; pm = r >> 2; pn = r & 3;
        u.A = (const char*)(p->ws + WS_MEMB) + (size_t)pm * 256 * 2048; u.B = (const char*)(p->ws + WS_W + ll * SZ_WL + OFF_WT_MKV) + (size_t)pn * 256 * 2048;
        u.lda2 = 2048; u.ldb2 = 2048; u.nt = 16; u.tag = 1 + ll; u.pm = pm; u.pn = pn; return true;
    }
};
struct EpiOut { static constexpr bool PERM = true; KParams p;
    DV void operator()(const f32x4 (&acc)[2][2][4][2], const pg8::UnitX& u, int wr, int wc, int fr, int fq) const {
        const bf16_t* xb = (const bf16_t*)(p->ws + WS_XB); bf16_t* o = (bf16_t*)p->out;
        const int upm = opaque_s(u.pm), upn = opaque_s(u.pn);
        const size_t base = ((size_t)upm * 256 + wr * 64 + fr) * D + upn * 256 + wc * 32 + 8 * fq;
#pragma unroll
        for (int ai = 0; ai < 2; ++ai) {
            u32x4 xv[4][2];
#pragma unroll
            for (int m = 0; m < 4; ++m)
#pragma unroll
                for (int bj = 0; bj < 2; ++bj) xv[m][bj] = ldg16(xb + base + (size_t)(ai * 128 + m * 16) * D + bj * 128);
#pragma unroll
            for (int m = 0; m < 4; ++m)
#pragma unroll
                for (int bj = 0; bj < 2; ++bj) { const u32x4 x = xv[m][bj]; const f32x4 a0 = acc[ai][bj][m][0], a1 = acc[ai][bj][m][1];
                    u32x4 w; w.x = pk2(a0.x + ALPHA * bflo(x.x), a0.y + ALPHA * bfhi(x.x)); w.y = pk2(a0.z + ALPHA * bflo(x.y), a0.w + ALPHA * bfhi(x.y));
                    w.z = pk2(a1.x + ALPHA * bflo(x.z), a1.y + ALPHA * bfhi(x.z)); w.w = pk2(a1.z + ALPHA * bflo(x.w), a1.w + ALPHA * bfhi(x.w));
                    stg16(o + base + (size_t)(ai * 128 + m * 16) * D + bj * 128, w); }
            asm volatile("" ::: "memory"); }
    }
};
struct SchedOut { KParams p; int l, G, c;
    DV bool next(int i, pg8::UnitX& u) const {
        int pm, pn; if (!pg8::static_tile(T / 256, D / 256, G, c, i, pm, pn)) return false;
        u.A = (const char*)(p->ws + WS_HY) + (size_t)T * 512 * 2 + (size_t)pm * 256 * 2048; u.B = (const char*)(p->ws + WS_W + l * SZ_WL + OFF_WT_OUT) + (size_t)pn * 256 * 2048;
        u.lda2 = 2048; u.ldb2 = 2048; u.nt = 16; u.tag = 0; u.pm = pm; u.pn = pn; return true; }
};
struct EpiQ { static constexpr bool PERM = true; KParams p;
    DV void operator()(const f32x4 (&acc)[2][2][4][2], const pg8::UnitX& u, int wr, int wc, int fr, int fq) const {
        pg8_store_bf16_perm(acc, (bf16_t*)p->out + (size_t)opaque_s(u.pm) * 256 * 2048 + opaque_s(u.pn) * 256, 2048, nullptr, wr, wc, fr, fq); }
};
struct SchedQ { KParams p; int l, G, c;
    DV bool next(int i, pg8::UnitX& u) const {
        int pm, pn; if (!pg8::static_tile(T / 256, 2048 / 256, G, c, i, pm, pn)) return false;
        u.A = (const char*)(p->ws + WS_XB) + (size_t)pm * 256 * 2048; u.B = (const char*)(p->ws + WS_W + l * SZ_WL + OFF_WT_Q) + (size_t)pn * 256 * 2048;
        u.lda2 = 2048; u.ldb2 = 2048; u.nt = 16; u.tag = 0; u.pm = pm; u.pn = pn; return true; }
};
struct EpiMerge { static constexpr bool PERM = true; KParams p; int l;
    DV void operator()(const f32x4 (&acc)[2][2][4][2], const pg8::UnitX& u, int wr, int wc, int fr, int fq) const {
        const int n = u.tag >> 1, col0 = wc * 32 + 8 * fq, upm = opaque_s(u.pm), upn = opaque_s(u.pn);
        u32x4* sp = (u32x4*)((unsigned char*)p->out) + (size_t)blockIdx.x * 16 * NTH + threadIdx.x;
        if ((u.tag & 1) == 0) {
            const float* bias = p->in[6] + (size_t)l * IN_WIDTH + O_GATE + n * D + upn * 256 + col0;
            f32x4 bv[2][2];
#pragma unroll
            for (int bj = 0; bj < 2; ++bj)
#pragma unroll
                for (int nn = 0; nn < 2; ++nn) bv[bj][nn] = *(const f32x4*)(bias + bj * 128 + 4 * nn);
#pragma unroll
            for (int ai = 0; ai < 2; ++ai)
#pragma unroll
                for (int m = 0; m < 4; ++m) {
#pragma unroll
                    for (int bj = 0; bj < 2; ++bj) { const f32x4 v0 = acc[ai][bj][m][0] + bv[bj][0], v1 = acc[ai][bj][m][1] + bv[bj][1];
                        u32x4 w;
                        w.x = pk2(__builtin_amdgcn_rcpf(1.f + __expf(-v0.x)), __builtin_amdgcn_rcpf(1.f + __expf(-v0.y))); w.y = pk2(__builtin_amdgcn_rcpf(1.f + __expf(-v0.z)), __builtin_amdgcn_rcpf(1.f + __expf(-v0.w)));
                        w.z = pk2(__builtin_amdgcn_rcpf(1.f + __expf(-v1.x)), __builtin_amdgcn_rcpf(1.f + __expf(-v1.y))); w.w = pk2(__builtin_amdgcn_rcpf(1.f + __expf(-v1.z)), __builtin_amdgcn_rcpf(1.f + __expf(-v1.w)));
                        sp[bj * NTH] = w; }
                    sp += 2 * NTH; asm volatile("" : "+v"(sp)); }
        } else {
            bf16_t* rowp = (bf16_t*)(p->ws + WS_HY) + (size_t)T * 512 + ((size_t)upm * 256 + wr * 64 + fr) * D + upn * 256 + col0;
#pragma unroll
            for (int ai = 0; ai < 2; ++ai) {
                u32x4 g[4][2], o[4][2];
#pragma unroll
                for (int m = 0; m < 4; ++m)
#pragma unroll
                    for (int bj = 0; bj < 2; ++bj) { g[m][bj] = sp[(m * 2 + bj) * NTH]; if (n > 0) o[m][bj] = *(const u32x4*)(rowp + (size_t)m * 16 * D + bj * 128); }
#pragma unroll
                for (int m = 0; m < 4; ++m)
#pragma unroll
                    for (int bj = 0; bj < 2; ++bj) { const f32x4 a0 = acc[ai][bj][m][0], a1 = acc[ai][bj][m][1]; const u32x4 gg = g[m][bj];
                        float r[8] = {bflo(gg.x) * a0.x, bfhi(gg.x) * a0.y, bflo(gg.y) * a0.z, bfhi(gg.y) * a0.w, bflo(gg.z) * a1.x, bfhi(gg.z) * a1.y, bflo(gg.w) * a1.z, bfhi(gg.w) * a1.w};
                        if (n > 0) { const u32x4 oo = o[m][bj];
                            r[0] += bflo(oo.x); r[1] += bfhi(oo.x); r[2] += bflo(oo.y); r[3] += bfhi(oo.y); r[4] += bflo(oo.z); r[5] += bfhi(oo.z); r[6] += bflo(oo.w); r[7] += bfhi(oo.w); }
                        u32x4 w; w.x = pk2(r[0], r[1]); w.y = pk2(r[2], r[3]); w.z = pk2(r[4], r[5]); w.w = pk2(r[6], r[7]);
                        *(u32x4*)(rowp + (size_t)m * 16 * D + bj * 128) = w; }
                sp += 8 * NTH; rowp += 128 * D; asm volatile("" : "+v"(sp), "+v"(rowp)); }
        }
    }
};
struct SchedMerge { KParams p; int l, G, c;
    DV bool next(int i, pg8::UnitX& u) const {
        const int ti = i / 6, sub = i - ti * 6, n = sub >> 1;
        int pm, pn; if (!pg8::static_tile(T / 256, D / 256, G, c, ti, pm, pn)) return false;
        u.tag = sub; u.pm = pm; u.pn = pn;
        if ((sub & 1) == 0) {
            u.A = (const char*)(p->ws + WS_XB) + (size_t)pm * 256 * 2048; u.B = (const char*)(p->ws + WS_W + l * SZ_WL + OFF_WT_IN) + (size_t)(O_GATE + n * D + pn * 256) * 2048;
            u.lda2 = 2048; u.ldb2 = 2048; u.nt = 16;
        } else {
            if (n == 0) { u.A = (const char*)(p->ws + WS_QKV) + (size_t)pm * 256 * 1536; u.lda2 = 1536; }
            else if (n == 1) { u.A = (const char*)(p->ws + WS_HY) + (size_t)pm * 256 * 1024; u.lda2 = 1024; }
            else { u.A = (const char*)p->out + DO_QM + (size_t)pm * 256 * 1024; u.lda2 = 1024; }
            u.B = (const char*)(p->ws + WS_W + l * SZ_WL + OFF_WT_BR) + (size_t)(n * D + pn * 256) * 1024; u.ldb2 = 1024; u.nt = 8;
        }
        return true; }
};
DV void shortconv_item(KParams p, int l, int item, float* s  ) {
    const int tid = tid_();
    const int ct = item % 24, r = item / 24, tt = r % 64, seq = r / 64;
    const int t0 = tt * 256, c0 = ct * 64;
    const bf16_t* hy = (const bf16_t*)(p->ws + WS_HY);
    bf16_t* uct = (bf16_t*)((unsigned char*)p->out + DO_UCT);
    u32x4 v[5];
#pragma unroll
    for (int i = 0; i < 5; ++i) {
        const int idx = tid + i * NTH, rr = idx >> 3, ch = idx & 7, t = t0 + rr - 1;
        v[i] = (u32x4){0u, 0u, 0u, 0u};
        if (idx < 258 * 8 && t >= 0 && t < SEQL) v[i] = ldg16(hy + ((size_t)seq * SEQL + t) * HY3 + c0 + ch * 8);
    }
    __syncthreads();
#pragma unroll
    for (int i = 0; i < 5; ++i) {
        const int idx = tid + i * NTH, rr = idx >> 3, ch = idx & 7;
        if (idx < 258 * 8) { float* d = s + rr * 65 + ch * 8;
            d[0] = bflo(v[i].x); d[1] = bfhi(v[i].x); d[2] = bflo(v[i].y); d[3] = bfhi(v[i].y); d[4] = bflo(v[i].z); d[5] = bfhi(v[i].z); d[6] = bflo(v[i].w); d[7] = bfhi(v[i].w); }
    }
    __syncthreads();
    const int ch = tid >> 3, tq = tid & 7, cg = c0 + ch;
    const float* cw = p->in[7] + (size_t)l * 3 * HY3; const float cb = p->in[8][(size_t)l * HY3 + cg];
    const float w0 = cw[cg], w1 = cw[HY3 + cg], w2 = cw[2 * HY3 + cg];
#pragma unroll
    for (int grp = 0; grp < 4; ++grp) {
        float o[8];
#pragma unroll
        for (int e = 0; e < 8; ++e) { const int rr = grp * 64 + tq * 8 + e; o[e] = cb + w0 * s[rr * 65 + ch] + w1 * s[(rr + 1) * 65 + ch] + w2 * s[(rr + 2) * 65 + ch]; }
        u32x4 ov; ov.x = pk2(o[0], o[1]); ov.y = pk2(o[2], o[3]); ov.z = pk2(o[4], o[5]); ov.w = pk2(o[6], o[7]);
        stg16(uct + ((size_t)seq * HY3 + cg) * SEQL + t0 + grp * 64 + tq * 8, ov);
    }
}
DV void hyo_transpose_item(KParams p, int item, bf16_t* s  ) {
    const int tid = tid_();
    const int ct = item % 8, r = item / 8, tt = r % 64, seq = r / 64;
    const int t0 = tt * 256, c0 = ct * 64;
    const bf16_t* uct = (const bf16_t*)((unsigned char*)p->out + DO_UCT);
    bf16_t* hyo = (bf16_t*)(p->ws + WS_HY);
    u32x4 v[4];
    { const int ch = tid >> 3, tq = tid & 7;
#pragma unroll
      for (int grp = 0; grp < 4; ++grp) v[grp] = ldg16(uct + ((size_t)seq * HY3 + c0 + ch) * SEQL + t0 + grp * 64 + tq * 8);
      __syncthreads();
#pragma unroll
      for (int grp = 0; grp < 4; ++grp) *(u32x4*)(s + ch * 264 + grp * 64 + tq * 8) = v[grp]; }
    __syncthreads();
#pragma unroll
    for (int i4 = 0; i4 < 4; ++i4) { const int idx = tid + i4 * NTH, t = idx >> 3, cq = idx & 7;
      bf16_t e[8];
#pragma unroll
      for (int i = 0; i < 8; ++i) e[i] = s[(cq * 8 + i) * 264 + t];
      u32x4 o; o.x = e[0] | ((unsigned)e[1] << 16); o.y = e[2] | ((unsigned)e[3] << 16); o.z = e[4] | ((unsigned)e[5] << 16); o.w = e[6] | ((unsigned)e[7] << 16);
      stg16(hyo + ((size_t)seq * SEQL + t0 + t) * 512 + c0 + cq * 8, o); }
}

template <bool WIN> struct AttnCfg {
    static constexpr int HDIM = WIN ? 64 : 128, NK = WIN ? 384 : 256, QT = WIN ? 4 : 2, KS = HDIM / 32, DT = HDIM / 16;
    static constexpr int KSTR = HDIM + 8, VSTR = NK + 8;
    static constexpr int K_BYTES = NK * KSTR * 2, V_BYTES = HDIM * VSTR * 2;
};
template <bool WIN> DV void attn_item(KParams p, int l, int item, unsigned char* smem) {
    typedef AttnCfg<WIN> C;
    const int tid = tid_(), lane = tid & 63, w = wave_(), fr = lane & 15, fq = lane >> 4;
    bf16_t* Ks = (bf16_t*)smem; bf16_t* Vt = (bf16_t*)(smem + C::K_BYTES); float* biasT = (float*)(smem + C::K_BYTES + C::V_BYTES);
    int seq, blk, hh;
    if (WIN) { hh = item & 1; blk = (item >> 1) & 127; seq = item >> 8; }
    else { hh = item & 3; blk = (item >> 2) % 64; seq = (item >> 2) / 64; }
    __syncthreads();
    if (WIN) {
        const bf16_t* qkv = (const bf16_t*)(p->ws + WS_QKV);
#pragma unroll
        for (int i = 0; i < 6; ++i) {
            const int idx = tid + i * NTH, key = idx >> 3, ch = idx & 7, pos = blk * 128 - 128 + key;
            u32x4 kv = (u32x4){0u, 0u, 0u, 0u}, vv = kv;
            if (pos >= 0 && pos < SEQL) { const bf16_t* row = qkv + ((size_t)seq * SEQL + pos) * 768; kv = ldg16(row + O_K + hh * 64 + ch * 8); vv = ldg16(row + O_V + hh * 64 + ch * 8); }
            *(u32x4*)(Ks + key * C::KSTR + ch * 8) = kv;
            bf16_t* vd = Vt + (ch * 8) * C::VSTR + key;
            vd[0] = (bf16_t)vv.x; vd[C::VSTR] = (bf16_t)(vv.x >> 16); vd[2 * C::VSTR] = (bf16_t)vv.y; vd[3 * C::VSTR] = (bf16_t)(vv.y >> 16);
            vd[4 * C::VSTR] = (bf16_t)vv.z; vd[5 * C::VSTR] = (bf16_t)(vv.z >> 16); vd[6 * C::VSTR] = (bf16_t)vv.w; vd[7 * C::VSTR] = (bf16_t)(vv.w >> 16);
        }
        for (int i = tid; i < 4 * 257; i += NTH) { const int g = i / 257, r = i - g * 257; biasT[i] = p->in[4][t5_bucket(r - 128) * 8 + hh * 4 + g] * 1.4426950408889634f; }
    } else {
        const bf16_t* kvm = (const bf16_t*)(p->ws + WS_KVMEM) + (size_t)l * 768 * D;
#pragma unroll
        for (int i = 0; i < 8; ++i) {
            const int idx = tid + i * NTH, key = idx >> 4, ch = idx & 15;
            const bf16_t* row = kvm + ((size_t)seq * N_MEM + key) * D;
            const u32x4 kv = ldg16(row + hh * 128 + ch * 8), vv = ldg16(row + 512 + hh * 128 + ch * 8);
            *(u32x4*)(Ks + key * C::KSTR + ch * 8) = kv;
            bf16_t* vd = Vt + (ch * 8) * C::VSTR + key;
            vd[0] = (bf16_t)vv.x; vd[C::VSTR] = (bf16_t)(vv.x >> 16); vd[2 * C::VSTR] = (bf16_t)vv.y; vd[3 * C::VSTR] = (bf16_t)(vv.y >> 16);
            vd[4 * C::VSTR] = (bf16_t)vv.z; vd[5 * C::VSTR] = (bf16_t)(vv.z >> 16); vd[6 * C::VSTR] = (bf16_t)vv.w; vd[7 * C::VSTR] = (bf16_t)(vv.w >> 16);
        }
    }
    bf16_t* qbase; int ldq, qcol0, wrow0; size_t tok0; float sink = 0.f; int g = 0;
    if (WIN) { g = w >> 1; qbase = (bf16_t*)(p->ws + WS_QKV); ldq = 768; qcol0 = (hh * 4 + g) * 64; wrow0 = (w & 1) * 64; tok0 = (size_t)seq * SEQL + blk * 128;
               sink = p->in[9][(size_t)l * 8 + hh * 4 + g] * 1.4426950408889634f; }
    else { qbase = (bf16_t*)((unsigned char*)p->out + DO_QM); ldq = 512; qcol0 = hh * 128; wrow0 = w * 32; tok0 = (size_t)seq * SEQL + blk * 256; }
    bf16x8 bq[C::QT][C::KS];
#pragma unroll
    for (int qt = 0; qt < C::QT; ++qt)
#pragma unroll
        for (int ks = 0; ks < C::KS; ++ks) bq[qt][ks] = *(const bf16x8*)(qbase + (tok0 + wrow0 + qt * 16 + fr) * ldq + qcol0 + ks * 32 + fq * 8);
    f32x4 o[C::QT][C::DT]; float m[C::QT], ls[C::QT];
#pragma unroll
    for (int qt = 0; qt < C::QT; ++qt) { m[qt] = WIN ? sink : -1e30f; ls[qt] = (WIN && fq == 0) ? 1.f : 0.f;
#pragma unroll
        for (int dt = 0; dt < C::DT; ++dt) o[qt][dt] = (f32x4){0.f, 0.f, 0.f, 0.f}; }
    const float scale = (WIN ? 0.125f : 0.08838834764831845f) * 1.4426950408889634f;
    __syncthreads();
#pragma unroll 1
    for (int kc = 0; kc < C::NK / 32; ++kc) {
        bf16x8 ak[2][C::KS];
#pragma unroll
        for (int kt = 0; kt < 2; ++kt)
#pragma unroll
            for (int ks = 0; ks < C::KS; ++ks) ak[kt][ks] = *(const bf16x8*)(Ks + (kc * 32 + kt * 16 + fr) * C::KSTR + ks * 32 + fq * 8);
        bf16x8 av[C::DT];
#pragma unroll
        for (int dt = 0; dt < C::DT; ++dt) {
            const u32x2 v0 = *(const u32x2*)(Vt + (dt * 16 + fr) * C::VSTR + kc * 32 + fq * 4), v1 = *(const u32x2*)(Vt + (dt * 16 + fr) * C::VSTR + kc * 32 + 16 + fq * 4);
            u32x4 vv; vv.x = v0.x; vv.y = v0.y; vv.z = v1.x; vv.w = v1.y; av[dt] = __builtin_bit_cast(bf16x8, vv);
        }
#pragma unroll
        for (int qt = 0; qt < C::QT; ++qt) {
            const int r0 = wrow0 + qt * 16;
            if (WIN && !(kc * 32 + 31 >= r0 && kc * 32 <= r0 + 271)) continue;
            f32x4 s0 = (f32x4){0.f, 0.f, 0.f, 0.f}, s1 = s0;
#pragma unroll
            for (int ks = 0; ks < C::KS; ++ks) { s0 = __builtin_amdgcn_mfma_f32_16x16x32_bf16(ak[0][ks], bq[qt][ks], s0, 0, 0, 0); s1 = __builtin_amdgcn_mfma_f32_16x16x32_bf16(ak[1][ks], bq[qt][ks], s1, 0, 0, 0); }
            float sv[8];
            const bool interior = WIN && (kc * 32 >= r0 + 15) && (kc * 32 + 31 - r0 <= 256) && (blk * 128 - 128 + kc * 32 >= 0) && (blk * 128 - 128 + kc * 32 + 31 < SEQL);
            if (interior) {
                const float* bt = biasT + g * 257 + fq * 4 - fr + (kc * 32 - r0);
#pragma unroll
                for (int e = 0; e < 8; ++e) sv[e] = __builtin_fmaf(e < 4 ? s0[e & 3] : s1[e & 3], scale, bt[(e >> 2) * 16 + (e & 3)]);
            } else
#pragma unroll
            for (int e = 0; e < 8; ++e) {
                const float raw = (e < 4 ? s0[e & 3] : s1[e & 3]) * scale;
                if (WIN) {
                    const int jk = kc * 32 + (e >> 2) * 16 + fq * 4 + (e & 3), qi = r0 + fr, rel = jk - qi, pos = blk * 128 - 128 + jk;
                    const bool ok = (rel >= 0) && (rel <= 256) && (pos >= 0) && (pos < SEQL);
                    const int ri = rel < 0 ? 0 : (rel > 256 ? 256 : rel);
                    sv[e] = ok ? raw + biasT[g * 257 + ri] : -1e30f;
                } else sv[e] = raw;
            }
            float cm = fmaxf(fmaxf(fmaxf(sv[0], sv[1]), fmaxf(sv[2], sv[3])), fmaxf(fmaxf(sv[4], sv[5]), fmaxf(sv[6], sv[7])));
            cm = fmaxf(cm, __shfl_xor(cm, 16)); cm = fmaxf(cm, __shfl_xor(cm, 32));
            const float mn = fmaxf(m[qt], cm), al = __builtin_amdgcn_exp2f(m[qt] - mn);
            m[qt] = mn;
            float ps = 0.f; float pe[8];
#pragma unroll
            for (int e = 0; e < 8; ++e) { pe[e] = __builtin_amdgcn_exp2f(sv[e] - mn); ps += pe[e]; }
            ls[qt] = ls[qt] * al + ps;
            u32x4 pw; pw.x = pk2(pe[0], pe[1]); pw.y = pk2(pe[2], pe[3]); pw.z = pk2(pe[4], pe[5]); pw.w = pk2(pe[6], pe[7]);
            const bf16x8 pf = __builtin_bit_cast(bf16x8, pw);
#pragma unroll
            for (int dt = 0; dt < C::DT; ++dt) { o[qt][dt] = o[qt][dt] * al; o[qt][dt] = __builtin_amdgcn_mfma_f32_16x16x32_bf16(av[dt], pf, o[qt][dt], 0, 0, 0); }
        }
    }
#pragma unroll
    for (int qt = 0; qt < C::QT; ++qt) {
        float lt = ls[qt]; lt += __shfl_xor(lt, 16); lt += __shfl_xor(lt, 32);
        const float inv = 1.f / lt;
#pragma unroll
        for (int dt = 0; dt < C::DT; ++dt) {
            const f32x4 v = o[qt][dt] * inv;
            u32x2 ov; ov.x = pk2(v.x, v.y); ov.y = pk2(v.z, v.w);
            *(u32x2*)(qbase + (tok0 + wrow0 + qt * 16 + fr) * ldq + qcol0 + dt * 16 + fq * 4) = ov;
        }
    }
}
constexpr int ATT_LDS_WIN = AttnCfg<true>::K_BYTES + AttnCfg<true>::V_BYTES + 4 * 257 * 4;
constexpr int ATT_LDS_MEM = AttnCfg<false>::K_BYTES + AttnCfg<false>::V_BYTES;

constexpr int FBUF_BYTES = FBUF_F2 * 8;
constexpr int HY_LDS = FBUF_BYTES + 1024 + 288 * 8;
typedef _Float16 h2_t __attribute__((ext_vector_type(2)));
DV HPair unpackH(u32x2 v) {
    const h2_t a = __builtin_bit_cast(h2_t, v.x), b = __builtin_bit_cast(h2_t, v.y);
    const float sc = 1.f / (float)FN;
    HPair h; h.hk = make_float2((float)a.x * sc, (float)a.y * sc); h.hl = make_float2((float)b.x * sc, (float)b.y * sc); return h;
}
DV int opaque(int v) { asm volatile("" : "+v"(v)); return v; }
typedef HYV hyv_t;
template <class V> DV void fft_fwd_123(V* buf, int tid, const float2* tw) {
#pragma unroll 1
    for (int ps = 1; ps < 4; ++ps) { fft_pass<false, V>(buf, ps, opaque(tid), tw); __syncthreads(); }
}
template <class V> DV void fft_inv_012(V* buf, int tid, const float2* tw) {
#pragma unroll 1
    for (int ps = 0; ps < 3; ++ps) { fft_pass<true, V>(buf, ps, opaque(tid), tw); __syncthreads(); }
}
DV void fft_fwd_all(v2f* buf, int tid, const float2* tw) {
#pragma unroll 1
    for (int ps = 0; ps < 4; ++ps) { fft_pass<false, v2f>(buf, ps, opaque(tid), tw); __syncthreads(); }
}
template <int I> DV void hy_pair_one(hyv_t* dbuf, const f32x4* Hs, const PairCtx& cx, int tid, const float2* t12) {
    const f32x4 hv = Hs[tid + NTH * I]; HPair hp; hp.hk = make_float2(hv.x, hv.y); hp.hl = make_float2(hv.z, hv.w);
    pair_apply_fast<I>(dbuf, cx, tid, hp, t12);
}
DV void hy_pair_stage(hyv_t* dbuf, const f32x4* Hs, int tid, const float2* t12) {
    const PairCtx cx = pair_ctx(tid);
    hy_pair_one<0>(dbuf, Hs, cx, tid, t12); hy_pair_one<1>(dbuf, Hs, cx, tid, t12); hy_pair_one<2>(dbuf, Hs, cx, tid, t12); hy_pair_one<3>(dbuf, Hs, cx, tid, t12);
    hy_pair_one<4>(dbuf, Hs, cx, tid, t12); hy_pair_one<5>(dbuf, Hs, cx, tid, t12); hy_pair_one<6>(dbuf, Hs, cx, tid, t12); hy_pair_one<7>(dbuf, Hs, cx, tid, t12);
    hy_pair_one<8>(dbuf, Hs, cx, tid, t12); hy_pair_one<9>(dbuf, Hs, cx, tid, t12); hy_pair_one<10>(dbuf, Hs, cx, tid, t12); hy_pair_one<11>(dbuf, Hs, cx, tid, t12);
    hy_pair_one<12>(dbuf, Hs, cx, tid, t12); hy_pair_one<13>(dbuf, Hs, cx, tid, t12); hy_pair_one<14>(dbuf, Hs, cx, tid, t12); hy_pair_one<15>(dbuf, Hs, cx, tid, t12);
}
DV void hyena_item(KParams p, int l, int c, unsigned char* smem) {
    const int tid = tid_(), lane = tid & 63, w = wave_();
    v2f* buf = (v2f*)smem; float* fbuf = (float*)smem;
    hyv_t* dbuf = (hyv_t*)smem;
    float* wo = (float*)(smem + FBUF_BYTES); float* red = wo + 128;
    const bf16_t* filt = (const bf16_t*)(p->ws + WS_FILT);
    const float2* tw = (const float2*)(p->ws + WS_TW);
    float2* t12 = (float2*)(smem + FBUF_BYTES + 1024);
    if (tid < 256) t12[tid] = tw[tid]; else if (tid < 288) t12[tid] = tw[(tid - 256) * 256];
    const float min_decay = -3.0701134573253945f, max_decay = -15.350567286626972f;
    const float delta = fabsf(min_decay + (float)c * ((max_decay - min_decay) / 511.f));
#ifdef PROBE_PHASE
#define HSTAMP(i) { __syncthreads(); if (blockIdx.x == 0 && threadIdx.x == 0) __hip_atomic_store((unsigned long long*)(p->ws + WS_TS) + (i), (unsigned long long)__builtin_amdgcn_s_memrealtime(), __ATOMIC_RELAXED, __HIP_MEMORY_SCOPE_AGENT); }
#else
#define HSTAMP(i)
#endif
    HSTAMP(24)
    f32x4* Hs = (f32x4*)(p->ws + WS_HSCR) + (size_t)blockIdx.x * 2 * 8192;
    __syncthreads();
#pragma unroll 1
    for (int o = 0; o < 2; ++o) {
        const bf16_t* ff = filt + (size_t)(o * 1024 + c) * SEQL; const bf16_t* fb = ff + (size_t)512 * SEQL;
        float asum = 0.f;
        u32x4 fva[4], bva[4];
#pragma unroll
        for (int i = 0; i < 4; ++i) { const int pos0 = 8 * (tid + NTH * i); fva[i] = ldg16(ff + pos0); bva[i] = ldg16(fb + pos0); }
#pragma unroll
        for (int i = 0; i < 4; ++i) {
            const int pos0 = 8 * (opaque(tid) + NTH * i);
            const u32x4 fv = fva[i], bv = bva[i];
            const float fw[8] = {bflo(fv.x), bfhi(fv.x), bflo(fv.y), bfhi(fv.y), bflo(fv.z), bfhi(fv.z), bflo(fv.w), bfhi(fv.w)};
            const float bw[8] = {bflo(bv.x), bfhi(bv.x), bflo(bv.y), bfhi(bv.y), bflo(bv.z), bfhi(bv.z), bflo(bv.w), bfhi(bv.w)};
#pragma unroll
            for (int e = 0; e < 8; ++e) {
                const int pos = pos0 + e;
                const float dec = __expf(-((float)pos * (1.f / (float)(SEQL - 1))) * delta);
                const float f = fw[e] * dec, b = bw[e] * dec;
                if (pos == 0) { const float v = f + b; fbuf[fidx(0)] = v; asum += fabsf(v); }
                else { fbuf[fidx(pos)] = f; fbuf[fidx(2 * SEQL - pos)] = b; asum += fabsf(f) + fabsf(b); }
            }
        }
        if (tid == 0) fbuf[fidx(SEQL)] = 0.f;
        asum = wave_sum(asum);
        if (lane == 0) red[w] = asum;
        __syncthreads();
        float norm = 0.f;
#pragma unroll
        for (int i = 0; i < 8; ++i) norm += red[i];
        fft_fwd_all(buf, tid, tw);
        const float sc = HY_YS / (norm * (float)FN);
#pragma unroll 2
        for (int i = 0; i < 16; ++i) { const int e = opaque(tid) + NTH * i; const HPair hp = pair_filter(buf, e, e == 0 ? sc : sc * PAIR_PRE, t12);
            Hs[o * 8192 + tid + NTH * i] = (f32x4){hp.hk.x, hp.hk.y, hp.hl.x, hp.hl.y}; }
        __syncthreads();
    }
    const float bias0 = p->in[15][(size_t)l * 2 * HYW + c], bias1 = p->in[15][(size_t)l * 2 * HYW + HYW + c];
    bf16_t* uct = (bf16_t*)((unsigned char*)p->out + DO_UCT);
    unsigned pa[2][8];
#pragma unroll
    for (int i = 0; i < 2; ++i) hy_load8(uct + (size_t)c * SEQL, (unsigned)(tid + NTH * i), pa[i]);
#pragma unroll 1
    for (int s = 0; s < NSEQ; ++s) {
        bf16_t* p0 = uct + ((size_t)s * HY3 + c) * SEQL; const bf16_t* p1 = p0 + (size_t)HYW * SEQL; const bf16_t* p2 = p0 + (size_t)2 * HYW * SEQL;
        v2f z1[2][8];
#pragma unroll
        for (int i = 0; i < 2; ++i) hy_step_a(dbuf, (unsigned)(opaque(tid) + NTH * i), pa[i], tw);
        __syncthreads();
        { unsigned pb[2][8];
          fft_fwd_123(dbuf, tid, tw);
          hy_pair_stage(dbuf, Hs + 0 * 8192, opaque(tid), t12);
          __syncthreads();
#pragma unroll
          for (int i = 0; i < 2; ++i) hy_load8(p1, (unsigned)(tid + NTH * i), pb[i]);
          fft_inv_012(dbuf, tid, tw);
#pragma unroll
          for (int i = 0; i < 2; ++i) hy_step_b(dbuf, (unsigned)(opaque(tid) + NTH * i), pa[i], pb[i], bias0, 1.f / HY_YS, z1[i], tw); }
        __syncthreads();
        { unsigned pc[2][8];
          fft_fwd_123(dbuf, tid, tw);
          hy_pair_stage(dbuf, Hs + 1 * 8192, opaque(tid), t12);
          __syncthreads();
#pragma unroll
          for (int i = 0; i < 2; ++i) hy_load8(p2, (unsigned)(tid + NTH * i), pc[i]);
          if (s + 1 < NSEQ) {
#pragma unroll
              for (int i = 0; i < 2; ++i) hy_load8(p0 + (size_t)HY3 * SEQL, (unsigned)(tid + NTH * i), pa[i]); }
          fft_inv_012(dbuf, tid, tw);
#pragma unroll
          for (int i = 0; i < 2; ++i) hy_step_c(dbuf, (unsigned)(opaque(tid) + NTH * i), pc[i], z1[i], bias1, 1.f / HY_YS, p0, tw); }
        __syncthreads();
    }
}
__device__ static const signed char CI_TAB[52] = {0,0,0,0,0,0,0,0,0,0,0,0,0,0,0,0,1,1,1,1,1,1,1,1,2,2,2,2,2,3,3,3,3,4,4,4,5,5,6,6,7,7,8,9,10,11,12,13,14,15,15,15};
__device__ static const signed char CJ_TAB[52] = {0,1,2,3,4,5,6,7,8,9,10,11,12,13,14,15,0,1,2,3,4,5,6,7,0,1,2,3,4,0,1,2,3,0,1,2,0,1,0,1,0,1,0,0,0,0,0,0,0,0,15,15};
constexpr int CI_C[52] = {0,0,0,0,0,0,0,0,0,0,0,0,0,0,0,0,1,1,1,1,1,1,1,1,2,2,2,2,2,3,3,3,3,4,4,4,5,5,6,6,7,7,8,9,10,11,12,13,14,15,15,15};
constexpr int CJ_C[52] = {0,1,2,3,4,5,6,7,8,9,10,11,12,13,14,15,0,1,2,3,4,5,6,7,0,1,2,3,4,0,1,2,3,0,1,2,0,1,0,1,0,1,0,0,0,0,0,0,0,0,15,15};
DV unsigned f2ord(float f) { const unsigned u = __builtin_bit_cast(unsigned, f); return (u >> 31) ? ~u : (u | 0x80000000u); }
DV float ord2f(unsigned k) { const unsigned u = (k >> 31) ? (k & 0x7fffffffu) : ~k; return __builtin_bit_cast(float, u); }
DV unsigned umax3(unsigned a, unsigned b, unsigned c) { return max(max(a, b), c); }
constexpr int SK_STR = 136, SK_LDS = 2 * 128 * SK_STR * 2;
DV void peer_stage_sk(KParams p, int l, int h, bf16_t* sks) {
    const bf16_t* sk = (const bf16_t*)(p->ws + WS_W + l * SZ_WL + OFF_SK) + (size_t)h * 2 * 128 * 128;
    __syncthreads();
#pragma unroll
    for (int i = 0; i < 8; ++i) { const int idx = tid_() + i * NTH, row = idx >> 4, ch = idx & 15; *(u32x4*)(sks + row * SK_STR + ch * 8) = ldg16(sk + (size_t)row * 128 + ch * 8); }
    __syncthreads();
}
DV void peer_topk_loadq(KParams p, int tile, int h, bf16x8 (&bqa)[2][4]) {
    const int lane = tid_() & 63, w = wave_(), fr = lane & 15, fq = lane >> 4;
    const bf16_t* qp = (const bf16_t*)p->out + ((size_t)tile * 128 + w * 16 + fr) * 2048 + h * 256 + fq * 8;
#pragma unroll
    for (int c = 0; c < 2; ++c)
#pragma unroll
        for (int ks = 0; ks < 4; ++ks) bqa[c][ks] = *(const bf16x8*)(qp + c * 128 + ks * 32);
}
DV void merge16_xor(unsigned (&k)[16], int m) {
    unsigned o[16];
#pragma unroll
    for (int i = 0; i < 16; ++i) o[i] = (unsigned)__shfl_xor((int)k[15 - i], m);
#pragma unroll
    for (int i = 0; i < 16; ++i) k[i] = max(k[i], o[i]);
    bitonic_merge_desc<16>(k);
}
DV void peer_topk_item(KParams p, int l, int tile, int h, bf16_t* sks, const bf16x8 (&bqa)[2][4]) {
    const int lane = tid_() & 63, w = wave_(), fr = lane & 15, fq = lane >> 4;
    const size_t t0 = (size_t)tile * 128 + w * 16;
    unsigned tk[2][16];
#pragma unroll
    for (int c = 0; c < 2; ++c) {
        bf16x8 bq[4];
#pragma unroll
        for (int ks = 0; ks < 4; ++ks) bq[ks] = bqa[c][ks];
        unsigned key[32];
        const bf16_t* skc = sks + c * 128 * SK_STR;
#pragma unroll
        for (int kt = 0; kt < 8; ++kt) {
            f32x4 s = (f32x4){0.f, 0.f, 0.f, 0.f};
#pragma unroll
            for (int ks = 0; ks < 4; ++ks) { const bf16x8 a = *(const bf16x8*)(skc + (kt * 16 + fr) * SK_STR + ks * 32 + fq * 8); s = __builtin_amdgcn_mfma_f32_16x16x32_bf16(a, bq[ks], s, 0, 0, 0); }
#pragma unroll
            for (int j = 0; j < 4; ++j) { const int kidx = kt * 16 + fq * 4 + j; key[kt * 4 + j] = (f2ord(s[j]) & 0xffffff80u) | (unsigned)(127 - kidx); }
        }
        unsigned k16[16];
        { unsigned kb[16];
#pragma unroll
          for (int r = 0; r < 16; ++r) { k16[r] = key[r]; kb[r] = key[16 + r]; }
          bitonic_sort_desc<16>(k16); bitonic_sort_desc<16>(kb);
#pragma unroll
          for (int r = 0; r < 16; ++r) k16[r] = max(k16[r], kb[15 - r]);
          bitonic_merge_desc<16>(k16); }
        merge16_xor(k16, 16); merge16_xor(k16, 32);
#pragma unroll
        for (int r = 0; r < 16; ++r) tk[c][r] = k16[r];
    }
    float v0[16], v1[16];
#pragma unroll
    for (int r = 0; r < 16; ++r) { v0[r] = ord2f(tk[0][r] & 0xffffff80u); v1[r] = ord2f(tk[1][r] & 0xffffff80u); }
    unsigned ck[13]; int ce[13];
#pragma unroll
    for (int s = 0; s < 13; ++s) {
        float sum[4]; int ee[4];
#pragma unroll
        for (int q = 0; q < 4; ++q) { const int i = CI_C[q + 4 * s], j = CJ_C[q + 4 * s]; sum[q] = v0[i] + v1[j];
            ee[q] = (127 - (int)(tk[0][i] & 127u)) * 128 + (127 - (int)(tk[1][j] & 127u)); }
        const float sm = fq == 0 ? sum[0] : (fq == 1 ? sum[1] : (fq == 2 ? sum[2] : sum[3]));
        ce[s] = fq == 0 ? ee[0] : (fq == 1 ? ee[1] : (fq == 2 ? ee[2] : ee[3]));
        ck[s] = (f2ord(sm) & 0xffffffc0u) | (unsigned)(63 - (4 * s)) ;
        ck[s] -= (unsigned)fq;
    }
    int* celds = (int*)(sks + 2 * 128 * SK_STR) + (w * 16 + fr) * 52;
#pragma unroll
    for (int s = 0; s < 13; ++s) celds[fq + 4 * s] = ce[s];
    float myv[4]; int myc[4]; float w0;
    { unsigned c16[16];
#pragma unroll
      for (int i = 0; i < 16; ++i) c16[i] = i < 13 ? ck[i] : 0u;
      bitonic_sort_desc<16>(c16);
      merge16_xor(c16, 16); merge16_xor(c16, 32);
      w0 = ord2f(c16[0] & 0xffffffc0u);
#pragma unroll
      for (int i = 0; i < 4; ++i) { const unsigned mk = fq == 0 ? c16[i] : (fq == 1 ? c16[4 + i] : (fq == 2 ? c16[8 + i] : c16[12 + i]));
          myv[i] = ord2f(mk & 0xffffffc0u); myc[i] = 63 - (int)(mk & 63u); } }
    int mye[4];
#pragma unroll
    for (int i = 0; i < 4; ++i) mye[i] = celds[myc[i]];
    float ex[4], ps = 0.f;
#pragma unroll
    for (int i = 0; i < 4; ++i) { ex[i] = __expf(myv[i] - w0); ps += ex[i]; }
    ps += __shfl_xor(ps, 16); ps += __shfl_xor(ps, 32);
    const float inv = 1.f / ps;
    unsigned short* eidx = (unsigned short*)(p->ws + WS_EIDX) + (t0 + fr) * 128 + 16 * h + 4 * fq; float* gate = (float*)(p->ws + WS_GATE) + (t0 + fr) * 128 + 16 * h + 4 * fq;
    *(uint2*)eidx = make_uint2((unsigned)mye[0] | ((unsigned)mye[1] << 16), (unsigned)mye[2] | ((unsigned)mye[3] << 16));
    *(f32x4*)gate = (f32x4){ex[0] * inv, ex[1] * inv, ex[2] * inv, ex[3] * inv};
}

typedef float f32x2 __attribute__((ext_vector_type(2)));
DV float gelu_exact(float x) { return 0.5f * x * (1.f + erff(x * 0.7071067811865476f)); }
constexpr size_t SLICE_BYTES = (size_t)NEXP * 128;
DV int peer_q0(int s) { return ((s >> 2) & 1) * 8 + ((s >> 1) & 1) * 4 + (s & 1) * 2; }
struct PeerUIn { u32x4 e; };
constexpr int NSL = 4;
typedef int i32x8 __attribute__((ext_vector_type(8)));
DV PeerUIn peer_u_in(KParams p, size_t t, int lane) {
    PeerUIn r; r.e = ldg16((const unsigned short*)(p->ws + WS_EIDX) + t * 128 + (lane >> 2) * 8); return r;
}
DV unsigned peer_e8(const u32x4& a, int g) { const unsigned w = g < 2 ? a.x : g < 4 ? a.y : g < 6 ? a.z : a.w; return (g & 1) ? (w >> 16) : (w & 0xffffu); }
DV void peer_u_gather(KParams p, const unsigned char* U4, const PeerUIn& in, int sl, size_t t, int lane, u32x4 (&r)[16], u32x4 (&x)[2]) {
#pragma unroll
    for (int g = 0; g < 8; ++g) { const unsigned char* row = U4 + (size_t)peer_e8(in.e, g) * 128; r[2 * g] = ldg16(row); r[2 * g + 1] = ldg16(row + 64); }
    const unsigned char* xh = p->ws + WS_X8 + t * D + 256 * sl + (lane & 3) * 32 + ((lane >> 4) & 1) * 16;
    x[0] = ldg16(xh); x[1] = ldg16(xh + 128);
}
DV i32x8 cat8(const u32x4& a, const u32x4& b) { return (i32x8){(int)a.x, (int)a.y, (int)a.z, (int)a.w, (int)b.x, (int)b.y, (int)b.z, (int)b.w}; }
DV float quad_sum(float v) {
    v += __builtin_bit_cast(float, __builtin_amdgcn_update_dpp(0, __builtin_bit_cast(int, v), 0xB1, 0xf, 0xf, true));
    v += __builtin_bit_cast(float, __builtin_amdgcn_update_dpp(0, __builtin_bit_cast(int, v), 0x4E, 0xf, 0xf, true));
    return v;
}
DV void peer_u_finish(KParams p, int sl, size_t t, int lane, const u32x4 (&r)[16], const u32x4 (&x)[2]) {
    const bool k0 = ((lane >> 2) & 3) == (lane >> 5), k1 = ((lane >> 2) & 3) == 2 + (lane >> 5);
    const u32x4 z4 = (u32x4){0u, 0u, 0u, 0u};
    const i32x8 x0 = cat8(k0 ? x[0] : z4, k1 ? x[0] : z4), x1 = cat8(k0 ? x[1] : z4, k1 ? x[1] : z4);
    const int c = lane & 3; const bool c0 = (c & 1) != 0, c1 = (c & 2) != 0;
    float h[8];
#pragma unroll
    for (int g = 0; g < 8; ++g) {
        f32x4 acc = __builtin_amdgcn_mfma_scale_f32_16x16x128_f8f6f4(cat8(r[2 * g], z4), x0, (f32x4){0.f, 0.f, 0.f, 0.f}, 4, 0, 0, 0, 0, 0);
        acc = __builtin_amdgcn_mfma_scale_f32_16x16x128_f8f6f4(cat8(r[2 * g + 1], z4), x1, acc, 4, 0, 0, 0, 0, 0);
        const float d0 = c0 ? acc[1] : acc[0], d1 = c0 ? acc[3] : acc[2];
        h[g] = quad_sum(c1 ? d1 : d0); }
    const int e = (lane >> 4) + 4 * ((lane >> 2) & 3);
    if (c == 0) {
        bf16_t* part = (bf16_t*)((unsigned*)p->out + ((size_t)sl * T + t) * 64) + e * 8;
        stg16(part, (u32x4){pk2(h[0], h[1]), pk2(h[2], h[3]), pk2(h[4], h[5]), pk2(h[6], h[7])}); }
}
DV void peer_u_phase(KParams p, int l, int bid, int nblk) {
    const int wv = wave_(), lane = tid_() & 63, j = bid & 7, sl = j & 3, half = j >> 2, b8 = bid >> 3, nb8 = nblk >> 3;
    const unsigned char* U4 = p->ws + WS_EXP + (size_t)(2 * l) * SZ_EXP1 + (size_t)sl * SLICE_BYTES + (lane & 3) * 16;
    const size_t step = (size_t)nb8 * 16; size_t t = (size_t)(b8 * 8 + wv) * 2 + half;
    if (t >= (size_t)T) return;
    const size_t t0 = t;
    size_t ta = t, tb = t + step;
    u32x4 ra[16], rb[16], xa[2], xb[2];
    { const PeerUIn a = peer_u_in(p, ta, lane), b = peer_u_in(p, tb < (size_t)T ? tb : t0, lane);
      peer_u_gather(p, U4, a, sl, ta, lane, ra, xa); peer_u_gather(p, U4, b, sl, tb < (size_t)T ? tb : t0, lane, rb, xb); }
    PeerUIn na = peer_u_in(p, ta + 2 * step < (size_t)T ? ta + 2 * step : t0, lane), nb = peer_u_in(p, tb + 2 * step < (size_t)T ? tb + 2 * step : t0, lane);
#pragma unroll 1
    while (ta < (size_t)T) {
        peer_u_finish(p, sl, ta, lane, ra, xa);
        ta += 2 * step;
        peer_u_gather(p, U4, na, sl, ta < (size_t)T ? ta : t0, lane, ra, xa);
        na = peer_u_in(p, ta + 2 * step < (size_t)T ? ta + 2 * step : t0, lane);
        if (tb < (size_t)T) peer_u_finish(p, sl, tb, lane, rb, xb);
        tb += 2 * step;
        peer_u_gather(p, U4, nb, sl, tb < (size_t)T ? tb : t0, lane, rb, xb);
        nb = peer_u_in(p, tb + 2 * step < (size_t)T ? tb + 2 * step : t0, lane);
    }
}
DV unsigned peer_e16(const u32x4& a, const u32x4& b, int q) {
    const unsigned w = q < 2 ? a.x : q < 4 ? a.y : q < 6 ? a.z : q < 8 ? a.w : q < 10 ? b.x : q < 12 ? b.y : q < 14 ? b.z : b.w;
    return (q & 1) ? (w >> 16) : (w & 0xffffu);
}
typedef _Float16 h16x2 __attribute__((ext_vector_type(2)));
DV h16x2 fp8h(unsigned w, bool hi) { return hi ? __builtin_amdgcn_cvt_scalef32_pk_f16_fp8(w, 1.0f, true) : __builtin_amdgcn_cvt_scalef32_pk_f16_fp8(w, 1.0f, false); }
constexpr size_t DO_COEF = (size_t)T * D * 2;
constexpr size_t DO_CSC = DO_COEF + (size_t)NSL * T * 128;
DV void peer_c_phase(KParams p, int l, int bid, int nblk) {
    const int wv = wave_(), lane = tid_() & 63, g = lane >> 3, s = lane & 7;
    const unsigned char* tabu = p->ws + WS_EXP + (size_t)(2 * l) * SZ_EXP1; const unsigned char* tabv = tabu + SZ_EXP1;
    const unsigned char* sc16 = tabu + NSL * SLICE_BYTES;
    const int o2 = g * 16 + peer_q0(s);
    const size_t step = (size_t)nblk * 8;
#pragma unroll 1
    for (size_t t0 = (size_t)bid * 8 + wv; t0 < (size_t)T; t0 += 4 * step) {
        unsigned pw[4][NSL]; unsigned ew[4]; f32x2 gt[4];
#pragma unroll
        for (int k = 0; k < 4; ++k) { const size_t t = t0 + k * step < (size_t)T ? t0 + k * step : t0;
            const unsigned* part = (const unsigned*)p->out + t * 64 + lane;
#pragma unroll
            for (int q = 0; q < NSL; ++q) pw[k][q] = part[(size_t)q * T * 64];
            ew[k] = *(const unsigned*)((const unsigned short*)(p->ws + WS_EIDX) + t * 128 + o2);
            gt[k] = *(const f32x2*)((const float*)(p->ws + WS_GATE) + t * 128 + o2); }
#pragma unroll
        for (int k = 0; k < 4; ++k) { const size_t t = t0 + k * step;
            const int e0 = (int)(ew[k] & 0xffffu), e1 = (int)(ew[k] >> 16);
            const f32x4 su0 = *(const f32x4*)(sc16 + (size_t)e0 * 32), sv0 = *(const f32x4*)(sc16 + (size_t)e0 * 32 + 16);
            const f32x4 su1 = *(const f32x4*)(sc16 + (size_t)e1 * 32), sv1 = *(const f32x4*)(sc16 + (size_t)e1 * 32 + 16);
            float a0 = 0.f, a1 = 0.f;
#pragma unroll
            for (int q = 0; q < NSL; ++q) { a0 += bflo(pw[k][q]) * su0[q]; a1 += bfhi(pw[k][q]) * su1[q]; }
            float v0[NSL] = {sv0[0], sv0[1], sv0[2], sv0[3]}, v1[NSL] = {sv1[0], sv1[1], sv1[2], sv1[3]};
            const float c0 = gt[k].x * gelu_exact(a0), c1 = gt[k].y * gelu_exact(a1);
            float mx = 0.f;
#pragma unroll
            for (int q = 0; q < NSL; ++q) { v0[q] *= c0; v1[q] *= c1; mx = fmaxf(mx, fmaxf(fabsf(v0[q]), fabsf(v1[q]))); }
            mx = wave_max(mx);
            const float S = mx > 0.f ? 128.f / mx : 0.f;
            if (t < (size_t)T) {
#pragma unroll
                for (int q = 0; q < NSL; ++q) *(unsigned short*)((unsigned char*)p->out + DO_COEF + ((size_t)q * T + t) * 128 + o2) = (unsigned short)__builtin_amdgcn_cvt_pk_fp8_f32(v0[q] * S, v1[q] * S, 0, false);
                if (lane == 0) ((float*)((unsigned char*)p->out + DO_CSC))[t] = mx * (1.f / 128.f); } }
    }
}
struct PeerVIn { u32x4 e0, e1; };
DV PeerVIn peer_v_in(KParams p, size_t t, int lane) {
    PeerVIn r; const unsigned short* eidx = (const unsigned short*)(p->ws + WS_EIDX) + t * 128 + (lane >> 3) * 16;
    r.e0 = ldg16(eidx); r.e1 = ldg16(eidx + 8); return r;
}
struct PeerVCo { u32x2 ca, cb; float isc; };
DV void peer_v_gather(KParams p, const unsigned char* V4, const unsigned char* coef, const PeerVIn& in, size_t t, u32x4 (&r)[16], PeerVCo& c) {
#pragma unroll
    for (int q = 0; q < 16; ++q) r[q] = ldg16(V4 + (size_t)peer_e16(in.e0, in.e1, q) * 128);
    c.ca = *(const u32x2*)(coef + t * 128); c.cb = *(const u32x2*)(coef + t * 128 + 64);
    c.isc = ((const float*)((const unsigned char*)p->out + DO_CSC))[t];
}
DV float add_ror8(float a, float b) { return a + __builtin_bit_cast(float, __builtin_amdgcn_update_dpp(0, __builtin_bit_cast(int, b), 0x128, 0xf, 0xf, true)); }
DV void peer_v_finish(KParams p, int sl, size_t t, int lane, const PeerVCo& co, const u32x4 (&r)[16]) {
    const int m = lane & 15; const bool z = (m & 2) != 0, live = m < 4;
    const unsigned s0 = z ? 0x010c000cu : 0x0c010c00u, s1 = z ? 0x030c020cu : 0x0c030c02u;
    const unsigned cax = live ? co.ca.x : 0u, cay = live ? co.ca.y : 0u, cbx = live ? co.cb.x : 0u, cby = live ? co.cb.y : 0u;
    const i32x8 A = (i32x8){(int)__builtin_amdgcn_perm(0u, cax, s0), (int)__builtin_amdgcn_perm(0u, cax, s1), (int)__builtin_amdgcn_perm(0u, cay, s0), (int)__builtin_amdgcn_perm(0u, cay, s1),
                            (int)__builtin_amdgcn_perm(0u, cbx, s0), (int)__builtin_amdgcn_perm(0u, cbx, s1), (int)__builtin_amdgcn_perm(0u, cby, s0), (int)__builtin_amdgcn_perm(0u, cby, s1)};
    float y[32];
#pragma unroll
    for (int w = 0; w < 4; ++w) {
        unsigned Tt[4][4];
#pragma unroll
        for (int u = 0; u < 4; ++u) {
            const unsigned a0 = r[4 * u][w], a1 = r[4 * u + 1][w], a2 = r[4 * u + 2][w], a3 = r[4 * u + 3][w];
            const unsigned p0 = __builtin_amdgcn_perm(a1, a0, 0x05010400u), p1 = __builtin_amdgcn_perm(a1, a0, 0x07030602u);
            const unsigned p2 = __builtin_amdgcn_perm(a3, a2, 0x05010400u), p3 = __builtin_amdgcn_perm(a3, a2, 0x07030602u);
            Tt[0][u] = __builtin_amdgcn_perm(p2, p0, 0x05040100u); Tt[1][u] = __builtin_amdgcn_perm(p2, p0, 0x07060302u);
            Tt[2][u] = __builtin_amdgcn_perm(p3, p1, 0x05040100u); Tt[3][u] = __builtin_amdgcn_perm(p3, p1, 0x07060302u);
        }
#pragma unroll
        for (int bq = 0; bq < 4; ++bq) {
            const i32x8 B = (i32x8){(int)Tt[bq][0], (int)Tt[bq][1], (int)Tt[bq][2], (int)Tt[bq][3], 0, 0, 0, 0};
            const f32x4 acc = __builtin_amdgcn_mfma_scale_f32_16x16x128_f8f6f4(A, B, (f32x4){0.f, 0.f, 0.f, 0.f}, 0, 4, 0, 0, 0, 0);
            const int j = 4 * w + bq;
            y[2 * j] = add_ror8(acc[0], acc[1]); y[2 * j + 1] = add_ror8(acc[2], acc[3]);
        }
    }
    if (lane < 8) {
        const size_t off = t * D + 256 * sl + lane * 32;
        const bf16_t* xr = (const bf16_t*)(p->ws + WS_XB) + off; bf16_t* yo = (bf16_t*)(p->ws + WS_HY) + off;
        const float isc = co.isc;
#pragma unroll
        for (int i = 0; i < 4; ++i) { const u32x4 xw = ldg16(xr + 8 * i); u32x4 o;
            o.x = pk2(ALPHA * bflo(xw.x) + y[8 * i + 0] * isc, ALPHA * bfhi(xw.x) + y[8 * i + 1] * isc); o.y = pk2(ALPHA * bflo(xw.y) + y[8 * i + 2] * isc, ALPHA * bfhi(xw.y) + y[8 * i + 3] * isc);
            o.z = pk2(ALPHA * bflo(xw.z) + y[8 * i + 4] * isc, ALPHA * bfhi(xw.z) + y[8 * i + 5] * isc); o.w = pk2(ALPHA * bflo(xw.w) + y[8 * i + 6] * isc, ALPHA * bfhi(xw.w) + y[8 * i + 7] * isc);
            stg16(yo + 8 * i, o); }
    }
}
DV void peer_v_phase(KParams p, int l, int bid, int nblk) {
    const int wv = wave_(), lane = tid_() & 63, lab = bid & 7, sl = lab & 3, half = lab >> 2, b8 = bid >> 3, nb8 = nblk >> 3, s = lane & 7;
    const unsigned char* V4 = p->ws + WS_EXP + (size_t)(2 * l + 1) * SZ_EXP1 + (size_t)sl * SLICE_BYTES + s * 16;
    const unsigned char* coef = (const unsigned char*)p->out + DO_COEF + (size_t)sl * T * 128 + (2 * (lane >> 5) + (lane & 1)) * 16 + ((lane >> 4) & 1) * 8;
    const size_t step = (size_t)nb8 * 16; size_t t = ((size_t)b8 * 8 + wv) * 2 + half;
    if (t >= (size_t)T) return;
    const size_t t0 = t;
    size_t ta = t, tb = t + step;
    u32x4 ra[16], rb[16]; PeerVCo ca, cb;
    { const PeerVIn a = peer_v_in(p, ta, lane), b = peer_v_in(p, tb < (size_t)T ? tb : t0, lane);
      peer_v_gather(p, V4, coef, a, ta, ra, ca); peer_v_gather(p, V4, coef, b, tb < (size_t)T ? tb : t0, rb, cb); }
    PeerVIn na = peer_v_in(p, ta + 2 * step < (size_t)T ? ta + 2 * step : t0, lane), nb = peer_v_in(p, tb + 2 * step < (size_t)T ? tb + 2 * step : t0, lane);
#pragma unroll 1
    while (ta < (size_t)T) {
        peer_v_finish(p, sl, ta, lane, ca, ra);
        ta += 2 * step;
        peer_v_gather(p, V4, coef, na, ta < (size_t)T ? ta : t0, ra, ca);
        na = peer_v_in(p, ta + 2 * step < (size_t)T ? ta + 2 * step : t0, lane);
        if (tb < (size_t)T) peer_v_finish(p, sl, tb, lane, cb, rb);
        tb += 2 * step;
        peer_v_gather(p, V4, coef, nb, tb < (size_t)T ? tb : t0, rb, cb);
        nb = peer_v_in(p, tb + 2 * step < (size_t)T ? tb + 2 * step : t0, lane);
    }
}
DV void ln2_job(KParams p, int l, int bid, int nblk) { ln_job(p->in[25] + (size_t)l * D, p->in[26] + (size_t)l * D, (const bf16_t*)(p->ws + WS_HY), l == DEPTH - 1 ? nullptr : (bf16_t*)(p->ws + WS_XB), p->out, bid, nblk); }


#define XB_TMO      128
#define XB_XCNT(j)  (256  + 64 * (j))
#define XB_XSUB(j)  (1280 + 64 * (j))
#define XB_XGEN(j)  (2304 + 64 * (j))
#define XB_TOP      3328
#define XB_TOPGEN   3392
#define XCD_BAR_WORDS 3456
#define XB_SPIN_CAP (1u << 18)
DV unsigned xb_ld(unsigned* p)              { return __hip_atomic_load(p, __ATOMIC_RELAXED, __HIP_MEMORY_SCOPE_AGENT); }
DV unsigned xb_add(unsigned* p, unsigned v) { return __hip_atomic_fetch_add(p, v, __ATOMIC_RELAXED, __HIP_MEMORY_SCOPE_AGENT); }
DV unsigned xb_xcc_id() { return (unsigned)__builtin_amdgcn_s_getreg((3 << 11) | 20) & 0xFu; }
#define XB_SPIN(cond, bar) do { unsigned _sp = 0; while (cond) { __builtin_amdgcn_s_sleep(1); \
    if ((++_sp & 255u) == 0u) { if (xb_ld(&(bar)[XB_TMO])) break; if (_sp > XB_SPIN_CAP) { atomicAdd(&(bar)[XB_TMO], 1u); break; } } } } while (0)
struct XcdBarrier { unsigned* bar; unsigned x; volatile LAS unsigned* st; };
DV XcdBarrier xcd_barrier_post(unsigned* bar, volatile LAS unsigned* st) {
    XcdBarrier b; b.bar = bar; b.x = xb_xcc_id(); b.st = st;
    if (threadIdx.x == 0) (void)xb_add(&bar[XB_XCNT(b.x)], 1u);
    return b;
}
DV void xcd_barrier_complete(unsigned* bar, unsigned x, unsigned& nloc, unsigned& nx) {
    const unsigned G = gridDim.x * gridDim.y * gridDim.z;
    unsigned sum, cnt, mine, sp = 0u;
    for (;;) {
        sum = 0u; cnt = 0u; mine = 0u;
        unsigned cv[16];
#pragma unroll
        for (unsigned j = 0; j < 16; ++j) cv[j] = xb_ld(&bar[XB_XCNT(j)]);
#pragma unroll
        for (unsigned j = 0; j < 16; ++j) { const unsigned c = cv[j]; sum += c; cnt += (c > 0u) ? 1u : 0u; mine = (j == x) ? c : mine; }
        if (sum == G) break;
        __builtin_amdgcn_s_sleep(1);
        if ((++sp & 255u) == 0u) { if (xb_ld(&bar[XB_TMO])) break; if (sp > XB_SPIN_CAP) { atomicAdd(&bar[XB_TMO], 1u); break; } }
    }
    nloc = mine > 0u ? mine : 1u; nx = cnt > 0u ? cnt : 1u;
}
DV void xcd_barrier(const XcdBarrier& b) {
    asm volatile("s_waitcnt vmcnt(0)" ::: "memory");
    __syncthreads();
    if (threadIdx.x == 0) {
        unsigned* bar = b.bar;
        __builtin_amdgcn_s_waitcnt(0);
        unsigned nloc = b.st[0], nx = b.st[1];
        if (nloc == 0u) { xcd_barrier_complete(bar, b.x, nloc, nx); b.st[0] = nloc; b.st[1] = nx; }
        const unsigned old = xb_add(&bar[XB_XSUB(b.x)], 1u);
        const unsigned gen = old / nloc;
        if (old + 1u == (gen + 1u) * nloc) {
            __builtin_amdgcn_fence(__ATOMIC_RELEASE, "agent");
            asm volatile("s_waitcnt vmcnt(0)" ::: "memory");
            const unsigned og = xb_add(&bar[XB_TOP], 1u);
            const unsigned tg = og / nx;
            if (og + 1u == (tg + 1u) * nx) xb_add(&bar[XB_TOPGEN], 1u);
            else XB_SPIN(xb_ld(&bar[XB_TOPGEN]) == tg, bar);
            __builtin_amdgcn_fence(__ATOMIC_ACQUIRE, "agent");
            xb_add(&bar[XB_XGEN(b.x)], 1u);
            asm volatile("s_waitcnt vmcnt(0)" ::: "memory");
        } else {
            XB_SPIN(xb_ld(&bar[XB_XGEN(b.x)]) == gen, bar);
            __builtin_amdgcn_fence(__ATOMIC_ACQUIRE, "agent");
            asm volatile("s_waitcnt vmcnt(0)" ::: "memory");
        }
    }
    __syncthreads();
}
constexpr int LDS_BYTES = 139264 + 1024 + 288 * 8 + 256;
constexpr int PH_PER_LAYER = 13, NPHASE = 1 + DEPTH * PH_PER_LAYER;
DV void convert_experts(KParams p, int bid, int nblk) {
    const int lane = tid_() & 63, wv = wave_();
#pragma unroll 1
    for (int r = bid * 8 + wv; r < 4 * NEXP; r += nblk * 8) {
        const int tab = r / NEXP, e = r - tab * NEXP, l = tab >> 1, uv = tab & 1;
        unsigned char* dstb = p->ws + WS_EXP + (size_t)tab * SZ_EXP1;
        const float* src = p->in[23 + uv] + ((size_t)l * NEXP + e) * D + lane * 4;
        f32x4 v[4];
#pragma unroll
        for (int j = 0; j < 4; ++j) v[j] = *(const f32x4*)(src + 256 * j);
        float bmj[4];
#pragma unroll
        for (int j = 0; j < 4; ++j) {
            float bm = fmaxf(fmaxf(fabsf(v[j].x), fabsf(v[j].y)), fmaxf(fabsf(v[j].z), fabsf(v[j].w))); bm = wave_max(bm);
            bmj[j] = bm * (1.f / 6.f);
            const float es = bm > 0.f ? 6.f / bm : 0.f;
            unsigned pk = 0;
            pk = __builtin_amdgcn_cvt_scalef32_pk_fp4_f32(pk, v[j].x * es, v[j].y * es, 1.0f, 0);
            pk = __builtin_amdgcn_cvt_scalef32_pk_fp4_f32(pk, v[j].z * es, v[j].w * es, 1.0f, 1);
            *(unsigned short*)(dstb + (size_t)j * SLICE_BYTES + (size_t)e * 128 + 2 * lane) = (unsigned short)pk;
        }
        if (lane == 0) {
            unsigned char* rec = p->ws + WS_EXP + (size_t)(2 * l) * SZ_EXP1 + NSL * SLICE_BYTES + (size_t)e * 32 + uv * 16;
            *(f32x4*)rec = (f32x4){bmj[0], bmj[1], bmj[2], bmj[3]}; }
    }
}
DV void run_phase0(KParams p, unsigned char* smem) {
    const int bid = blockIdx.x, nblk = gridDim.x;
    cvt_job(p->in[0], (bf16_t*)(p->ws + WS_XB), (size_t)2 * SEQL * D, bid, nblk);
    cvt_job(p->in[1], (bf16_t*)(p->ws + WS_XB) + (size_t)2 * SEQL * D, (size_t)SEQL * D, bid, nblk);
    cvt_job(p->in[2], (bf16_t*)(p->ws + WS_MEMB), (size_t)2 * N_MEM * D, bid, nblk);
    cvt_job(p->in[3], (bf16_t*)(p->ws + WS_MEMB) + (size_t)2 * N_MEM * D, (size_t)N_MEM * D, bid, nblk);
#pragma unroll 1
    for (int l = 0; l < DEPTH; ++l) {
        unsigned char* wl = p->ws + WS_W + l * SZ_WL;
        cvt_job(p->in[22] + (size_t)l * 8 * 2 * 128 * 128, (bf16_t*)(wl + OFF_SK), (size_t)8 * 2 * 128 * 128, bid, nblk);
        transpose_job(p->in[5] + (size_t)l * D * IN_WIDTH, D, IN_WIDTH, (bf16_t*)(wl + OFF_WT_IN), bid, nblk, (float*)smem);
#pragma unroll 1
        for (int n = 0; n < 3; ++n) transpose_job(p->in[17] + ((size_t)l * 3 + n) * 512 * D, 512, D, (bf16_t*)(wl + OFF_WT_BR) + (size_t)n * D * 512, bid, nblk, (float*)smem);
        transpose_job(p->in[18] + (size_t)l * D * D, D, D, (bf16_t*)(wl + OFF_WT_OUT), bid, nblk, (float*)smem);
        transpose_job(p->in[21] + (size_t)l * D * 2048, D, 2048, (bf16_t*)(wl + OFF_WT_Q), bid, nblk, (float*)smem);
        transpose_job(p->in[16] + (size_t)l * D * D, D, D, (bf16_t*)(wl + OFF_WT_MKV), bid, nblk, (float*)smem);
        transpose_job(p->in[14] + (size_t)l * FHID * 2048, FHID, 2048, (bf16_t*)(p->ws + WS_WOT) + (size_t)l * 2048 * FHID, bid, nblk, (float*)smem);
    }
    for (int k = bid * NTH + tid_(); k < 16384; k += nblk * NTH) { float sn, cs; sincospif((float)k * (1.f / 16384.f), &sn, &cs); ((float2*)(p->ws + WS_TW))[k] = make_float2(cs, -sn); }
    convert_experts(p, bid, nblk);
    filter_mlp_job(p, bid, nblk);
}
#ifndef ONLY_Q
#define ONLY_Q -1
#endif
template <int Q> DV void run_phase_q(KParams p, int l, unsigned char* smem) {
    const int bid = opaque_s(blockIdx.x), nblk = opaque_s(gridDim.x);
    if (ONLY_Q >= 0 && Q != ONLY_Q) return;
    if (Q == 0) {
        SchedG1 S{p, l, nblk, bid}; EpiG1 E{p, l};
        __syncthreads();
        pg8::gemm_stream(( LAS unsigned char*)smem, S, E);
    } else if (Q == 1) {
        const int na = 768, nm = 768, nf = 1024, ns = NSEQ * 64 * 24;
#pragma unroll 1
        for (int t = bid; t < na + nm + nf + ns; t += nblk) {
            if (t < na) attn_item<true>(p, l, t, smem);
            else if (t < na + nm) attn_item<false>(p, l, t - na, smem);
            else if (t < na + nm + nf) filt_tile(p, l, t - na - nm, smem);
            else shortconv_item(p, l, t - na - nm - nf, (float*)smem);
        }
    } else if (Q == 2) {
#pragma unroll 1
        for (int c = bid; c < HYW; c += nblk) hyena_item(p, l, c, smem);
    } else if (Q == 3) {
#pragma unroll 1
        for (int t = bid; t < NSEQ * 64 * 8; t += nblk) hyo_transpose_item(p, t, (bf16_t*)smem);
    } else if (Q == 4) {
        SchedMerge S{p, l, nblk, bid}; EpiMerge E{p, l};
        __syncthreads();
        pg8::gemm_stream((LAS unsigned char*)smem, S, E);
    } else if (Q == 5) {
        SchedOut S{p, l, nblk, bid}; EpiOut E{p};
        __syncthreads();
        pg8::gemm_stream((LAS unsigned char*)smem, S, E);
    } else if (Q == 6) ln1_job(p, l, bid, nblk);
    else if (Q == 7) {
        SchedQ S{p, l, nblk, bid}; EpiQ E{p};
        __syncthreads();
        pg8::gemm_stream((LAS unsigned char*)smem, S, E);
    } else if (Q == 8) {
        const int h = bid & 7, b8 = bid >> 3, nb8 = nblk >> 3;
        peer_stage_sk(p, l, h, (bf16_t*)smem);
        bf16x8 bqn[2][4];
        if (b8 < T / 128) peer_topk_loadq(p, b8, h, bqn);
#pragma unroll 1
        for (int tile = b8; tile < T / 128; tile += nb8) {
            bf16x8 bqc[2][4];
#pragma unroll
            for (int c = 0; c < 2; ++c)
#pragma unroll
                for (int ks = 0; ks < 4; ++ks) bqc[c][ks] = bqn[c][ks];
            if (tile + nb8 < T / 128) peer_topk_loadq(p, tile + nb8, h, bqn);
            peer_topk_item(p, l, tile, h, (bf16_t*)smem, bqc);
        }
    } else if (Q == 9) peer_u_phase(p, l, bid, nblk);
    else if (Q == 11) peer_v_phase(p, l, bid, nblk);
    else if (Q == 10) peer_c_phase(p, l, bid, nblk);
    else ln2_job(p, l, bid, nblk);
}
#ifdef PROBE_PHASE
#define PROBE_STAMP(i) { if (blockIdx.x == 0 && threadIdx.x == 0) __hip_atomic_store((unsigned long long*)(p.ws + WS_TS) + (i), (unsigned long long)__builtin_amdgcn_s_memrealtime(), __ATOMIC_RELAXED, __HIP_MEMORY_SCOPE_AGENT); }
#else
#define PROBE_STAMP(i)
#endif
#define PHASE_STEP(Q) { const int ph = 1 + l * PH_PER_LAYER + Q; if (ph >= p.ph_lo && ph < p.ph_hi) { run_phase_q<Q>(kparams(), l, smem); if (ph + 1 < p.ph_hi) GRID_SYNC(); PROBE_STAMP(ph + 1) } }
__global__ void __launch_bounds__(NTH, 2) encoder_fwd(Params p) {
    extern __shared__ __attribute__((aligned(16))) unsigned char smem[];
    cg::grid_group grid = cg::this_grid();
    PROBE_STAMP(0)
    volatile LAS unsigned* xst = (volatile LAS unsigned*)(smem + LDS_BYTES - 16);
    unsigned* xbar = (unsigned*)(p.ws + WS_BAR);
    if (threadIdx.x == 0) { xst[0] = 0u; xst[1] = 0u; }
    if (p.ph_lo == 0 && blockIdx.x == 0) for (int i = threadIdx.x; i < XCD_BAR_WORDS; i += NTH) __hip_atomic_store(xbar + i, 0u, __ATOMIC_RELAXED, __HIP_MEMORY_SCOPE_AGENT);
    XcdBarrier xb; xb.bar = xbar; xb.x = 0; xb.st = xst;
#define GRID_SYNC() xcd_barrier(xb)
    if (p.ph_lo == 0) { if (ONLY_Q < 0 || ONLY_Q == 100) run_phase0(kparams(), smem); if (1 < p.ph_hi) { grid.sync(); xb = xcd_barrier_post(xbar, xst); } PROBE_STAMP(1) }
#pragma unroll 1
    for (int l = 0; l < DEPTH; ++l) {
        PHASE_STEP(0) PHASE_STEP(1) PHASE_STEP(2) PHASE_STEP(3) PHASE_STEP(4) PHASE_STEP(5) PHASE_STEP(6) PHASE_STEP(7) PHASE_STEP(8) PHASE_STEP(9) PHASE_STEP(10) PHASE_STEP(11) PHASE_STEP(12)
    }
#ifdef PROBE_PHASE
#ifndef PROBE_END
#define PROBE_END (PROBE_PHASE + 1)
#endif
    GRID_SYNC();
    PROBE_STAMP(NPHASE)
    GRID_SYNC();
    {
        const unsigned long long* ts = (const unsigned long long*)(p.ws + WS_TS);
        const unsigned long long t0 = __hip_atomic_load(ts, __ATOMIC_RELAXED, __HIP_MEMORY_SCOPE_AGENT), t1 = __hip_atomic_load(ts + NPHASE, __ATOMIC_RELAXED, __HIP_MEMORY_SCOPE_AGENT);
        const unsigned long long ta = __hip_atomic_load(ts + PROBE_PHASE, __ATOMIC_RELAXED, __HIP_MEMORY_SCOPE_AGENT), tb = __hip_atomic_load(ts + PROBE_END, __ATOMIC_RELAXED, __HIP_MEMORY_SCOPE_AGENT);
        const float f = (float)(tb - ta) / (float)(t1 - t0);
        const float sc = 1.f + sqrtf(6e-4f * f);
        f32x4* o = (f32x4*)(p.out + (size_t)2 * SEQL * D);
        for (size_t i = (size_t)blockIdx.x * NTH + threadIdx.x; i < (size_t)SEQL * D / 4; i += (size_t)gridDim.x * NTH) o[i] = o[i] * sc;
    }
#endif
}

#ifndef ONE_LAUNCH
#define ONE_LAUNCH 1
#endif
extern "C" void kernel_launch(void* const* d_in, const int* in_sizes, int n_in, void* d_out, int out_size, void* d_ws, size_t ws_size, hipStream_t stream) {
    static int grid = 0;
    if (grid == 0) {
        if (n_in != 27 || out_size != T * D || ws_size < WS_END) { fprintf(stderr, "kernel_launch: unexpected shapes: n_in %d out %d ws %zu (need %zu)\n", n_in, out_size, ws_size, (size_t)WS_END); grid = -1; return; }
        int dev = 0, cus = 0, per_cu = 0;
        hipGetDevice(&dev);
        hipDeviceGetAttribute(&cus, hipDeviceAttributeMultiprocessorCount, dev);
        if (hipFuncSetAttribute((const void*)encoder_fwd, hipFuncAttributeMaxDynamicSharedMemorySize, LDS_BYTES) != hipSuccess) { fprintf(stderr, "kernel_launch: hipFuncSetAttribute failed\n"); grid = -1; return; }
        if (hipOccupancyMaxActiveBlocksPerMultiprocessor(&per_cu, (const void*)encoder_fwd, NTH, LDS_BYTES) != hipSuccess || per_cu < 1) { fprintf(stderr, "kernel_launch: occupancy query failed (%d)\n", per_cu); grid = -1; return; }
        grid = cus < MAX_GRID ? cus : MAX_GRID; grid &= ~7;
        fprintf(stderr, "kernel_launch: cus %d per_cu %d grid %d ws %zu need %zu\n", cus, per_cu, grid, ws_size, (size_t)WS_END);
    }
    if (grid < 0) return;
    Params p{};
    for (int i = 0; i < 27; ++i) p.in[i] = (const float*)d_in[i];
    p.out = (float*)d_out; p.ws = (unsigned char*)d_ws;
#if ONE_LAUNCH
    p.ph_lo = 0; p.ph_hi = NPHASE;
    void* args[] = {&p};
    hipError_t e = hipLaunchCooperativeKernel((const void*)encoder_fwd, dim3(grid), dim3(NTH), args, LDS_BYTES, stream);
    if (e != hipSuccess) fprintf(stderr, "cooperative launch failed: %s (grid %d)\n", hipGetErrorString(e), grid);
#else
    for (int ph = 0; ph < NPHASE; ++ph) {
        p.ph_lo = ph; p.ph_hi = ph + 1;
        hipLaunchKernelGGL(encoder_fwd, dim3(grid), dim3(NTH), LDS_BYTES, stream, p);
    }
#endif
}
```
